# Optimizing an MI355X kernel written in HIP

```python
import math
import jax, jax.numpy as jnp
from jax import lax
import numpy as np

D_MODEL = 1024
BATCH = 8
SEQ = 4096
DEPTH = 1

D_FF = 2816
D_MIX = D_MODEL
A_WIDTH = D_MIX // 2
A_HEADS = 8
A_HEAD_DIM = A_WIDTH // A_HEADS
CHUNK = 128
B_WIDTH = D_MIX - A_WIDTH
POOL_WINDOWS = (2, 4, 8, 16)
B_GROUPS = len(POOL_WINDOWS)
B_GROUP_DIM = B_WIDTH // B_GROUPS
IN_COLS = 2 * A_WIDTH + B_WIDTH
EPS = 1e-6

kernel_name = "hybrid_gmlp_pool_macaron_block"


def rmsnorm(x, g):
    xf = x.astype(jnp.float32)
    r = lax.rsqrt(jnp.mean(xf * xf, axis=-1, keepdims=True) + EPS)
    return (xf * r).astype(x.dtype) * g


def swiglu(h, w_gate, w_up, w_down):
    return (jax.nn.silu(h @ w_gate) * (h @ w_up)) @ w_down


def gmlp_mixer(u, v, v_gain, w_s, b_s):
    bsz, seq, _ = u.shape
    u = jax.nn.gelu(u)
    v = jax.nn.gelu(v).reshape(bsz, seq, A_HEADS, A_HEAD_DIM)
    v = rmsnorm(v, v_gain.reshape(A_HEADS, A_HEAD_DIM))
    v = v.reshape(bsz, seq // CHUNK, CHUNK, A_HEADS, A_HEAD_DIM)
    causal = jnp.tril(jnp.ones((CHUNK, CHUNK), dtype=bool))
    w = jnp.where(causal[None], w_s, jnp.zeros_like(w_s))
    v = jnp.einsum('hts,bnshd->bnthd', w, v) + b_s.T[None, None, :, :, None]
    return u * v.reshape(bsz, seq, A_WIDTH)


def pool_mixer(z, w_pool, scale):
    bsz, seq, _ = z.shape
    zf = z.astype(jnp.float32)
    cs = jnp.concatenate([jnp.zeros((bsz, 1, B_WIDTH), jnp.float32),
                          jnp.cumsum(zf, axis=1)], axis=1)
    pos = jnp.arange(1, seq + 1, dtype=jnp.int32)
    outs = []
    for g, win in enumerate(POOL_WINDOWS):
        sl = slice(g * B_GROUP_DIM, (g + 1) * B_GROUP_DIM)
        c = cs[..., sl]
        upper = c[:, 1:]
        lower = jnp.concatenate([jnp.zeros((bsz, win - 1, B_GROUP_DIM), jnp.float32),
                                 c[:, :seq - win + 1]], axis=1)
        count = jnp.minimum(pos, win).astype(jnp.float32)[None, :, None]
        d = ((upper - lower) / count - zf[..., sl]).astype(z.dtype)
        outs.append(d @ w_pool[g])
    return jnp.concatenate(outs, axis=-1) * scale


def setup_inputs(seed: int = 0) -> dict:
    key = jax.random.key(seed)
    ks = jax.random.split(key, 20)
    f32 = jnp.float32
    L = DEPTH

    def nrm(k, shape, s):
        return jax.random.normal(k, shape, f32) * s

    def gain(k, shape):
        return 1.0 + 0.05 * jax.random.normal(k, shape, f32)

    return {
        "x": jax.random.normal(ks[0], (BATCH, SEQ, D_MODEL), f32),
        "ffn1_norm": gain(ks[1], (L, D_MODEL)),
        "ffn1_w_gate": nrm(ks[2], (L, D_MODEL, D_FF), D_MODEL ** -0.5),
        "ffn1_w_up": nrm(ks[3], (L, D_MODEL, D_FF), D_MODEL ** -0.5),
        "ffn1_w_down": nrm(ks[4], (L, D_FF, D_MODEL), D_FF ** -0.5),
        "mix_norm": gain(ks[5], (L, D_MODEL)),
        "w_in": nrm(ks[6], (L, D_MODEL, IN_COLS), D_MODEL ** -0.5),
        "gmlp_v_norm": gain(ks[7], (L, A_WIDTH)),
        "gmlp_w_s": nrm(ks[8], (L, A_HEADS, CHUNK, CHUNK), 0.5 * CHUNK ** -0.5),
        "gmlp_b_s": 1.0 + 0.1 * jax.random.normal(ks[9], (L, A_HEADS, CHUNK), f32),
        "pool_w": nrm(ks[10], (L, B_GROUPS, B_GROUP_DIM, B_GROUP_DIM), B_GROUP_DIM ** -0.5),
        "pool_scale": gain(ks[11], (L, B_WIDTH)),
        "w_out": nrm(ks[12], (L, D_MIX, D_MODEL), D_MIX ** -0.5),
        "ffn2_norm": gain(ks[13], (L, D_MODEL)),
        "ffn2_w_gate": nrm(ks[14], (L, D_MODEL, D_FF), D_MODEL ** -0.5),
        "ffn2_w_up": nrm(ks[15], (L, D_MODEL, D_FF), D_MODEL ** -0.5),
        "ffn2_w_down": nrm(ks[16], (L, D_FF, D_MODEL), D_FF ** -0.5),
        "final_norm": gain(ks[17], (D_MODEL,)),
    }


def reference(x, ffn1_norm, ffn1_w_gate, ffn1_w_up, ffn1_w_down, mix_norm, w_in,
              gmlp_v_norm, gmlp_w_s, gmlp_b_s, pool_w, pool_scale, w_out,
              ffn2_norm, ffn2_w_gate, ffn2_w_up, ffn2_w_down, final_norm):
    for l in range(DEPTH):
        x = x + 0.5 * swiglu(rmsnorm(x, ffn1_norm[l]), ffn1_w_gate[l], ffn1_w_up[l], ffn1_w_down[l])
        p = rmsnorm(x, mix_norm[l]) @ w_in[l]
        u_a = p[..., :A_WIDTH]
        v_a = p[..., A_WIDTH:2 * A_WIDTH]
        z_b = p[..., 2 * A_WIDTH:]
        y_a = gmlp_mixer(u_a, v_a, gmlp_v_norm[l], gmlp_w_s[l], gmlp_b_s[l])
        y_b = pool_mixer(z_b, pool_w[l], pool_scale[l])
        x = x + jnp.concatenate([y_a, y_b], axis=-1) @ w_out[l]
        x = x + 0.5 * swiglu(rmsnorm(x, ffn2_norm[l]), ffn2_w_gate[l], ffn2_w_up[l], ffn2_w_down[l])
    return rmsnorm(x, final_norm)
```

```cpp
#include <hip/hip_runtime.h>
#include <hip/hip_cooperative_groups.h>
#include <cstdio>
#include <cstdint>
namespace cg = cooperative_groups;
#ifndef PHM
#define PHM 0x1ff
#endif
#ifndef MK_LAUNCHES
#define MK_LAUNCHES 9
#endif
namespace pg8 {
#define PG8_LAS __attribute__((address_space(3)))
typedef unsigned short bf16_t;
typedef short bf16x8 __attribute__((ext_vector_type(8)));
typedef float f32x4 __attribute__((ext_vector_type(4)));
typedef unsigned u32x4 __attribute__((ext_vector_type(4)));
constexpr int BM = 256, BK = 64, HALF = 128, HTB = HALF * BK * 2  , STAGE_BYTES = 8 * HTB, NXCD = 8, WGM = 8;

__host__ __device__ __forceinline__ int lds_byte(int r, int c) { const int st = (r >> 4) * 2 + (c >> 5), rr = r & 15, cc = c & 31, ob = rr * 64 + cc * 2; return st * 1024 + (ob ^ (((ob >> 9) & 1) << 5)); }
__host__ __device__ __forceinline__ void stage_rc(int b, int& R, int& C) { const int st = b / 1024, sb = b % 1024, swz = sb ^ (((sb >> 9) & 1) << 5); R = (st >> 1) * 16 + swz / 64; C = (st & 1) * 32 + (swz % 64) / 2; }
__host__ __device__ __forceinline__ int perm32(int rho) { const int n = rho >> 4, i = rho & 15; return 8 * (i >> 2) + 4 * n + (i & 3); }

struct Unit { int pm, pn; };
struct Gemm { const bf16_t* A; const bf16_t* Bt; int M, N, K; };

struct StaticOrder {
    int nM, nN, nwg, G, c;
    __host__ __device__ void init(int M, int N, int G_, int c_) { nM = M / BM; nN = N / BM; nwg = nM * nN; G = G_; c = c_; }
    __host__ __device__ bool next(int i, Unit& u) const {
        const long L = (long)i * G + c; if (L >= nwg) return false;
        int wgid = (int)L; { const int q = nwg / NXCD, r = nwg % NXCD, xcd = wgid % NXCD, off = wgid / NXCD; wgid = (xcd < r ? xcd * (q + 1) : r * (q + 1) + (xcd - r) * q) + off; }
        const int nig = WGM * nN, gid = wgid / nig, fm = gid * WGM, gsz = (nM - fm) < WGM ? (nM - fm) : WGM;
        u.pm = fm + ((wgid % nig) % gsz); u.pn = (wgid % nig) / gsz; return true;
    }
    __device__ __forceinline__ void a_ready(const Unit&) const {}
    __device__ __forceinline__ void done(const Unit&) const {}
};
__device__ __forceinline__ unsigned cvt_pk_bf16(float lo, float hi) { unsigned r; asm volatile("v_cvt_pk_bf16_f32 %0, %1, %2" : "=v"(r) : "v"(lo), "v"(hi)); return r; }
template <class Epi, class Sched, bool ALIGN_EPI = false, bool SP2 = false>
__device__ __forceinline__ void gemm_phase(PG8_LAS unsigned char* lds, const Gemm g, const Sched& S, const Epi& E, const int tid) {
    const int wid = __builtin_amdgcn_readfirstlane(tid >> 6), lane = tid & 63, wr = wid >> 2, wc = wid & 3, fr = lane & 15, fq = lane >> 4;
    const int K = g.K, nt = K / BK;
    unsigned voffA[2], voffB[2];
#pragma unroll
    for (int i = 0; i < 2; ++i) { int R, C; stage_rc(tid * 16 + i * 8192, R, C); const int Rb = Epi::PERM ? ((R & ~31) + perm32(R & 31)) : R;
        voffA[i] = (unsigned)(R * K + C) * 2u; voffB[i] = (unsigned)(Rb * K + C) * 2u; }
    const size_t kstep = (size_t)(BK * 2);
    const size_t hstep = (size_t)HALF * K * 2;
    const size_t tstep = 2 * hstep;
    const unsigned ldsw = (unsigned)wid * 1024u;
    const int aoff = lds_byte(wr * 64 + fr, fq * 8), boff = lds_byte(wc * 32 + fr, fq * 8);
#define PG8_SA(b, h) (((b) * 2 + (h)) * HTB)
#define PG8_SB(b, h) ((4 + (b) * 2 + (h)) * HTB)
#define PG8_STAGE(bufoff, gbase, voff) do { _Pragma("unroll") for (int _i = 0; _i < 2; ++_i) \
        __builtin_amdgcn_global_load_lds((const unsigned*)((const char*)(gbase) + (voff)[_i]), (PG8_LAS unsigned*)(lds + (bufoff) + ldsw + _i * 8192), 16, 0, 0); } while (0)
#define PG8_LDA(dst, b, h) do { _Pragma("unroll") for (int m = 0; m < 4; ++m) _Pragma("unroll") for (int k = 0; k < 2; ++k) dst[m][k] = *(const PG8_LAS bf16x8*)(lds + PG8_SA(b, h) + aoff + m * 2048 + k * 1024); } while (0)
#define PG8_LDB(dst, b, h) do { _Pragma("unroll") for (int n = 0; n < 2; ++n) _Pragma("unroll") for (int k = 0; k < 2; ++k) dst[n][k] = *(const PG8_LAS bf16x8*)(lds + PG8_SB(b, h) + boff + n * 2048 + k * 1024); } while (0)
#define PG8_MMA(ai, bj, At, Bt) do { __builtin_amdgcn_s_setprio(1); _Pragma("unroll") for (int m = 0; m < 4; ++m) _Pragma("unroll") for (int n = 0; n < 2; ++n) _Pragma("unroll") for (int k = 0; k < 2; ++k) \
        acc[ai][bj][m][n] = __builtin_amdgcn_mfma_f32_16x16x32_bf16(Bt[n][k], At[m][k], acc[ai][bj][m][n], 0, 0, 0); __builtin_amdgcn_s_setprio(0); } while (0)
#define PG8_WAIT_V(n) asm volatile("s_waitcnt vmcnt(" #n ")" ::: "memory")
#define PG8_WAIT_L(n) asm volatile("s_waitcnt lgkmcnt(" #n ")" ::: "memory")
#define PG8_BAR __builtin_amdgcn_s_barrier()
#define PG8_SCHED __builtin_amdgcn_sched_barrier(0)
    Unit cur, nxt; int ui = 0;
    if (!S.next(0, cur)) return;
    f32x4 acc[2][2][4][2];
#pragma unroll
    for (int a = 0; a < 2; ++a)
#pragma unroll
        for (int b = 0; b < 2; ++b)
#pragma unroll
            for (int m = 0; m < 4; ++m)
#pragma unroll
                for (int n = 0; n < 2; ++n) acc[a][b][m][n] = (f32x4){0.f, 0.f, 0.f, 0.f};
    bf16x8 At[4][2], B0[2][2], B1[2][2];
    const char* cA = (const char*)g.A + (size_t)cur.pm * tstep; const char* cB = (const char*)g.Bt + (size_t)cur.pn * tstep;
    S.a_ready(cur);
    if constexpr (SP2) {
        PG8_STAGE(PG8_SB(0, 0), cB, voffB); PG8_STAGE(PG8_SB(0, 1), cB + hstep, voffB); PG8_STAGE(PG8_SA(0, 0), cA, voffA); PG8_STAGE(PG8_SA(0, 1), cA + hstep, voffA);
        if (wr == 1) PG8_BAR;
        PG8_WAIT_V(2); PG8_BAR;
        PG8_STAGE(PG8_SB(1, 0), cB + kstep, voffB); PG8_STAGE(PG8_SA(1, 0), cA + kstep, voffA); PG8_STAGE(PG8_SB(1, 1), cB + hstep + kstep, voffB);
        PG8_WAIT_V(6); PG8_BAR;
    } else {
        PG8_STAGE(PG8_SB(0, 0), cB, voffB); PG8_STAGE(PG8_SA(0, 0), cA, voffA); PG8_STAGE(PG8_SB(0, 1), cB + hstep, voffB); PG8_STAGE(PG8_SA(0, 1), cA + hstep, voffA);
        if (wr == 1) PG8_BAR;
        PG8_WAIT_V(4); PG8_BAR;
        PG8_STAGE(PG8_SB(1, 0), cB + kstep, voffB); PG8_STAGE(PG8_SA(1, 0), cA + kstep, voffA); PG8_STAGE(PG8_SB(1, 1), cB + hstep + kstep, voffB);
        PG8_WAIT_V(6); PG8_BAR;
    }
    for (;;) {
        const bool has_next = S.next(ui + 1, nxt);
        const char* nA = has_next ? (const char*)g.A + (size_t)nxt.pm * tstep : cA; const char* nB = has_next ? (const char*)g.Bt + (size_t)nxt.pn * tstep : cB;
        for (int t = 0; t < nt; t += 2) {
            const bool last = (t == nt - 2);
            const char* a1 = cA + (size_t)(t + 1) * kstep;
            const char* a2 = last ? nA : cA + (size_t)(t + 2) * kstep; const char* b2 = last ? nB : cB + (size_t)(t + 2) * kstep;
            const char* a3 = a2 + kstep; const char* b3 = b2 + kstep;
            if (last && has_next) S.a_ready(nxt);
            if constexpr (SP2) {
            PG8_LDB(B0, 0, 0); PG8_LDB(B1, 0, 1); PG8_SCHED; PG8_LDA(At, 0, 0); PG8_STAGE(PG8_SA(1, 1), a1 + hstep, voffA);
            PG8_WAIT_V(8); PG8_WAIT_L(0); PG8_BAR; PG8_MMA(0, 0, At, B0); PG8_MMA(0, 1, At, B1); PG8_BAR; PG8_SCHED;
            PG8_LDA(At, 0, 1); PG8_STAGE(PG8_SB(0, 0), b2, voffB); PG8_STAGE(PG8_SB(0, 1), b2 + hstep, voffB); PG8_STAGE(PG8_SA(0, 0), a2, voffA);
            PG8_WAIT_V(8); PG8_WAIT_L(0); PG8_BAR; PG8_MMA(1, 0, At, B0); PG8_MMA(1, 1, At, B1); PG8_BAR; PG8_SCHED;
            PG8_LDB(B0, 1, 0); PG8_LDB(B1, 1, 1); PG8_SCHED; PG8_LDA(At, 1, 0); PG8_STAGE(PG8_SA(0, 1), a2 + hstep, voffA);
            PG8_WAIT_V(8); PG8_WAIT_L(0); PG8_BAR; PG8_MMA(0, 0, At, B0); PG8_MMA(0, 1, At, B1); PG8_BAR; PG8_SCHED;
            PG8_LDA(At, 1, 1); PG8_STAGE(PG8_SB(1, 0), b3, voffB); PG8_STAGE(PG8_SB(1, 1), b3 + hstep, voffB); PG8_STAGE(PG8_SA(1, 0), a3, voffA);
            PG8_WAIT_V(8); PG8_WAIT_L(0); PG8_BAR; PG8_MMA(1, 0, At, B0); PG8_MMA(1, 1, At, B1); PG8_BAR; PG8_SCHED;
            } else {
            PG8_LDB(B0, 0, 0); PG8_SCHED; PG8_LDA(At, 0, 0); PG8_STAGE(PG8_SA(1, 1), a1 + hstep, voffA);
            PG8_WAIT_L(8); PG8_BAR; PG8_WAIT_L(0); PG8_MMA(0, 0, At, B0); PG8_BAR; PG8_SCHED;
            PG8_LDB(B1, 0, 1); PG8_STAGE(PG8_SB(0, 0), b2, voffB);
            PG8_BAR; PG8_WAIT_L(0); PG8_MMA(0, 1, At, B1); PG8_BAR;
            PG8_LDA(At, 0, 1); PG8_STAGE(PG8_SA(0, 0), a2, voffA);
            PG8_BAR; PG8_WAIT_L(0); PG8_MMA(1, 0, At, B0); PG8_BAR; PG8_SCHED;
            PG8_STAGE(PG8_SB(0, 1), b2 + hstep, voffB);
            PG8_WAIT_V(6); PG8_BAR; PG8_MMA(1, 1, At, B1); PG8_BAR;
            PG8_LDB(B0, 1, 0); PG8_SCHED; PG8_LDA(At, 1, 0); PG8_STAGE(PG8_SA(0, 1), a2 + hstep, voffA);
            PG8_WAIT_L(8); PG8_BAR; PG8_WAIT_L(0); PG8_MMA(0, 0, At, B0); PG8_BAR; PG8_SCHED;
            PG8_LDB(B1, 1, 1); PG8_STAGE(PG8_SB(1, 0), b3, voffB);
            PG8_BAR; PG8_WAIT_L(0); PG8_MMA(0, 1, At, B1); PG8_BAR;
            PG8_LDA(At, 1, 1); PG8_STAGE(PG8_SA(1, 0), a3, voffA);
            PG8_BAR; PG8_WAIT_L(0); PG8_MMA(1, 0, At, B0); PG8_BAR; PG8_SCHED;
            PG8_STAGE(PG8_SB(1, 1), b3 + hstep, voffB);
            PG8_WAIT_V(6); PG8_BAR; PG8_MMA(1, 1, At, B1); PG8_BAR;
            }
        }
        if constexpr (ALIGN_EPI) { if (wr == 0) PG8_BAR; }
        if constexpr (!Epi::AFTER_DRAIN) { E(acc, cur, wr, wc, fr, fq); S.done(cur); }
        if (!has_next) break;
#pragma unroll
        for (int a = 0; a < 2; ++a)
#pragma unroll
            for (int b = 0; b < 2; ++b)
#pragma unroll
                for (int m = 0; m < 4; ++m)
#pragma unroll
                    for (int n = 0; n < 2; ++n) acc[a][b][m][n] = (f32x4){0.f, 0.f, 0.f, 0.f};
        cur = nxt; cA = nA; cB = nB; ++ui;
        if constexpr (ALIGN_EPI) { if (wr == 1) PG8_BAR; }
    }
    PG8_WAIT_V(0);
    if constexpr (!ALIGN_EPI) { if (wr == 0) PG8_BAR; }
    PG8_BAR;
    if constexpr (Epi::AFTER_DRAIN) { E.fused(acc, cur, wr, wc, fr, fq, lds, wid, lane); S.done(cur); }
#undef PG8_SA
#undef PG8_SB
#undef PG8_STAGE
#undef PG8_LDA
#undef PG8_LDB
#undef PG8_MMA
#undef PG8_WAIT_V
#undef PG8_WAIT_L
#undef PG8_BAR
#undef PG8_SCHED
}
}

namespace mk {
using pg8::bf16_t; using pg8::f32x4; using pg8::u32x4; using pg8::bf16x8; using pg8::Unit;
#define LAS __attribute__((address_space(3)))
typedef unsigned u32x2 __attribute__((ext_vector_type(2)));
constexpr int M = 32768, D = 1024, FF = 2816, NIN = 1536, AW = 512, SEQ = 4096;
constexpr float EPS = 1e-6f;
constexpr int LDS_BYTES = 147456;
constexpr size_t MiB = 1u << 20;
constexpr size_t WS_W1A = 0 * MiB, WS_W1D = 11 * MiB, WS_W2A = 17 * MiB, WS_W2D = 28 * MiB, WS_WIN = 34 * MiB, WS_WOUT = 37 * MiB, WS_WM = 39 * MiB, WS_SS = 40 * MiB,
                 WS_XB = 42 * MiB, WS_ACT = 106 * MiB, WS_U = WS_ACT, WS_V = WS_ACT + 32 * MiB, WS_Z = WS_ACT + 64 * MiB, WS_Y = WS_ACT + 96 * MiB, WS_END = 282 * MiB;

__device__ __forceinline__ float silu_f(float g) { return g * __builtin_amdgcn_rcpf(1.0f + __builtin_amdgcn_exp2f(-1.4426950409f * g)); }
__device__ __forceinline__ float gelu_f(float v) { const float w = v + 0.044715f * v * v * v; return v * __builtin_amdgcn_rcpf(1.0f + __builtin_amdgcn_exp2f(-2.3022081981f * w)); }
__device__ __forceinline__ float bf_lo(unsigned w) { return __uint_as_float(w << 16); }
__device__ __forceinline__ float bf_hi(unsigned w) { return __uint_as_float(w & 0xffff0000u); }
__device__ __forceinline__ u32x4 pack8(const f32x4 a, const f32x4 b) { u32x4 w; w.x = pg8::cvt_pk_bf16(a[0], a[1]); w.y = pg8::cvt_pk_bf16(a[2], a[3]); w.z = pg8::cvt_pk_bf16(b[0], b[1]); w.w = pg8::cvt_pk_bf16(b[2], b[3]); return w; }
__device__ __forceinline__ float row_rstd(const float* ss, int row, int fq) {
    const f32x4 p = *(const f32x4*)(ss + (size_t)row * 16 + 4 * fq);
    float s = (p[0] + p[1]) + (p[2] + p[3]);
    s += __shfl_xor(s, 16); s += __shfl_xor(s, 32);
    return __builtin_amdgcn_rsqf(s * (1.0f / 1024.0f) + EPS);
}

struct EpiSwiglu {
    static constexpr bool PERM = true, AFTER_DRAIN = false;
    bf16_t* O; const float* ss;
    __device__ __forceinline__ void operator()(const f32x4 (&acc)[2][2][4][2], const Unit& u, int wr, int wc, int fr, int fq) const {
        const int row0 = u.pm * 256 + wr * 64 + fr, col0 = u.pn * 128 + wc * 32 + 8 * fq;
        float r[2][4];
#pragma unroll
        for (int ai = 0; ai < 2; ++ai)
#pragma unroll
            for (int m = 0; m < 4; ++m) r[ai][m] = row_rstd(ss, row0 + ai * 128 + m * 16, fq);
#pragma unroll
        for (int ai = 0; ai < 2; ++ai)
#pragma unroll
            for (int m = 0; m < 4; ++m) {
                const float rr = r[ai][m];
                f32x4 o0, o1;
#pragma unroll
                for (int e = 0; e < 4; ++e) { o0[e] = silu_f(acc[ai][0][m][0][e] * rr) * (acc[ai][1][m][0][e] * rr); o1[e] = silu_f(acc[ai][0][m][1][e] * rr) * (acc[ai][1][m][1][e] * rr); }
                *(u32x4*)(O + (size_t)(row0 + ai * 128 + m * 16) * FF + col0) = pack8(o0, o1);
            }
    }
};
struct EpiRes {
    static constexpr bool PERM = true, AFTER_DRAIN = false;
    const float* base; float* out; bf16_t* xb; float* ss; float alpha;
    __device__ __forceinline__ void operator()(const f32x4 (&acc)[2][2][4][2], const Unit& u, int wr, int wc, int fr, int fq) const {
        const unsigned off0 = (unsigned)(u.pm * 256 + wr * 64 + fr) * (unsigned)D + (unsigned)(u.pn * 256 + wc * 32 + 8 * fq);
        const unsigned sso = (unsigned)(u.pm * 256 + wr * 64 + fr) * 16u + (unsigned)(u.pn * 4 + wc);
#pragma unroll
        for (int ai = 0; ai < 2; ++ai)
#pragma unroll
            for (int m = 0; m < 4; ++m) {
                float sq = 0.f;
#pragma unroll
                for (int bj = 0; bj < 2; ++bj) {
                    const unsigned off = off0 + (unsigned)((ai * 128 + m * 16) * D + bj * 128);
                    const f32x4 b0 = *(const f32x4*)(base + off), b1 = *(const f32x4*)(base + off + 4);
                    const f32x4 v0 = b0 + acc[ai][bj][m][0] * alpha, v1 = b1 + acc[ai][bj][m][1] * alpha;
                    *(f32x4*)(out + off) = v0; *(f32x4*)(out + off + 4) = v1;
                    if (xb) *(u32x4*)(xb + off) = pack8(v0, v1);
                    sq += (v0[0] * v0[0] + v0[1] * v0[1]) + (v0[2] * v0[2] + v0[3] * v0[3]) + (v1[0] * v1[0] + v1[1] * v1[1]) + (v1[2] * v1[2] + v1[3] * v1[3]);
                }
                sq += __shfl_xor(sq, 16); sq += __shfl_xor(sq, 32);
                if (fq == 0) ss[sso + (unsigned)((ai * 128 + m * 16) * 16)] = sq;
                asm volatile("" ::: "memory");
            }
    }
};
struct EpiWin {
    static constexpr bool PERM = true, AFTER_DRAIN = false;
    bf16_t *U, *V, *Z; const float* ss;
    __device__ __forceinline__ void operator()(const f32x4 (&acc)[2][2][4][2], const Unit& u, int wr, int wc, int fr, int fq) const {
        const int row0 = u.pm * 256 + wr * 64 + fr;
        float r[2][4];
#pragma unroll
        for (int ai = 0; ai < 2; ++ai)
#pragma unroll
            for (int m = 0; m < 4; ++m) r[ai][m] = row_rstd(ss, row0 + ai * 128 + m * 16, fq);
        if (u.pn < 2) {
            const int col0 = u.pn * 256 + wc * 32 + 8 * fq;
#pragma unroll
            for (int ai = 0; ai < 2; ++ai)
#pragma unroll
                for (int m = 0; m < 4; ++m) { const float rr = r[ai][m]; bf16_t* rowp = U + (size_t)(row0 + ai * 128 + m * 16) * AW + col0;
#pragma unroll
                    for (int bj = 0; bj < 2; ++bj) { f32x4 o0, o1;
#pragma unroll
                        for (int e = 0; e < 4; ++e) { o0[e] = gelu_f(acc[ai][bj][m][0][e] * rr); o1[e] = gelu_f(acc[ai][bj][m][1][e] * rr); }
                        *(u32x4*)(rowp + bj * 128) = pack8(o0, o1); } }
        } else if (u.pn < 4) {
            const int colb = 64 * ((u.pn - 2) * 4 + wc) + 8 * fq;
#pragma unroll
            for (int ai = 0; ai < 2; ++ai)
#pragma unroll
                for (int m = 0; m < 4; ++m) { const float rr = r[ai][m]; f32x4 g[2][2]; float sq = 0.f;
#pragma unroll
                    for (int bj = 0; bj < 2; ++bj)
#pragma unroll
                        for (int n = 0; n < 2; ++n)
#pragma unroll
                            for (int e = 0; e < 4; ++e) { const float t = gelu_f(acc[ai][bj][m][n][e] * rr); g[bj][n][e] = t; sq += t * t; }
                    sq += __shfl_xor(sq, 16); sq += __shfl_xor(sq, 32);
                    const float hr = __builtin_amdgcn_rsqf(sq * (1.0f / 64.0f) + EPS);
                    bf16_t* rowp = V + (size_t)(row0 + ai * 128 + m * 16) * AW + colb;
#pragma unroll
                    for (int bj = 0; bj < 2; ++bj) *(u32x4*)(rowp + 32 * bj) = pack8(g[bj][0] * hr, g[bj][1] * hr); }
        } else {
            const int col0 = (u.pn - 4) * 256 + wc * 32 + 8 * fq;
#pragma unroll
            for (int ai = 0; ai < 2; ++ai)
#pragma unroll
                for (int m = 0; m < 4; ++m) { const float rr = r[ai][m]; bf16_t* rowp = Z + (size_t)(row0 + ai * 128 + m * 16) * AW + col0;
#pragma unroll
                    for (int bj = 0; bj < 2; ++bj) *(u32x4*)(rowp + bj * 128) = pack8(acc[ai][bj][m][0] * rr, acc[ai][bj][m][1] * rr); }
        }
    }
};

__device__ __forceinline__ float wave_sum(float v) {
#pragma unroll
    for (int o = 1; o < 64; o <<= 1) v += __shfl_xor(v, o);
    return v;
}
__device__ __forceinline__ void p0_transpose_item(const float* src, int ld, int Kd, int k0, int scol0, bf16_t* dst, int drow0, const float* gk, LAS float* scr, int lane) {
#pragma unroll 8
    for (int i = 0; i < 32; ++i) { const int kk = 2 * i + (lane >> 5); const float gsc = gk ? gk[k0 + kk] : 1.0f; scr[kk * 33 + (lane & 31)] = src[(size_t)(k0 + kk) * ld + scol0 + (lane & 31)] * gsc; }
    asm volatile("s_waitcnt lgkmcnt(0)" ::: "memory");
    const int c = lane & 7;
#pragma unroll
    for (int j = 0; j < 4; ++j) { const int n = (lane >> 3) + 8 * j; const LAS float* s = scr + (8 * c) * 33 + n;
        u32x4 o; o.x = pg8::cvt_pk_bf16(s[0 * 33], s[1 * 33]); o.y = pg8::cvt_pk_bf16(s[2 * 33], s[3 * 33]); o.z = pg8::cvt_pk_bf16(s[4 * 33], s[5 * 33]); o.w = pg8::cvt_pk_bf16(s[6 * 33], s[7 * 33]);
        *(u32x4*)(dst + (size_t)(drow0 + n) * Kd + k0 + 8 * c) = o; }
    asm volatile("s_waitcnt lgkmcnt(0)" ::: "memory");
}

struct Params { const float* in[18]; float* out; unsigned char* ws; int ph_lo, ph_hi; };

__device__ __forceinline__ void p0_prep(const Params& p, LAS unsigned char* lds, int tid, int wave, int lane) {
    unsigned char* ws = p.ws;
    LAS float* scr = (LAS float*)(lds + wave * 16384);
    const int gw = blockIdx.x * 8 + wave, NGW = gridDim.x * 8;
    constexpr int I_A = 16 * 176, I_D = 44 * 32, I_IN = 16 * 32, I_OUT = 16 * 32, I_ZP = 256;
    constexpr int NITEMS = 2 * (I_A + I_D) + I_IN + I_OUT + I_ZP;
    for (int it = gw; it < NITEMS; it += NGW) {
        int r = it;
        if (r < 2 * (I_A + I_D)) {
            const int l = r >= (I_A + I_D); if (l) r -= (I_A + I_D);
            const float* nrm = l ? p.in[13] : p.in[1]; const float* wg = l ? p.in[14] : p.in[2]; const float* wu = l ? p.in[15] : p.in[3]; const float* wd = l ? p.in[16] : p.in[4];
            bf16_t* dA = (bf16_t*)(ws + (l ? WS_W2A : WS_W1A)); bf16_t* dD = (bf16_t*)(ws + (l ? WS_W2D : WS_W1D));
            if (r < I_A) { const int kb = r / 176, rb = r % 176, pn = rb >> 3, bj = (rb >> 2) & 1, c0 = (rb & 3) * 32;
                p0_transpose_item(bj ? wu : wg, FF, D, 64 * kb, 128 * pn + c0, dA, 32 * rb, nrm, scr, lane); }
            else { r -= I_A; const int kb = r / 32, rb = r % 32; p0_transpose_item(wd, D, FF, 64 * kb, 32 * rb, dD, 32 * rb, nullptr, scr, lane); }
            continue;
        }
        r -= 2 * (I_A + I_D);
        if (r < I_IN) { const int kb = r / 32, rb = r % 32; int sc;
            if (rb < 16) sc = 32 * rb; else { const int q = rb - 16, pn = q >> 3, bj = (q >> 2) & 1, wc = q & 3; sc = 512 + 64 * (4 * pn + wc) + 32 * bj; }
            p0_transpose_item(p.in[6], NIN, D, 64 * kb, sc, (bf16_t*)(ws + WS_WIN), 32 * rb, p.in[5], scr, lane); continue; }
        r -= I_IN;
        if (r < I_OUT) { const int kb = r / 32, rb = r % 32; p0_transpose_item(p.in[12], D, D, 64 * kb, 32 * rb, (bf16_t*)(ws + WS_WOUT), 32 * rb, nullptr, scr, lane); continue; }
        r -= I_OUT;
        {
            const int g = r >> 6, kb = (r >> 2) & 15, jb = r & 3, k = 64 * kb + lane;
            const float* wrow = p.in[6] + (size_t)k * NIN + 1024 + 128 * g;
            const float* wp = p.in[10] + (size_t)g * 16384 + 32 * jb;
            float a[32];
#pragma unroll
            for (int j = 0; j < 32; ++j) a[j] = 0.f;
            for (int i4 = 0; i4 < 32; ++i4) { const f32x4 w4 = *(const f32x4*)(wrow + 4 * i4);
#pragma unroll
                for (int e = 0; e < 4; ++e) { const float* wpi = wp + (size_t)(4 * i4 + e) * 128;
#pragma unroll
                    for (int j = 0; j < 32; ++j) a[j] += w4[e] * wpi[j]; } }
            const float gm = p.in[5][k];
            bf16_t* dst = (bf16_t*)(ws + WS_WIN) + (size_t)(1024 + 128 * g + 32 * jb) * D + k;
#pragma unroll
            for (int j = 0; j < 32; ++j) dst[(size_t)j * D] = (bf16_t)(pg8::cvt_pk_bf16(a[j] * gm, 0.f) & 0xffffu);
        }
    }
    for (int e8 = blockIdx.x * 512 + tid; e8 < 8 * 128 * 128 / 8; e8 += gridDim.x * 512) {
        const int e = e8 * 8, t = (e >> 7) & 127, s0 = e & 127;
        const f32x4 a = *(const f32x4*)(p.in[8] + e), b = *(const f32x4*)(p.in[8] + e + 4); f32x4 ma, mb;
#pragma unroll
        for (int j = 0; j < 4; ++j) { ma[j] = (s0 + j <= t) ? a[j] : 0.f; mb[j] = (s0 + 4 + j <= t) ? b[j] : 0.f; }
        *(u32x4*)((bf16_t*)(ws + WS_WM) + e) = pack8(ma, mb);
    }
    bf16_t* XB = (bf16_t*)(ws + WS_XB); float* ss = (float*)(ws + WS_SS);
    for (int m = gw; m < M; m += 2 * NGW) {
        const int m2 = m + NGW; const bool has2 = m2 < M;
        const f32x4* x0 = (const f32x4*)(p.in[0] + (size_t)m * D) + lane; const f32x4* x1 = (const f32x4*)(p.in[0] + (size_t)(has2 ? m2 : m) * D) + lane;
        f32x4 v0[4], v1[4];
#pragma unroll
        for (int j = 0; j < 4; ++j) { v0[j] = x0[64 * j]; v1[j] = x1[64 * j]; }
        float s0 = 0.f, s1 = 0.f;
#pragma unroll
        for (int j = 0; j < 4; ++j) { s0 += (v0[j][0] * v0[j][0] + v0[j][1] * v0[j][1]) + (v0[j][2] * v0[j][2] + v0[j][3] * v0[j][3]); s1 += (v1[j][0] * v1[j][0] + v1[j][1] * v1[j][1]) + (v1[j][2] * v1[j][2] + v1[j][3] * v1[j][3]); }
        s0 = wave_sum(s0); s1 = wave_sum(s1);
        u32x2* o0 = (u32x2*)(XB + (size_t)m * D) + lane; u32x2* o1 = (u32x2*)(XB + (size_t)m2 * D) + lane;
#pragma unroll
        for (int j = 0; j < 4; ++j) { u32x2 w; w.x = pg8::cvt_pk_bf16(v0[j][0], v0[j][1]); w.y = pg8::cvt_pk_bf16(v0[j][2], v0[j][3]); o0[64 * j] = w; }
        if (lane < 16) ss[(size_t)m * 16 + lane] = lane == 0 ? s0 : 0.f;
        if (has2) {
#pragma unroll
            for (int j = 0; j < 4; ++j) { u32x2 w; w.x = pg8::cvt_pk_bf16(v1[j][0], v1[j][1]); w.y = pg8::cvt_pk_bf16(v1[j][2], v1[j][3]); o1[64 * j] = w; }
            if (lane < 16) ss[(size_t)m2 * 16 + lane] = lane == 0 ? s1 : 0.f;
        }
    }
}

__device__ __forceinline__ void p4_mixer(const Params& p, LAS unsigned char* lds, int tid, int wave, int lane) {
    unsigned char* ws = p.ws;
    const bf16_t* U = (const bf16_t*)(ws + WS_U); const bf16_t* V = (const bf16_t*)(ws + WS_V); const bf16_t* Z = (const bf16_t*)(ws + WS_Z); bf16_t* Y = (bf16_t*)(ws + WS_Y);
    const bf16_t* Wm = (const bf16_t*)(ws + WS_WM); const float* bs = p.in[9]; const float* pscale = p.in[11]; const float* vgain = p.in[7];
    constexpr int P = 136;
    LAS bf16_t* Vt = (LAS bf16_t*)lds;
    const int fr = lane & 15, fq = lane >> 4;
    for (int chunk = blockIdx.x; chunk < M / 128; chunk += gridDim.x) {
        const size_t R0 = (size_t)chunk * 128;
        {
            const int s = tid & 127, cq0 = tid >> 7; const bf16_t* vrow = V + (R0 + s) * AW;
#pragma unroll 4
            for (int it = 0; it < 16; ++it) { const int cq = cq0 + 4 * it; const u32x4 v = *(const u32x4*)(vrow + 8 * cq); LAS bf16_t* d = Vt + (8 * cq) * P + s;
                d[0 * P] = (bf16_t)(v.x & 0xffffu); d[1 * P] = (bf16_t)(v.x >> 16); d[2 * P] = (bf16_t)(v.y & 0xffffu); d[3 * P] = (bf16_t)(v.y >> 16);
                d[4 * P] = (bf16_t)(v.z & 0xffffu); d[5 * P] = (bf16_t)(v.z >> 16); d[6 * P] = (bf16_t)(v.w & 0xffffu); d[7 * P] = (bf16_t)(v.w >> 16); }
        }
        __syncthreads();
        for (int i = 0; i < 8; ++i) {
            const int h = i, ts = (wave + i) & 7, t = 16 * ts + fr, nks = (ts >> 1) + 1;
            f32x4 acc[4];
#pragma unroll
            for (int nb = 0; nb < 4; ++nb) acc[nb] = (f32x4){0.f, 0.f, 0.f, 0.f};
            const bf16_t* wrow = Wm + (size_t)(h * 128 + t) * 128 + 8 * fq;
            for (int ks = 0; ks < nks; ++ks) {
                const bf16x8 wf = *(const bf16x8*)(wrow + 32 * ks);
#pragma unroll
                for (int nb = 0; nb < 4; ++nb) { const bf16x8 vf = *(const LAS bf16x8*)(Vt + (64 * h + 16 * nb + fr) * P + 32 * ks + 8 * fq);
                    acc[nb] = __builtin_amdgcn_mfma_f32_16x16x32_bf16(vf, wf, acc[nb], 0, 0, 0); }
            }
            const float bias = bs[h * 128 + t]; const size_t row = R0 + t;
#pragma unroll
            for (int nb = 0; nb < 4; ++nb) { const int col = 64 * h + 16 * nb + 4 * fq; const u32x2 uu = *(const u32x2*)(U + row * AW + col); const f32x4 gn = *(const f32x4*)(vgain + col);
                u32x2 w; w.x = pg8::cvt_pk_bf16(bf_lo(uu.x) * (acc[nb][0] * gn[0] + bias), bf_hi(uu.x) * (acc[nb][1] * gn[1] + bias)); w.y = pg8::cvt_pk_bf16(bf_lo(uu.y) * (acc[nb][2] * gn[2] + bias), bf_hi(uu.y) * (acc[nb][3] * gn[3] + bias));
                *(u32x2*)(Y + row * D + col) = w; }
        }
        {
            const int cq = tid & 127, rg = tid >> 7, win = 2 << (cq >> 5);
            const int p0 = (chunk & 31) * 128 + 32 * rg; const size_t Rb = R0 + 32 * rg;
            const bf16_t* zc = Z + 4 * cq; const f32x4 sc = *(const f32x4*)(pscale + 4 * cq);
            f32x4 s = (f32x4){0.f, 0.f, 0.f, 0.f};
            for (int w = 1; w < win; ++w) if (p0 - w >= 0) { const u32x2 zz = *(const u32x2*)(zc + (Rb - w) * AW); s += (f32x4){bf_lo(zz.x), bf_hi(zz.x), bf_lo(zz.y), bf_hi(zz.y)}; }
            for (int t = 0; t < 32; ++t) {
                const int pos = p0 + t; const u32x2 zz = *(const u32x2*)(zc + (Rb + t) * AW); const f32x4 zt = (f32x4){bf_lo(zz.x), bf_hi(zz.x), bf_lo(zz.y), bf_hi(zz.y)};
                s += zt; const int cnt = (pos + 1 < win) ? pos + 1 : win; const float inv = 1.0f / (float)cnt;
                const f32x4 o = (s * inv - zt) * sc;
                u32x2 w; w.x = pg8::cvt_pk_bf16(o[0], o[1]); w.y = pg8::cvt_pk_bf16(o[2], o[3]);
                *(u32x2*)(Y + (Rb + t) * D + 512 + 4 * cq) = w;
                if (pos - win + 1 >= 0) { const u32x2 zo = *(const u32x2*)(zc + (Rb + t - win + 1) * AW); s -= (f32x4){bf_lo(zo.x), bf_hi(zo.x), bf_lo(zo.y), bf_hi(zo.y)}; }
            }
        }
        __syncthreads();
    }
}

__device__ __forceinline__ void p8_final(const Params& p, int wave, int lane) {
    const float* ss = (const float*)(p.ws + WS_SS); const float* g = p.in[17];
    const int gw = blockIdx.x * 8 + wave, NGW = gridDim.x * 8;
    f32x4 gv[4];
#pragma unroll
    for (int j = 0; j < 4; ++j) gv[j] = ((const f32x4*)g)[lane + 64 * j];
    for (int m = gw; m < M; m += 2 * NGW) {
        const int m2 = (m + NGW < M) ? m + NGW : m;
        f32x4* x0 = (f32x4*)(p.out + (size_t)m * D) + lane; f32x4* x1 = (f32x4*)(p.out + (size_t)m2 * D) + lane;
        f32x4 v0[4], v1[4];
#pragma unroll
        for (int j = 0; j < 4; ++j) { v0[j] = x0[64 * j]; v1[j] = x1[64 * j]; }
        float s0 = ss[(size_t)m * 16 + (lane & 15)], s1 = ss[(size_t)m2 * 16 + (lane & 15)];
#pragma unroll
        for (int o = 1; o < 16; o <<= 1) { s0 += __shfl_xor(s0, o); s1 += __shfl_xor(s1, o); }
        const float r0 = __builtin_amdgcn_rsqf(s0 * (1.0f / 1024.0f) + EPS), r1 = __builtin_amdgcn_rsqf(s1 * (1.0f / 1024.0f) + EPS);
#pragma unroll
        for (int j = 0; j < 4; ++j) x0[64 * j] = v0[j] * r0 * gv[j];
        if (m2 != m) {
#pragma unroll
            for (int j = 0; j < 4; ++j) x1[64 * j] = v1[j] * r1 * gv[j];
        }
    }
}

__global__ void __launch_bounds__(512, 2) fwd(Params p) {
    extern __shared__ __attribute__((aligned(16))) unsigned char lds_raw[];
    LAS unsigned char* lds = (LAS unsigned char*)lds_raw;
    unsigned char* ws = p.ws;
    bf16_t* XB = (bf16_t*)(ws + WS_XB); bf16_t* ACT = (bf16_t*)(ws + WS_ACT); float* ss = (float*)(ws + WS_SS);
    const int G = gridDim.x, c = blockIdx.x;
    for (int ph = p.ph_lo; ph < p.ph_hi; ++ph) {
        int tid = threadIdx.x; asm volatile("" : "+v"(tid));
        const int lane = tid & 63, wave = __builtin_amdgcn_readfirstlane(tid >> 6);
        switch (ph) {
        case 0: if constexpr (PHM & 1) p0_prep(p, lds, tid, wave, lane); break;
        case 1: case 6: if constexpr (PHM & 2) {
            pg8::Gemm g{XB, (const bf16_t*)(ws + (ph == 1 ? WS_W1A : WS_W2A)), M, 2 * FF, D}; pg8::StaticOrder S; S.init(M, 2 * FF, G, c);
            EpiSwiglu E{ACT, ss};
            pg8::gemm_phase<EpiSwiglu, pg8::StaticOrder, true, true>(lds, g, S, E, tid);
        } break;
        case 2: case 7: if constexpr (PHM & 4) {
            pg8::Gemm g{ACT, (const bf16_t*)(ws + (ph == 2 ? WS_W1D : WS_W2D)), M, D, FF}; pg8::StaticOrder S; S.init(M, D, G, c);
            EpiRes E{ph == 2 ? p.in[0] : p.out, p.out, ph == 2 ? XB : nullptr, ss, 0.5f};
            pg8::gemm_phase<EpiRes, pg8::StaticOrder, true, true>(lds, g, S, E, tid);
        } break;
        case 3: if constexpr (PHM & 8) {
            pg8::Gemm g{XB, (const bf16_t*)(ws + WS_WIN), M, NIN, D}; pg8::StaticOrder S; S.init(M, NIN, G, c);
            EpiWin E{(bf16_t*)(ws + WS_U), (bf16_t*)(ws + WS_V), (bf16_t*)(ws + WS_Z), ss};
            pg8::gemm_phase<EpiWin, pg8::StaticOrder, true, true>(lds, g, S, E, tid);
        } break;
        case 4: if constexpr (PHM & 16) p4_mixer(p, lds, tid, wave, lane); break;
        case 5: if constexpr (PHM & 4) {
            pg8::Gemm g{(const bf16_t*)(ws + WS_Y), (const bf16_t*)(ws + WS_WOUT), M, D, D}; pg8::StaticOrder S; S.init(M, D, G, c);
            EpiRes E{p.out, p.out, XB, ss, 1.0f};
            pg8::gemm_phase<EpiRes, pg8::StaticOrder, true, true>(lds, g, S, E, tid);
        } break;
        default: if constexpr (PHM & 32) p8_final(p, wave, lane); break;
        }
        if (ph + 1 < p.ph_hi) cg::this_grid().sync();
    }
}
}

extern "C" void kernel_launch(void* const* d_in, const int* in_sizes, int n_in, void* d_out, int out_size, void* d_ws, size_t ws_size, hipStream_t stream) {
    static int grid = 0;
    if (grid == 0) {
        if (n_in != 18 || out_size != mk::M * mk::D || ws_size < mk::WS_END) { fprintf(stderr, "kernel_launch: unexpected shapes (n_in %d out %d ws %zu)\n", n_in, out_size, ws_size); grid = -1; return; }
        int dev = 0, cus = 0;
        if (hipGetDevice(&dev) != hipSuccess || hipDeviceGetAttribute(&cus, hipDeviceAttributeMultiprocessorCount, dev) != hipSuccess) { grid = -1; return; }
        if (hipFuncSetAttribute((const void*)mk::fwd, hipFuncAttributeMaxDynamicSharedMemorySize, mk::LDS_BYTES) != hipSuccess) { fprintf(stderr, "kernel_launch: hipFuncSetAttribute failed\n"); grid = -1; return; }
        grid = cus;
    }
    if (grid < 0) return;
    mk::Params p{};
    for (int i = 0; i < 18; ++i) p.in[i] = (const float*)d_in[i];
    p.out = (float*)d_out; p.ws = (unsigned char*)d_ws;
#if MK_LAUNCHES == 1
    p.ph_lo = 0; p.ph_hi = 9;
    void* args[] = {&p};
    hipError_t e = hipLaunchCooperativeKernel((const void*)mk::fwd, dim3(grid), dim3(512), args, mk::LDS_BYTES, stream);
    if (e != hipSuccess) fprintf(stderr, "cooperative launch failed: %s (grid %d)\n", hipGetErrorString(e), grid);
#else
    for (int ph = 0; ph < 9; ++ph) { p.ph_lo = ph; p.ph_hi = ph + 1; hipLaunchKernelGGL(mk::fwd, dim3(grid), dim3(512), mk::LDS_BYTES, stream, p); }
#endif
}
```

```cpp
#include <hip/hip_runtime.h>
#include <hip/hip_cooperative_groups.h>
#include <cstdio>
#include <cstdint>
namespace cg = cooperative_groups;
#ifndef PHM
#define PHM 0x1ff
#endif
#ifndef MK_LAUNCHES
#define MK_LAUNCHES 1
#endif
namespace pg8 {
#define PG8_LAS __attribute__((address_space(3)))
typedef unsigned short bf16_t;
typedef short bf16x8 __attribute__((ext_vector_type(8)));
typedef float f32x4 __attribute__((ext_vector_type(4)));
typedef unsigned u32x4 __attribute__((ext_vector_type(4)));
constexpr int BM = 256, BK = 64, HALF = 128, HTB = HALF * BK * 2  , STAGE_BYTES = 8 * HTB, NXCD = 8, WGM = 8;

__host__ __device__ __forceinline__ int lds_byte(int r, int c) { const int st = (r >> 4) * 2 + (c >> 5), rr = r & 15, cc = c & 31, ob = rr * 64 + cc * 2; return st * 1024 + (ob ^ (((ob >> 9) & 1) << 5)); }
__host__ __device__ __forceinline__ void stage_rc(int b, int& R, int& C) { const int st = b / 1024, sb = b % 1024, swz = sb ^ (((sb >> 9) & 1) << 5); R = (st >> 1) * 16 + swz / 64; C = (st & 1) * 32 + (swz % 64) / 2; }
__host__ __device__ __forceinline__ int perm32(int rho) { const int n = rho >> 4, i = rho & 15; return 8 * (i >> 2) + 4 * n + (i & 3); }

struct Unit { int pm, pn; };
struct Gemm { const bf16_t* A; const bf16_t* Bt; int M, N, K; };

struct StaticOrder {
    int nM, nN, nwg, G, c;
    __host__ __device__ void init(int M, int N, int G_, int c_) { nM = M / BM; nN = N / BM; nwg = nM * nN; G = G_; c = c_; }
    __host__ __device__ bool next(int i, Unit& u) const {
        const long L = (long)i * G + c; if (L >= nwg) return false;
        int wgid = (int)L; { const int q = nwg / NXCD, r = nwg % NXCD, xcd = wgid % NXCD, off = wgid / NXCD; wgid = (xcd < r ? xcd * (q + 1) : r * (q + 1) + (xcd - r) * q) + off; }
        const int nig = WGM * nN, gid = wgid / nig, fm = gid * WGM, gsz = (nM - fm) < WGM ? (nM - fm) : WGM;
        u.pm = fm + ((wgid % nig) % gsz); u.pn = (wgid % nig) / gsz; return true;
    }
    __device__ __forceinline__ void a_ready(const Unit&) const {}
    __device__ __forceinline__ void done(const Unit&) const {}
};
__device__ __forceinline__ unsigned cvt_pk_bf16(float lo, float hi) { unsigned r; asm volatile("v_cvt_pk_bf16_f32 %0, %1, %2" : "=v"(r) : "v"(lo), "v"(hi)); return r; }
template <class Epi, class Sched, bool ALIGN_EPI = false, bool SP2 = false>
__device__ __forceinline__ void gemm_phase(PG8_LAS unsigned char* lds, const Gemm g, const Sched& S, const Epi& E, const int tid) {
    const int wid = __builtin_amdgcn_readfirstlane(tid >> 6), lane = tid & 63, wr = wid >> 2, wc = wid & 3, fr = lane & 15, fq = lane >> 4;
    const int K = g.K, nt = K / BK;
    unsigned voffA[2], voffB[2];
#pragma unroll
    for (int i = 0; i < 2; ++i) { int R, C; stage_rc(tid * 16 + i * 8192, R, C); const int Rb = Epi::PERM ? ((R & ~31) + perm32(R & 31)) : R;
        voffA[i] = (unsigned)(R * K + C) * 2u; voffB[i] = (unsigned)(Rb * K + C) * 2u; }
    const size_t kstep = (size_t)(BK * 2);
    const size_t hstep = (size_t)HALF * K * 2;
    const size_t tstep = 2 * hstep;
    const unsigned ldsw = (unsigned)wid * 1024u;
    const int aoff = lds_byte(wr * 64 + fr, fq * 8), boff = lds_byte(wc * 32 + fr, fq * 8);
#define PG8_SA(b, h) (((b) * 2 + (h)) * HTB)
#define PG8_SB(b, h) ((4 + (b) * 2 + (h)) * HTB)
#define PG8_STAGE(bufoff, gbase, voff) do { _Pragma("unroll") for (int _i = 0; _i < 2; ++_i) \
        __builtin_amdgcn_global_load_lds((const unsigned*)((const char*)(gbase) + (voff)[_i]), (PG8_LAS unsigned*)(lds + (bufoff) + ldsw + _i * 8192), 16, 0, 0); } while (0)
#define PG8_LDA(dst, b, h) do { _Pragma("unroll") for (int m = 0; m < 4; ++m) _Pragma("unroll") for (int k = 0; k < 2; ++k) dst[m][k] = *(const PG8_LAS bf16x8*)(lds + PG8_SA(b, h) + aoff + m * 2048 + k * 1024); } while (0)
#define PG8_LDB(dst, b, h) do { _Pragma("unroll") for (int n = 0; n < 2; ++n) _Pragma("unroll") for (int k = 0; k < 2; ++k) dst[n][k] = *(const PG8_LAS bf16x8*)(lds + PG8_SB(b, h) + boff + n * 2048 + k * 1024); } while (0)
#define PG8_MMA(ai, bj, At, Bt) do { __builtin_amdgcn_s_setprio(1); _Pragma("unroll") for (int m = 0; m < 4; ++m) _Pragma("unroll") for (int n = 0; n < 2; ++n) _Pragma("unroll") for (int k = 0; k < 2; ++k) \
        acc[ai][bj][m][n] = __builtin_amdgcn_mfma_f32_16x16x32_bf16(Bt[n][k], At[m][k], acc[ai][bj][m][n], 0, 0, 0); __builtin_amdgcn_s_setprio(0); } while (0)
#define PG8_WAIT_V(n) asm volatile("s_waitcnt vmcnt(" #n ")" ::: "memory")
#define PG8_WAIT_L(n) asm volatile("s_waitcnt lgkmcnt(" #n ")" ::: "memory")
#define PG8_BAR __builtin_amdgcn_s_barrier()
#define PG8_SCHED __builtin_amdgcn_sched_barrier(0)
    Unit cur, nxt; int ui = 0;
    if (!S.next(0, cur)) return;
    f32x4 acc[2][2][4][2];
#pragma unroll
    for (int a = 0; a < 2; ++a)
#pragma unroll
        for (int b = 0; b < 2; ++b)
#pragma unroll
            for (int m = 0; m < 4; ++m)
#pragma unroll
                for (int n = 0; n < 2; ++n) acc[a][b][m][n] = (f32x4){0.f, 0.f, 0.f, 0.f};
    bf16x8 At[4][2], B0[2][2], B1[2][2];
    const char* cA = (const char*)g.A + (size_t)cur.pm * tstep; const char* cB = (const char*)g.Bt + (size_t)cur.pn * tstep;
    S.a_ready(cur);
    if constexpr (SP2) {
        PG8_STAGE(PG8_SB(0, 0), cB, voffB); PG8_STAGE(PG8_SB(0, 1), cB + hstep, voffB); PG8_STAGE(PG8_SA(0, 0), cA, voffA); PG8_STAGE(PG8_SA(0, 1), cA + hstep, voffA);
        if (wr == 1) PG8_BAR;
        PG8_WAIT_V(2); PG8_BAR;
        PG8_STAGE(PG8_SB(1, 0), cB + kstep, voffB); PG8_STAGE(PG8_SA(1, 0), cA + kstep, voffA); PG8_STAGE(PG8_SB(1, 1), cB + hstep + kstep, voffB);
        PG8_WAIT_V(6); PG8_BAR;
    } else {
        PG8_STAGE(PG8_SB(0, 0), cB, voffB); PG8_STAGE(PG8_SA(0, 0), cA, voffA); PG8_STAGE(PG8_SB(0, 1), cB + hstep, voffB); PG8_STAGE(PG8_SA(0, 1), cA + hstep, voffA);
        if (wr == 1) PG8_BAR;
        PG8_WAIT_V(4); PG8_BAR;
        PG8_STAGE(PG8_SB(1, 0), cB + kstep, voffB); PG8_STAGE(PG8_SA(1, 0), cA + kstep, voffA); PG8_STAGE(PG8_SB(1, 1), cB + hstep + kstep, voffB);
        PG8_WAIT_V(6); PG8_BAR;
    }
    for (;;) {
        const bool has_next = S.next(ui + 1, nxt);
        const char* nA = has_next ? (const char*)g.A + (size_t)nxt.pm * tstep : cA; const char* nB = has_next ? (const char*)g.Bt + (size_t)nxt.pn * tstep : cB;
        for (int t = 0; t < nt; t += 2) {
            const bool last = (t == nt - 2);
            const char* a1 = cA + (size_t)(t + 1) * kstep;
            const char* a2 = last ? nA : cA + (size_t)(t + 2) * kstep; const char* b2 = last ? nB : cB + (size_t)(t + 2) * kstep;
            const char* a3 = a2 + kstep; const char* b3 = b2 + kstep;
            if (last && has_next) S.a_ready(nxt);
            if constexpr (SP2) {
            PG8_LDB(B0, 0, 0); PG8_LDB(B1, 0, 1); PG8_SCHED; PG8_LDA(At, 0, 0); PG8_STAGE(PG8_SA(1, 1), a1 + hstep, voffA);
            PG8_WAIT_V(8); PG8_WAIT_L(0); PG8_BAR; PG8_MMA(0, 0, At, B0); PG8_MMA(0, 1, At, B1); PG8_BAR; PG8_SCHED;
            PG8_LDA(At, 0, 1); PG8_STAGE(PG8_SB(0, 0), b2, voffB); PG8_STAGE(PG8_SB(0, 1), b2 + hstep, voffB); PG8_STAGE(PG8_SA(0, 0), a2, voffA);
            PG8_WAIT_V(8); PG8_WAIT_L(0); PG8_BAR; PG8_MMA(1, 0, At, B0); PG8_MMA(1, 1, At, B1); PG8_BAR; PG8_SCHED;
            PG8_LDB(B0, 1, 0); PG8_LDB(B1, 1, 1); PG8_SCHED; PG8_LDA(At, 1, 0); PG8_STAGE(PG8_SA(0, 1), a2 + hstep, voffA);
            PG8_WAIT_V(8); PG8_WAIT_L(0); PG8_BAR; PG8_MMA(0, 0, At, B0); PG8_MMA(0, 1, At, B1); PG8_BAR; PG8_SCHED;
            PG8_LDA(At, 1, 1); PG8_STAGE(PG8_SB(1, 0), b3, voffB); PG8_STAGE(PG8_SB(1, 1), b3 + hstep, voffB); PG8_STAGE(PG8_SA(1, 0), a3, voffA);
            PG8_WAIT_V(8); PG8_WAIT_L(0); PG8_BAR; PG8_MMA(1, 0, At, B0); PG8_MMA(1, 1, At, B1); PG8_BAR; PG8_SCHED;
            } else {
            PG8_LDB(B0, 0, 0); PG8_SCHED; PG8_LDA(At, 0, 0); PG8_STAGE(PG8_SA(1, 1), a1 + hstep, voffA);
            PG8_WAIT_L(8); PG8_BAR; PG8_WAIT_L(0); PG8_MMA(0, 0, At, B0); PG8_BAR; PG8_SCHED;
            PG8_LDB(B1, 0, 1); PG8_STAGE(PG8_SB(0, 0), b2, voffB);
            PG8_BAR; PG8_WAIT_L(0); PG8_MMA(0, 1, At, B1); PG8_BAR;
            PG8_LDA(At, 0, 1); PG8_STAGE(PG8_SA(0, 0), a2, voffA);
            PG8_BAR; PG8_WAIT_L(0); PG8_MMA(1, 0, At, B0); PG8_BAR; PG8_SCHED;
            PG8_STAGE(PG8_SB(0, 1), b2 + hstep, voffB);
            PG8_WAIT_V(6); PG8_BAR; PG8_MMA(1, 1, At, B1); PG8_BAR;
            PG8_LDB(B0, 1, 0); PG8_SCHED; PG8_LDA(At, 1, 0); PG8_STAGE(PG8_SA(0, 1), a2 + hstep, voffA);
            PG8_WAIT_L(8); PG8_BAR; PG8_WAIT_L(0); PG8_MMA(0, 0, At, B0); PG8_BAR; PG8_SCHED;
            PG8_LDB(B1, 1, 1); PG8_STAGE(PG8_SB(1, 0), b3, voffB);
            PG8_BAR; PG8_WAIT_L(0); PG8_MMA(0, 1, At, B1); PG8_BAR;
            PG8_LDA(At, 1, 1); PG8_STAGE(PG8_SA(1, 0), a3, voffA);
            PG8_BAR; PG8_WAIT_L(0); PG8_MMA(1, 0, At, B0); PG8_BAR; PG8_SCHED;
            PG8_STAGE(PG8_SB(1, 1), b3 + hstep, voffB);
            PG8_WAIT_V(6); PG8_BAR; PG8_MMA(1, 1, At, B1); PG8_BAR;
            }
        }
        if constexpr (ALIGN_EPI) { if (wr == 0) PG8_BAR; }
        if constexpr (!Epi::AFTER_DRAIN) { E(acc, cur, wr, wc, fr, fq); S.done(cur); }
        if (!has_next) break;
#pragma unroll
        for (int a = 0; a < 2; ++a)
#pragma unroll
            for (int b = 0; b < 2; ++b)
#pragma unroll
                for (int m = 0; m < 4; ++m)
#pragma unroll
                    for (int n = 0; n < 2; ++n) acc[a][b][m][n] = (f32x4){0.f, 0.f, 0.f, 0.f};
        cur = nxt; cA = nA; cB = nB; ++ui;
        if constexpr (ALIGN_EPI) { if (wr == 1) PG8_BAR; }
    }
    PG8_WAIT_V(0);
    if constexpr (!ALIGN_EPI) { if (wr == 0) PG8_BAR; }
    PG8_BAR;
    if constexpr (Epi::AFTER_DRAIN) { E.fused(acc, cur, wr, wc, fr, fq, lds, wid, lane); S.done(cur); }
#undef PG8_SA
#undef PG8_SB
#undef PG8_STAGE
#undef PG8_LDA
#undef PG8_LDB
#undef PG8_MMA
#undef PG8_WAIT_V
#undef PG8_WAIT_L
#undef PG8_BAR
#undef PG8_SCHED
}
}

namespace mk {
using pg8::bf16_t; using pg8::f32x4; using pg8::u32x4; using pg8::bf16x8; using pg8::Unit;
#define LAS __attribute__((address_space(3)))
typedef unsigned u32x2 __attribute__((ext_vector_type(2)));
constexpr int M = 32768, D = 1024, FF = 2816, NIN = 1536, AW = 512, SEQ = 4096;
constexpr float EPS = 1e-6f;
constexpr int LDS_BYTES = 147456;
constexpr size_t MiB = 1u << 20;
constexpr size_t WS_W1A = 0 * MiB, WS_W1D = 11 * MiB, WS_W2A = 17 * MiB, WS_W2D = 28 * MiB, WS_WIN = 34 * MiB, WS_WOUT = 37 * MiB, WS_WM = 39 * MiB, WS_SS = 40 * MiB,
                 WS_XB = 42 * MiB, WS_ACT = 106 * MiB, WS_U = WS_ACT, WS_V = WS_ACT + 32 * MiB, WS_Z = WS_ACT + 64 * MiB, WS_Y = WS_ACT + 96 * MiB, WS_END = 282 * MiB;

__device__ __forceinline__ float silu_f(float g) { return g * __builtin_amdgcn_rcpf(1.0f + __builtin_amdgcn_exp2f(-1.4426950409f * g)); }
__device__ __forceinline__ float gelu_f(float v) { const float w = v + 0.044715f * v * v * v; return v * __builtin_amdgcn_rcpf(1.0f + __builtin_amdgcn_exp2f(-2.3022081981f * w)); }
__device__ __forceinline__ float bf_lo(unsigned w) { return __uint_as_float(w << 16); }
__device__ __forceinline__ float bf_hi(unsigned w) { return __uint_as_float(w & 0xffff0000u); }
__device__ __forceinline__ u32x4 pack8(const f32x4 a, const f32x4 b) { u32x4 w; w.x = pg8::cvt_pk_bf16(a[0], a[1]); w.y = pg8::cvt_pk_bf16(a[2], a[3]); w.z = pg8::cvt_pk_bf16(b[0], b[1]); w.w = pg8::cvt_pk_bf16(b[2], b[3]); return w; }
__device__ __forceinline__ float row_rstd(const float* ss, int row, int fq) {
    const f32x4 p = *(const f32x4*)(ss + (size_t)row * 16 + 4 * fq);
    float s = (p[0] + p[1]) + (p[2] + p[3]);
    s += __shfl_xor(s, 16); s += __shfl_xor(s, 32);
    return __builtin_amdgcn_rsqf(s * (1.0f / 1024.0f) + EPS);
}

struct EpiSwiglu {
    static constexpr bool PERM = true, AFTER_DRAIN = false;
    bf16_t* O; const float* ss;
    __device__ __forceinline__ void operator()(const f32x4 (&acc)[2][2][4][2], const Unit& u, int wr, int wc, int fr, int fq) const {
        const int row0 = u.pm * 256 + wr * 64 + fr, col0 = u.pn * 128 + wc * 32 + 8 * fq;
        float r[2][4];
#pragma unroll
        for (int ai = 0; ai < 2; ++ai)
#pragma unroll
            for (int m = 0; m < 4; ++m) r[ai][m] = row_rstd(ss, row0 + ai * 128 + m * 16, fq);
#pragma unroll
        for (int ai = 0; ai < 2; ++ai)
#pragma unroll
            for (int m = 0; m < 4; ++m) {
                const float rr = r[ai][m];
                f32x4 o0, o1;
#pragma unroll
                for (int e = 0; e < 4; ++e) { o0[e] = silu_f(acc[ai][0][m][0][e] * rr) * (acc[ai][1][m][0][e] * rr); o1[e] = silu_f(acc[ai][0][m][1][e] * rr) * (acc[ai][1][m][1][e] * rr); }
                *(u32x4*)(O + (size_t)(row0 + ai * 128 + m * 16) * FF + col0) = pack8(o0, o1);
            }
    }
};
struct EpiRes {
    static constexpr bool PERM = true, AFTER_DRAIN = false;
    const float* base; float* out; bf16_t* xb; float* ss; float alpha;
    __device__ __forceinline__ void operator()(const f32x4 (&acc)[2][2][4][2], const Unit& u, int wr, int wc, int fr, int fq) const {
        const unsigned off0 = (unsigned)(u.pm * 256 + wr * 64 + fr) * (unsigned)D + (unsigned)(u.pn * 256 + wc * 32 + 8 * fq);
        const unsigned sso = (unsigned)(u.pm * 256 + wr * 64 + fr) * 16u + (unsigned)(u.pn * 4 + wc);
#pragma unroll
        for (int ai = 0; ai < 2; ++ai)
#pragma unroll
            for (int m = 0; m < 4; ++m) {
                float sq = 0.f;
#pragma unroll
                for (int bj = 0; bj < 2; ++bj) {
                    const unsigned off = off0 + (unsigned)((ai * 128 + m * 16) * D + bj * 128);
                    const f32x4 b0 = *(const f32x4*)(base + off), b1 = *(const f32x4*)(base + off + 4);
                    const f32x4 v0 = b0 + acc[ai][bj][m][0] * alpha, v1 = b1 + acc[ai][bj][m][1] * alpha;
                    *(f32x4*)(out + off) = v0; *(f32x4*)(out + off + 4) = v1;
                    if (xb) *(u32x4*)(xb + off) = pack8(v0, v1);
                    sq += (v0[0] * v0[0] + v0[1] * v0[1]) + (v0[2] * v0[2] + v0[3] * v0[3]) + (v1[0] * v1[0] + v1[1] * v1[1]) + (v1[2] * v1[2] + v1[3] * v1[3]);
                }
                sq += __shfl_xor(sq, 16); sq += __shfl_xor(sq, 32);
                if (fq == 0) ss[sso + (unsigned)((ai * 128 + m * 16) * 16)] = sq;
                asm volatile("" ::: "memory");
            }
    }
};
struct EpiWin {
    static constexpr bool PERM = true, AFTER_DRAIN = false;
    bf16_t *U, *V, *Z; const float* ss;
    __device__ __forceinline__ void operator()(const f32x4 (&acc)[2][2][4][2], const Unit& u, int wr, int wc, int fr, int fq) const {
        const int row0 = u.pm * 256 + wr * 64 + fr;
        float r[2][4];
#pragma unroll
        for (int ai = 0; ai < 2; ++ai)
#pragma unroll
            for (int m = 0; m < 4; ++m) r[ai][m] = row_rstd(ss, row0 + ai * 128 + m * 16, fq);
        if (u.pn < 2) {
            const int col0 = u.pn * 256 + wc * 32 + 8 * fq;
#pragma unroll
            for (int ai = 0; ai < 2; ++ai)
#pragma unroll
                for (int m = 0; m < 4; ++m) { const float rr = r[ai][m]; bf16_t* rowp = U + (size_t)(row0 + ai * 128 + m * 16) * AW + col0;
#pragma unroll
                    for (int bj = 0; bj < 2; ++bj) { f32x4 o0, o1;
#pragma unroll
                        for (int e = 0; e < 4; ++e) { o0[e] = gelu_f(acc[ai][bj][m][0][e] * rr); o1[e] = gelu_f(acc[ai][bj][m][1][e] * rr); }
                        *(u32x4*)(rowp + bj * 128) = pack8(o0, o1); } }
        } else if (u.pn < 4) {
            const int colb = 64 * ((u.pn - 2) * 4 + wc) + 8 * fq;
#pragma unroll
            for (int ai = 0; ai < 2; ++ai)
#pragma unroll
                for (int m = 0; m < 4; ++m) { const float rr = r[ai][m]; f32x4 g[2][2]; float sq = 0.f;
#pragma unroll
                    for (int bj = 0; bj < 2; ++bj)
#pragma unroll
                        for (int n = 0; n < 2; ++n)
#pragma unroll
                            for (int e = 0; e < 4; ++e) { const float t = gelu_f(acc[ai][bj][m][n][e] * rr); g[bj][n][e] = t; sq += t * t; }
                    sq += __shfl_xor(sq, 16); sq += __shfl_xor(sq, 32);
                    const float hr = __builtin_amdgcn_rsqf(sq * (1.0f / 64.0f) + EPS);
                    bf16_t* rowp = V + (size_t)(row0 + ai * 128 + m * 16) * AW + colb;
#pragma unroll
                    for (int bj = 0; bj < 2; ++bj) *(u32x4*)(rowp + 32 * bj) = pack8(g[bj][0] * hr, g[bj][1] * hr); }
        } else {
            const int col0 = (u.pn - 4) * 256 + wc * 32 + 8 * fq;
#pragma unroll
            for (int ai = 0; ai < 2; ++ai)
#pragma unroll
                for (int m = 0; m < 4; ++m) { const float rr = r[ai][m]; bf16_t* rowp = Z + (size_t)(row0 + ai * 128 + m * 16) * AW + col0;
#pragma unroll
                    for (int bj = 0; bj < 2; ++bj) *(u32x4*)(rowp + bj * 128) = pack8(acc[ai][bj][m][0] * rr, acc[ai][bj][m][1] * rr); }
        }
    }
};

__device__ __forceinline__ float wave_sum(float v) {
#pragma unroll
    for (int o = 1; o < 64; o <<= 1) v += __shfl_xor(v, o);
    return v;
}
__device__ __forceinline__ void p0_transpose_item(const float* src, int ld, int Kd, int k0, int scol0, bf16_t* dst, int drow0, const float* gk, LAS float* scr, int lane) {
#pragma unroll 8
    for (int i = 0; i < 32; ++i) { const int kk = 2 * i + (lane >> 5); const float gsc = gk ? gk[k0 + kk] : 1.0f; scr[kk * 33 + (lane & 31)] = src[(size_t)(k0 + kk) * ld + scol0 + (lane & 31)] * gsc; }
    asm volatile("s_waitcnt lgkmcnt(0)" ::: "memory");
    const int c = lane & 7;
#pragma unroll
    for (int j = 0; j < 4; ++j) { const int n = (lane >> 3) + 8 * j; const LAS float* s = scr + (8 * c) * 33 + n;
        u32x4 o; o.x = pg8::cvt_pk_bf16(s[0 * 33], s[1 * 33]); o.y = pg8::cvt_pk_bf16(s[2 * 33], s[3 * 33]); o.z = pg8::cvt_pk_bf16(s[4 * 33], s[5 * 33]); o.w = pg8::cvt_pk_bf16(s[6 * 33], s[7 * 33]);
        *(u32x4*)(dst + (size_t)(drow0 + n) * Kd + k0 + 8 * c) = o; }
    asm volatile("s_waitcnt lgkmcnt(0)" ::: "memory");
}

struct Params { const float* in[18]; float* out; unsigned char* ws; int ph_lo, ph_hi; };

__device__ __forceinline__ void p0_prep(const Params& p, LAS unsigned char* lds, int tid, int wave, int lane) {
    unsigned char* ws = p.ws;
    LAS float* scr = (LAS float*)(lds + wave * 16384);
    const int gw = blockIdx.x * 8 + wave, NGW = gridDim.x * 8;
    constexpr int I_A = 16 * 176, I_D = 44 * 32, I_IN = 16 * 32, I_OUT = 16 * 32, I_ZP = 256;
    constexpr int NITEMS = 2 * (I_A + I_D) + I_IN + I_OUT + I_ZP;
    for (int it = gw; it < NITEMS; it += NGW) {
        int r = it;
        if (r < 2 * (I_A + I_D)) {
            const int l = r >= (I_A + I_D); if (l) r -= (I_A + I_D);
            const float* nrm = l ? p.in[13] : p.in[1]; const float* wg = l ? p.in[14] : p.in[2]; const float* wu = l ? p.in[15] : p.in[3]; const float* wd = l ? p.in[16] : p.in[4];
            bf16_t* dA = (bf16_t*)(ws + (l ? WS_W2A : WS_W1A)); bf16_t* dD = (bf16_t*)(ws + (l ? WS_W2D : WS_W1D));
            if (r < I_A) { const int kb = r / 176, rb = r % 176, pn = rb >> 3, bj = (rb >> 2) & 1, c0 = (rb & 3) * 32;
                p0_transpose_item(bj ? wu : wg, FF, D, 64 * kb, 128 * pn + c0, dA, 32 * rb, nrm, scr, lane); }
            else { r -= I_A; const int kb = r / 32, rb = r % 32; p0_transpose_item(wd, D, FF, 64 * kb, 32 * rb, dD, 32 * rb, nullptr, scr, lane); }
            continue;
        }
        r -= 2 * (I_A + I_D);
        if (r < I_IN) { const int kb = r / 32, rb = r % 32; int sc;
            if (rb < 16) sc = 32 * rb; else { const int q = rb - 16, pn = q >> 3, bj = (q >> 2) & 1, wc = q & 3; sc = 512 + 64 * (4 * pn + wc) + 32 * bj; }
            p0_transpose_item(p.in[6], NIN, D, 64 * kb, sc, (bf16_t*)(ws + WS_WIN), 32 * rb, p.in[5], scr, lane); continue; }
        r -= I_IN;
        if (r < I_OUT) { const int kb = r / 32, rb = r % 32; p0_transpose_item(p.in[12], D, D, 64 * kb, 32 * rb, (bf16_t*)(ws + WS_WOUT), 32 * rb, nullptr, scr, lane); continue; }
        r -= I_OUT;
        {
            const int g = r >> 6, kb = (r >> 2) & 15, jb = r & 3, k = 64 * kb + lane;
            const float* wrow = p.in[6] + (size_t)k * NIN + 1024 + 128 * g;
            const float* wp = p.in[10] + (size_t)g * 16384 + 32 * jb;
            float a[32];
#pragma unroll
            for (int j = 0; j < 32; ++j) a[j] = 0.f;
            for (int i4 = 0; i4 < 32; ++i4) { const f32x4 w4 = *(const f32x4*)(wrow + 4 * i4);
#pragma unroll
                for (int e = 0; e < 4; ++e) { const float* wpi = wp + (size_t)(4 * i4 + e) * 128;
#pragma unroll
                    for (int j = 0; j < 32; ++j) a[j] += w4[e] * wpi[j]; } }
            const float gm = p.in[5][k];
            bf16_t* dst = (bf16_t*)(ws + WS_WIN) + (size_t)(1024 + 128 * g + 32 * jb) * D + k;
#pragma unroll
            for (int j = 0; j < 32; ++j) dst[(size_t)j * D] = (bf16_t)(pg8::cvt_pk_bf16(a[j] * gm, 0.f) & 0xffffu);
        }
    }
    for (int e8 = blockIdx.x * 512 + tid; e8 < 8 * 128 * 128 / 8; e8 += gridDim.x * 512) {
        const int e = e8 * 8, t = (e >> 7) & 127, s0 = e & 127;
        const f32x4 a = *(const f32x4*)(p.in[8] + e), b = *(const f32x4*)(p.in[8] + e + 4); f32x4 ma, mb;
#pragma unroll
        for (int j = 0; j < 4; ++j) { ma[j] = (s0 + j <= t) ? a[j] : 0.f; mb[j] = (s0 + 4 + j <= t) ? b[j] : 0.f; }
        *(u32x4*)((bf16_t*)(ws + WS_WM) + e) = pack8(ma, mb);
    }
    bf16_t* XB = (bf16_t*)(ws + WS_XB); float* ss = (float*)(ws + WS_SS);
    for (int m = gw; m < M; m += 2 * NGW) {
        const int m2 = m + NGW; const bool has2 = m2 < M;
        const f32x4* x0 = (const f32x4*)(p.in[0] + (size_t)m * D) + lane; const f32x4* x1 = (const f32x4*)(p.in[0] + (size_t)(has2 ? m2 : m) * D) + lane;
        f32x4 v0[4], v1[4];
#pragma unroll
        for (int j = 0; j < 4; ++j) { v0[j] = x0[64 * j]; v1[j] = x1[64 * j]; }
        float s0 = 0.f, s1 = 0.f;
#pragma unroll
        for (int j = 0; j < 4; ++j) { s0 += (v0[j][0] * v0[j][0] + v0[j][1] * v0[j][1]) + (v0[j][2] * v0[j][2] + v0[j][3] * v0[j][3]); s1 += (v1[j][0] * v1[j][0] + v1[j][1] * v1[j][1]) + (v1[j][2] * v1[j][2] + v1[j][3] * v1[j][3]); }
        s0 = wave_sum(s0); s1 = wave_sum(s1);
        u32x2* o0 = (u32x2*)(XB + (size_t)m * D) + lane; u32x2* o1 = (u32x2*)(XB + (size_t)m2 * D) + lane;
#pragma unroll
        for (int j = 0; j < 4; ++j) { u32x2 w; w.x = pg8::cvt_pk_bf16(v0[j][0], v0[j][1]); w.y = pg8::cvt_pk_bf16(v0[j][2], v0[j][3]); o0[64 * j] = w; }
        if (lane < 16) ss[(size_t)m * 16 + lane] = lane == 0 ? s0 : 0.f;
        if (has2) {
#pragma unroll
            for (int j = 0; j < 4; ++j) { u32x2 w; w.x = pg8::cvt_pk_bf16(v1[j][0], v1[j][1]); w.y = pg8::cvt_pk_bf16(v1[j][2], v1[j][3]); o1[64 * j] = w; }
            if (lane < 16) ss[(size_t)m2 * 16 + lane] = lane == 0 ? s1 : 0.f;
        }
    }
}

__device__ __forceinline__ void p4_mixer(const Params& p, LAS unsigned char* lds, int tid, int wave, int lane) {
    unsigned char* ws = p.ws;
    const bf16_t* U = (const bf16_t*)(ws + WS_U); const bf16_t* V = (const bf16_t*)(ws + WS_V); const bf16_t* Z = (const bf16_t*)(ws + WS_Z); bf16_t* Y = (bf16_t*)(ws + WS_Y);
    const bf16_t* Wm = (const bf16_t*)(ws + WS_WM); const float* bs = p.in[9]; const float* pscale = p.in[11]; const float* vgain = p.in[7];
    constexpr int P = 136;
    LAS bf16_t* Vt = (LAS bf16_t*)lds;
    const int fr = lane & 15, fq = lane >> 4;
    for (int chunk = blockIdx.x; chunk < M / 128; chunk += gridDim.x) {
        const size_t R0 = (size_t)chunk * 128;
        {
            const int s = tid & 127, cq0 = tid >> 7; const bf16_t* vrow = V + (R0 + s) * AW;
#pragma unroll 4
            for (int it = 0; it < 16; ++it) { const int cq = cq0 + 4 * it; const u32x4 v = *(const u32x4*)(vrow + 8 * cq); LAS bf16_t* d = Vt + (8 * cq) * P + s;
                d[0 * P] = (bf16_t)(v.x & 0xffffu); d[1 * P] = (bf16_t)(v.x >> 16); d[2 * P] = (bf16_t)(v.y & 0xffffu); d[3 * P] = (bf16_t)(v.y >> 16);
                d[4 * P] = (bf16_t)(v.z & 0xffffu); d[5 * P] = (bf16_t)(v.z >> 16); d[6 * P] = (bf16_t)(v.w & 0xffffu); d[7 * P] = (bf16_t)(v.w >> 16); }
        }
        __syncthreads();
        for (int i = 0; i < 8; ++i) {
            const int h = i, ts = (wave + i) & 7, t = 16 * ts + fr, nks = (ts >> 1) + 1;
            f32x4 acc[4];
#pragma unroll
            for (int nb = 0; nb < 4; ++nb) acc[nb] = (f32x4){0.f, 0.f, 0.f, 0.f};
            const bf16_t* wrow = Wm + (size_t)(h * 128 + t) * 128 + 8 * fq;
            for (int ks = 0; ks < nks; ++ks) {
                const bf16x8 wf = *(const bf16x8*)(wrow + 32 * ks);
#pragma unroll
                for (int nb = 0; nb < 4; ++nb) { const bf16x8 vf = *(const LAS bf16x8*)(Vt + (64 * h + 16 * nb + fr) * P + 32 * ks + 8 * fq);
                    acc[nb] = __builtin_amdgcn_mfma_f32_16x16x32_bf16(vf, wf, acc[nb], 0, 0, 0); }
            }
            const float bias = bs[h * 128 + t]; const size_t row = R0 + t;
#pragma unroll
            for (int nb = 0; nb < 4; ++nb) { const int col = 64 * h + 16 * nb + 4 * fq; const u32x2 uu = *(const u32x2*)(U + row * AW + col); const f32x4 gn = *(const f32x4*)(vgain + col);
                u32x2 w; w.x = pg8::cvt_pk_bf16(bf_lo(uu.x) * (acc[nb][0] * gn[0] + bias), bf_hi(uu.x) * (acc[nb][1] * gn[1] + bias)); w.y = pg8::cvt_pk_bf16(bf_lo(uu.y) * (acc[nb][2] * gn[2] + bias), bf_hi(uu.y) * (acc[nb][3] * gn[3] + bias));
                *(u32x2*)(Y + row * D + col) = w; }
        }
        {
            const int cq = tid & 127, rg = tid >> 7, win = 2 << (cq >> 5);
            const int p0 = (chunk & 31) * 128 + 32 * rg; const size_t Rb = R0 + 32 * rg;
            const bf16_t* zc = Z + 4 * cq; const f32x4 sc = *(const f32x4*)(pscale + 4 * cq);
            f32x4 s = (f32x4){0.f, 0.f, 0.f, 0.f};
            for (int w = 1; w < win; ++w) if (p0 - w >= 0) { const u32x2 zz = *(const u32x2*)(zc + (Rb - w) * AW); s += (f32x4){bf_lo(zz.x), bf_hi(zz.x), bf_lo(zz.y), bf_hi(zz.y)}; }
            for (int t = 0; t < 32; ++t) {
                const int pos = p0 + t; const u32x2 zz = *(const u32x2*)(zc + (Rb + t) * AW); const f32x4 zt = (f32x4){bf_lo(zz.x), bf_hi(zz.x), bf_lo(zz.y), bf_hi(zz.y)};
                s += zt; const int cnt = (pos + 1 < win) ? pos + 1 : win; const float inv = 1.0f / (float)cnt;
                const f32x4 o = (s * inv - zt) * sc;
                u32x2 w; w.x = pg8::cvt_pk_bf16(o[0], o[1]); w.y = pg8::cvt_pk_bf16(o[2], o[3]);
                *(u32x2*)(Y + (Rb + t) * D + 512 + 4 * cq) = w;
                if (pos - win + 1 >= 0) { const u32x2 zo = *(const u32x2*)(zc + (Rb + t - win + 1) * AW); s -= (f32x4){bf_lo(zo.x), bf_hi(zo.x), bf_lo(zo.y), bf_hi(zo.y)}; }
            }
        }
        __syncthreads();
    }
}

__device__ __forceinline__ void p8_final(const Params& p, int wave, int lane) {
    const float* ss = (const float*)(p.ws + WS_SS); const float* g = p.in[17];
    const int gw = blockIdx.x * 8 + wave, NGW = gridDim.x * 8;
    f32x4 gv[4];
#pragma unroll
    for (int j = 0; j < 4; ++j) gv[j] = ((const f32x4*)g)[lane + 64 * j];
    for (int m = gw; m < M; m += 2 * NGW) {
        const int m2 = (m + NGW < M) ? m + NGW : m;
        f32x4* x0 = (f32x4*)(p.out + (size_t)m * D) + lane; f32x4* x1 = (f32x4*)(p.out + (size_t)m2 * D) + lane;
        f32x4 v0[4], v1[4];
#pragma unroll
        for (int j = 0; j < 4; ++j) { v0[j] = x0[64 * j]; v1[j] = x1[64 * j]; }
        float s0 = ss[(size_t)m * 16 + (lane & 15)], s1 = ss[(size_t)m2 * 16 + (lane & 15)];
#pragma unroll
        for (int o = 1; o < 16; o <<= 1) { s0 += __shfl_xor(s0, o); s1 += __shfl_xor(s1, o); }
        const float r0 = __builtin_amdgcn_rsqf(s0 * (1.0f / 1024.0f) + EPS), r1 = __builtin_amdgcn_rsqf(s1 * (1.0f / 1024.0f) + EPS);
#pragma unroll
        for (int j = 0; j < 4; ++j) x0[64 * j] = v0[j] * r0 * gv[j];
        if (m2 != m) {
#pragma unroll
            for (int j = 0; j < 4; ++j) x1[64 * j] = v1[j] * r1 * gv[j];
        }
    }
}

__global__ void __launch_bounds__(512, 2) fwd(Params p) {
    extern __shared__ __attribute__((aligned(16))) unsigned char lds_raw[];
    LAS unsigned char* lds = (LAS unsigned char*)lds_raw;
    unsigned char* ws = p.ws;
    bf16_t* XB = (bf16_t*)(ws + WS_XB); bf16_t* ACT = (bf16_t*)(ws + WS_ACT); float* ss = (float*)(ws + WS_SS);
    const int G = gridDim.x, c = blockIdx.x;
    for (int ph = p.ph_lo; ph < p.ph_hi; ++ph) {
        int tid = threadIdx.x; asm volatile("" : "+v"(tid));
        const int lane = tid & 63, wave = __builtin_amdgcn_readfirstlane(tid >> 6);
        switch (ph) {
        case 0: if constexpr (PHM & 1) p0_prep(p, lds, tid, wave, lane); break;
        case 1: case 6: if constexpr (PHM & 2) {
            pg8::Gemm g{XB, (const bf16_t*)(ws + (ph == 1 ? WS_W1A : WS_W2A)), M, 2 * FF, D}; pg8::StaticOrder S; S.init(M, 2 * FF, G, c);
            EpiSwiglu E{ACT, ss};
            pg8::gemm_phase<EpiSwiglu, pg8::StaticOrder, true, true>(lds, g, S, E, tid);
        } break;
        case 2: case 7: if constexpr (PHM & 4) {
            pg8::Gemm g{ACT, (const bf16_t*)(ws + (ph == 2 ? WS_W1D : WS_W2D)), M, D, FF}; pg8::StaticOrder S; S.init(M, D, G, c);
            EpiRes E{ph == 2 ? p.in[0] : p.out, p.out, ph == 2 ? XB : nullptr, ss, 0.5f};
            pg8::gemm_phase<EpiRes, pg8::StaticOrder, true, true>(lds, g, S, E, tid);
        } break;
        case 3: if constexpr (PHM & 8) {
            pg8::Gemm g{XB, (const bf16_t*)(ws + WS_WIN), M, NIN, D}; pg8::StaticOrder S; S.init(M, NIN, G, c);
            EpiWin E{(bf16_t*)(ws + WS_U), (bf16_t*)(ws + WS_V), (bf16_t*)(ws + WS_Z), ss};
            pg8::gemm_phase<EpiWin, pg8::StaticOrder, true, true>(lds, g, S, E, tid);
        } break;
        case 4: if constexpr (PHM & 16) p4_mixer(p, lds, tid, wave, lane); break;
        case 5: if constexpr (PHM & 4) {
            pg8::Gemm g{(const bf16_t*)(ws + WS_Y), (const bf16_t*)(ws + WS_WOUT), M, D, D}; pg8::StaticOrder S; S.init(M, D, G, c);
            EpiRes E{p.out, p.out, XB, ss, 1.0f};
            pg8::gemm_phase<EpiRes, pg8::StaticOrder, true, true>(lds, g, S, E, tid);
        } break;
        default: if constexpr (PHM & 32) p8_final(p, wave, lane); break;
        }
        if (ph + 1 < p.ph_hi) cg::this_grid().sync();
    }
}
}

extern "C" void kernel_launch(void* const* d_in, const int* in_sizes, int n_in, void* d_out, int out_size, void* d_ws, size_t ws_size, hipStream_t stream) {
    static int grid = 0;
    if (grid == 0) {
        if (n_in != 18 || out_size != mk::M * mk::D || ws_size < mk::WS_END) { fprintf(stderr, "kernel_launch: unexpected shapes (n_in %d out %d ws %zu)\n", n_in, out_size, ws_size); grid = -1; return; }
        int dev = 0, cus = 0;
        if (hipGetDevice(&dev) != hipSuccess || hipDeviceGetAttribute(&cus, hipDeviceAttributeMultiprocessorCount, dev) != hipSuccess) { grid = -1; return; }
        if (hipFuncSetAttribute((const void*)mk::fwd, hipFuncAttributeMaxDynamicSharedMemorySize, mk::LDS_BYTES) != hipSuccess) { fprintf(stderr, "kernel_launch: hipFuncSetAttribute failed\n"); grid = -1; return; }
        grid = cus;
    }
    if (grid < 0) return;
    mk::Params p{};
    for (int i = 0; i < 18; ++i) p.in[i] = (const float*)d_in[i];
    p.out = (float*)d_out; p.ws = (unsigned char*)d_ws;
#if MK_LAUNCHES == 1
    p.ph_lo = 0; p.ph_hi = 9;
    void* args[] = {&p};
    hipError_t e = hipLaunchCooperativeKernel((const void*)mk::fwd, dim3(grid), dim3(512), args, mk::LDS_BYTES, stream);
    if (e != hipSuccess) fprintf(stderr, "cooperative launch failed: %s (grid %d)\n", hipGetErrorString(e), grid);
#else
    for (int ph = 0; ph < 9; ++ph) { p.ph_lo = ph; p.ph_hi = ph + 1; hipLaunchKernelGGL(mk::fwd, dim3(grid), dim3(512), mk::LDS_BYTES, stream, p); }
#endif
}
```

```cpp
#include <hip/hip_runtime.h>
#include <hip/hip_cooperative_groups.h>
#include <cstdio>
#include <cstdint>
namespace cg = cooperative_groups;
#ifndef PHM
#define PHM 0x1ff
#endif
#ifndef PROBE_REP
#define PROBE_REP -1
#endif
#ifndef MK_LAUNCHES
#define MK_LAUNCHES 1
#endif
namespace pg8 {
#define PG8_LAS __attribute__((address_space(3)))
typedef unsigned short bf16_t;
typedef short bf16x8 __attribute__((ext_vector_type(8)));
typedef float f32x4 __attribute__((ext_vector_type(4)));
typedef unsigned u32x4 __attribute__((ext_vector_type(4)));
constexpr int BM = 256, BK = 64, HALF = 128, HTB = HALF * BK * 2  , STAGE_BYTES = 8 * HTB, NXCD = 8, WGM = 8;

__host__ __device__ __forceinline__ int lds_byte(int r, int c) { const int st = (r >> 4) * 2 + (c >> 5), rr = r & 15, cc = c & 31, ob = rr * 64 + cc * 2; return st * 1024 + (ob ^ (((ob >> 9) & 1) << 5)); }
__host__ __device__ __forceinline__ void stage_rc(int b, int& R, int& C) { const int st = b / 1024, sb = b % 1024, swz = sb ^ (((sb >> 9) & 1) << 5); R = (st >> 1) * 16 + swz / 64; C = (st & 1) * 32 + (swz % 64) / 2; }
__host__ __device__ __forceinline__ int perm32(int rho) { const int n = rho >> 4, i = rho & 15; return 8 * (i >> 2) + 4 * n + (i & 3); }

struct Unit { int pm, pn; };
struct Gemm { const bf16_t* A; const bf16_t* Bt; int M, N, K; };

struct StaticOrder {
    int nM, nN, nwg, G, c;
    __host__ __device__ void init(int M, int N, int G_, int c_) { nM = M / BM; nN = N / BM; nwg = nM * nN; G = G_; c = c_; }
    __host__ __device__ bool next(int i, Unit& u) const {
        const long L = (long)i * G + c; if (L >= nwg) return false;
        int wgid = (int)L; { const int q = nwg / NXCD, r = nwg % NXCD, xcd = wgid % NXCD, off = wgid / NXCD; wgid = (xcd < r ? xcd * (q + 1) : r * (q + 1) + (xcd - r) * q) + off; }
        const int nig = WGM * nN, gid = wgid / nig, fm = gid * WGM, gsz = (nM - fm) < WGM ? (nM - fm) : WGM;
        u.pm = fm + ((wgid % nig) % gsz); u.pn = (wgid % nig) / gsz; return true;
    }
    __device__ __forceinline__ void a_ready(const Unit&) const {}
    __device__ __forceinline__ void done(const Unit&) const {}
};
__device__ __forceinline__ unsigned cvt_pk_bf16(float lo, float hi) { unsigned r; asm volatile("v_cvt_pk_bf16_f32 %0, %1, %2" : "=v"(r) : "v"(lo), "v"(hi)); return r; }
template <class Epi, class Sched, bool ALIGN_EPI = false, bool SP2 = false>
__device__ __forceinline__ void gemm_phase(PG8_LAS unsigned char* lds, const Gemm g, const Sched& S, const Epi& E, const int tid) {
    const int wid = __builtin_amdgcn_readfirstlane(tid >> 6), lane = tid & 63, wr = wid >> 2, wc = wid & 3, fr = lane & 15, fq = lane >> 4;
    const int K = g.K, nt = K / BK;
    unsigned voffA[2], voffB[2];
#pragma unroll
    for (int i = 0; i < 2; ++i) { int R, C; stage_rc(tid * 16 + i * 8192, R, C); const int Rb = Epi::PERM ? ((R & ~31) + perm32(R & 31)) : R;
        voffA[i] = (unsigned)(R * K + C) * 2u; voffB[i] = (unsigned)(Rb * K + C) * 2u; }
    const size_t kstep = (size_t)(BK * 2);
    const size_t hstep = (size_t)HALF * K * 2;
    const size_t tstep = 2 * hstep;
    const unsigned ldsw = (unsigned)wid * 1024u;
    const int aoff = lds_byte(wr * 64 + fr, fq * 8), boff = lds_byte(wc * 32 + fr, fq * 8);
#define PG8_SA(b, h) (((b) * 2 + (h)) * HTB)
#define PG8_SB(b, h) ((4 + (b) * 2 + (h)) * HTB)
#define PG8_STAGE(bufoff, gbase, voff) do { _Pragma("unroll") for (int _i = 0; _i < 2; ++_i) \
        __builtin_amdgcn_global_load_lds((const unsigned*)((const char*)(gbase) + (voff)[_i]), (PG8_LAS unsigned*)(lds + (bufoff) + ldsw + _i * 8192), 16, 0, 0); } while (0)
#define PG8_LDA(dst, b, h) do { _Pragma("unroll") for (int m = 0; m < 4; ++m) _Pragma("unroll") for (int k = 0; k < 2; ++k) dst[m][k] = *(const PG8_LAS bf16x8*)(lds + PG8_SA(b, h) + aoff + m * 2048 + k * 1024); } while (0)
#define PG8_LDB(dst, b, h) do { _Pragma("unroll") for (int n = 0; n < 2; ++n) _Pragma("unroll") for (int k = 0; k < 2; ++k) dst[n][k] = *(const PG8_LAS bf16x8*)(lds + PG8_SB(b, h) + boff + n * 2048 + k * 1024); } while (0)
#define PG8_MMA(ai, bj, At, Bt) do { __builtin_amdgcn_s_setprio(1); _Pragma("unroll") for (int m = 0; m < 4; ++m) _Pragma("unroll") for (int n = 0; n < 2; ++n) _Pragma("unroll") for (int k = 0; k < 2; ++k) \
        acc[ai][bj][m][n] = __builtin_amdgcn_mfma_f32_16x16x32_bf16(Bt[n][k], At[m][k], acc[ai][bj][m][n], 0, 0, 0); __builtin_amdgcn_s_setprio(0); } while (0)
#define PG8_WAIT_V(n) asm volatile("s_waitcnt vmcnt(" #n ")" ::: "memory")
#define PG8_WAIT_L(n) asm volatile("s_waitcnt lgkmcnt(" #n ")" ::: "memory")
#define PG8_BAR __builtin_amdgcn_s_barrier()
#define PG8_SCHED __builtin_amdgcn_sched_barrier(0)
    Unit cur, nxt; int ui = 0;
    if (!S.next(0, cur)) return;
    f32x4 acc[2][2][4][2];
#pragma unroll
    for (int a = 0; a < 2; ++a)
#pragma unroll
        for (int b = 0; b < 2; ++b)
#pragma unroll
            for (int m = 0; m < 4; ++m)
#pragma unroll
                for (int n = 0; n < 2; ++n) acc[a][b][m][n] = (f32x4){0.f, 0.f, 0.f, 0.f};
    bf16x8 At[4][2], B0[2][2], B1[2][2];
    const char* cA = (const char*)g.A + (size_t)cur.pm * tstep; const char* cB = (const char*)g.Bt + (size_t)cur.pn * tstep;
    S.a_ready(cur);
    if constexpr (SP2) {
        PG8_STAGE(PG8_SB(0, 0), cB, voffB); PG8_STAGE(PG8_SB(0, 1), cB + hstep, voffB); PG8_STAGE(PG8_SA(0, 0), cA, voffA); PG8_STAGE(PG8_SA(0, 1), cA + hstep, voffA);
        if (wr == 1) PG8_BAR;
        PG8_WAIT_V(2); PG8_BAR;
        PG8_STAGE(PG8_SB(1, 0), cB + kstep, voffB); PG8_STAGE(PG8_SA(1, 0), cA + kstep, voffA); PG8_STAGE(PG8_SB(1, 1), cB + hstep + kstep, voffB);
        PG8_WAIT_V(6); PG8_BAR;
    } else {
        PG8_STAGE(PG8_SB(0, 0), cB, voffB); PG8_STAGE(PG8_SA(0, 0), cA, voffA); PG8_STAGE(PG8_SB(0, 1), cB + hstep, voffB); PG8_STAGE(PG8_SA(0, 1), cA + hstep, voffA);
        if (wr == 1) PG8_BAR;
        PG8_WAIT_V(4); PG8_BAR;
        PG8_STAGE(PG8_SB(1, 0), cB + kstep, voffB); PG8_STAGE(PG8_SA(1, 0), cA + kstep, voffA); PG8_STAGE(PG8_SB(1, 1), cB + hstep + kstep, voffB);
        PG8_WAIT_V(6); PG8_BAR;
    }
    for (;;) {
        const bool has_next = S.next(ui + 1, nxt);
        const char* nA = has_next ? (const char*)g.A + (size_t)nxt.pm * tstep : cA; const char* nB = has_next ? (const char*)g.Bt + (size_t)nxt.pn * tstep : cB;
        for (int t = 0; t < nt; t += 2) {
            const bool last = (t == nt - 2);
            const char* a1 = cA + (size_t)(t + 1) * kstep;
            const char* a2 = last ? nA : cA + (size_t)(t + 2) * kstep; const char* b2 = last ? nB : cB + (size_t)(t + 2) * kstep;
            const char* a3 = a2 + kstep; const char* b3 = b2 + kstep;
            if (last && has_next) S.a_ready(nxt);
            if constexpr (SP2) {
            PG8_LDB(B0, 0, 0); PG8_LDB(B1, 0, 1); PG8_SCHED; PG8_LDA(At, 0, 0); PG8_STAGE(PG8_SA(1, 1), a1 + hstep, voffA);
            PG8_WAIT_V(8); PG8_WAIT_L(0); PG8_BAR; PG8_MMA(0, 0, At, B0); PG8_MMA(0, 1, At, B1); PG8_BAR; PG8_SCHED;
            PG8_LDA(At, 0, 1); PG8_STAGE(PG8_SB(0, 0), b2, voffB); PG8_STAGE(PG8_SB(0, 1), b2 + hstep, voffB); PG8_STAGE(PG8_SA(0, 0), a2, voffA);
            PG8_WAIT_V(8); PG8_WAIT_L(0); PG8_BAR; PG8_MMA(1, 0, At, B0); PG8_MMA(1, 1, At, B1); PG8_BAR; PG8_SCHED;
            PG8_LDB(B0, 1, 0); PG8_LDB(B1, 1, 1); PG8_SCHED; PG8_LDA(At, 1, 0); PG8_STAGE(PG8_SA(0, 1), a2 + hstep, voffA);
            PG8_WAIT_V(8); PG8_WAIT_L(0); PG8_BAR; PG8_MMA(0, 0, At, B0); PG8_MMA(0, 1, At, B1); PG8_BAR; PG8_SCHED;
            PG8_LDA(At, 1, 1); PG8_STAGE(PG8_SB(1, 0), b3, voffB); PG8_STAGE(PG8_SB(1, 1), b3 + hstep, voffB); PG8_STAGE(PG8_SA(1, 0), a3, voffA);
            PG8_WAIT_V(8); PG8_WAIT_L(0); PG8_BAR; PG8_MMA(1, 0, At, B0); PG8_MMA(1, 1, At, B1); PG8_BAR; PG8_SCHED;
            } else {
            PG8_LDB(B0, 0, 0); PG8_SCHED; PG8_LDA(At, 0, 0); PG8_STAGE(PG8_SA(1, 1), a1 + hstep, voffA);
            PG8_WAIT_L(8); PG8_BAR; PG8_WAIT_L(0); PG8_MMA(0, 0, At, B0); PG8_BAR; PG8_SCHED;
            PG8_LDB(B1, 0, 1); PG8_STAGE(PG8_SB(0, 0), b2, voffB);
            PG8_BAR; PG8_WAIT_L(0); PG8_MMA(0, 1, At, B1); PG8_BAR;
            PG8_LDA(At, 0, 1); PG8_STAGE(PG8_SA(0, 0), a2, voffA);
            PG8_BAR; PG8_WAIT_L(0); PG8_MMA(1, 0, At, B0); PG8_BAR; PG8_SCHED;
            PG8_STAGE(PG8_SB(0, 1), b2 + hstep, voffB);
            PG8_WAIT_V(6); PG8_BAR; PG8_MMA(1, 1, At, B1); PG8_BAR;
            PG8_LDB(B0, 1, 0); PG8_SCHED; PG8_LDA(At, 1, 0); PG8_STAGE(PG8_SA(0, 1), a2 + hstep, voffA);
            PG8_WAIT_L(8); PG8_BAR; PG8_WAIT_L(0); PG8_MMA(0, 0, At, B0); PG8_BAR; PG8_SCHED;
            PG8_LDB(B1, 1, 1); PG8_STAGE(PG8_SB(1, 0), b3, voffB);
            PG8_BAR; PG8_WAIT_L(0); PG8_MMA(0, 1, At, B1); PG8_BAR;
            PG8_LDA(At, 1, 1); PG8_STAGE(PG8_SA(1, 0), a3, voffA);
            PG8_BAR; PG8_WAIT_L(0); PG8_MMA(1, 0, At, B0); PG8_BAR; PG8_SCHED;
            PG8_STAGE(PG8_SB(1, 1), b3 + hstep, voffB);
            PG8_WAIT_V(6); PG8_BAR; PG8_MMA(1, 1, At, B1); PG8_BAR;
            }
        }
        if constexpr (ALIGN_EPI) { if (wr == 0) PG8_BAR; }
        if constexpr (!Epi::AFTER_DRAIN) { E(acc, cur, wr, wc, fr, fq); S.done(cur); }
        if (!has_next) break;
#pragma unroll
        for (int a = 0; a < 2; ++a)
#pragma unroll
            for (int b = 0; b < 2; ++b)
#pragma unroll
                for (int m = 0; m < 4; ++m)
#pragma unroll
                    for (int n = 0; n < 2; ++n) acc[a][b][m][n] = (f32x4){0.f, 0.f, 0.f, 0.f};
        cur = nxt; cA = nA; cB = nB; ++ui;
        if constexpr (ALIGN_EPI) { if (wr == 1) PG8_BAR; }
    }
    PG8_WAIT_V(0);
    if constexpr (!ALIGN_EPI) { if (wr == 0) PG8_BAR; }
    PG8_BAR;
    if constexpr (Epi::AFTER_DRAIN) { E.fused(acc, cur, wr, wc, fr, fq, lds, wid, lane); S.done(cur); }
#undef PG8_SA
#undef PG8_SB
#undef PG8_STAGE
#undef PG8_LDA
#undef PG8_LDB
#undef PG8_MMA
#undef PG8_WAIT_V
#undef PG8_WAIT_L
#undef PG8_BAR
#undef PG8_SCHED
}
}

namespace mk {
using pg8::bf16_t; using pg8::f32x4; using pg8::u32x4; using pg8::bf16x8; using pg8::Unit;
#define LAS __attribute__((address_space(3)))
typedef unsigned u32x2 __attribute__((ext_vector_type(2)));
constexpr int M = 32768, D = 1024, FF = 2816, NIN = 1536, AW = 512, SEQ = 4096;
constexpr float EPS = 1e-6f;
constexpr int LDS_BYTES = 147456;
constexpr size_t MiB = 1u << 20;
constexpr size_t WS_W1A = 0 * MiB, WS_W1D = 11 * MiB, WS_W2A = 17 * MiB, WS_W2D = 28 * MiB, WS_WIN = 34 * MiB, WS_WOUT = 37 * MiB, WS_WM = 39 * MiB, WS_SS = 40 * MiB,
                 WS_XB = 42 * MiB, WS_ACT = 106 * MiB, WS_U = WS_ACT, WS_V = WS_ACT + 32 * MiB, WS_Z = WS_ACT + 64 * MiB, WS_Y = WS_ACT + 96 * MiB, WS_END = 282 * MiB;

__device__ __forceinline__ float silu_f(float g) { return g * __builtin_amdgcn_rcpf(1.0f + __builtin_amdgcn_exp2f(-1.4426950409f * g)); }
__device__ __forceinline__ float gelu_f(float v) { const float w = v + 0.044715f * v * v * v; return v * __builtin_amdgcn_rcpf(1.0f + __builtin_amdgcn_exp2f(-2.3022081981f * w)); }
__device__ __forceinline__ float bf_lo(unsigned w) { return __uint_as_float(w << 16); }
__device__ __forceinline__ float bf_hi(unsigned w) { return __uint_as_float(w & 0xffff0000u); }
__device__ __forceinline__ u32x4 pack8(const f32x4 a, const f32x4 b) { u32x4 w; w.x = pg8::cvt_pk_bf16(a[0], a[1]); w.y = pg8::cvt_pk_bf16(a[2], a[3]); w.z = pg8::cvt_pk_bf16(b[0], b[1]); w.w = pg8::cvt_pk_bf16(b[2], b[3]); return w; }
__device__ __forceinline__ float row_rstd(const float* ss, int row) { return __builtin_amdgcn_rsqf(ss[row] * (1.0f / 1024.0f) + EPS); }
constexpr size_t SS_STRIDE = 32768;

struct EpiSwiglu {
    static constexpr bool PERM = true, AFTER_DRAIN = false;
    bf16_t* O; const float* ss;
    __device__ __forceinline__ void operator()(const f32x4 (&acc)[2][2][4][2], const Unit& u, int wr, int wc, int fr, int fq) const {
        const int row0 = u.pm * 256 + wr * 64 + fr, col0 = u.pn * 128 + wc * 32 + 8 * fq;
        float r[2][4];
#pragma unroll
        for (int ai = 0; ai < 2; ++ai)
#pragma unroll
            for (int m = 0; m < 4; ++m) r[ai][m] = row_rstd(ss, row0 + ai * 128 + m * 16);
#pragma unroll
        for (int ai = 0; ai < 2; ++ai)
#pragma unroll
            for (int m = 0; m < 4; ++m) {
                const float rr = r[ai][m];
                f32x4 o0, o1;
#pragma unroll
                for (int e = 0; e < 4; ++e) { o0[e] = silu_f(acc[ai][0][m][0][e] * rr) * (acc[ai][1][m][0][e] * rr); o1[e] = silu_f(acc[ai][0][m][1][e] * rr) * (acc[ai][1][m][1][e] * rr); }
                *(u32x4*)(O + (size_t)(row0 + ai * 128 + m * 16) * FF + col0) = pack8(o0, o1);
            }
    }
};
struct EpiRes {
    static constexpr bool PERM = true, AFTER_DRAIN = false;
    const float* base; float* out; bf16_t* xb; float* ss; float alpha;
    __device__ __forceinline__ void operator()(const f32x4 (&acc)[2][2][4][2], const Unit& u, int wr, int wc, int fr, int fq) const {
        const unsigned off0 = (unsigned)(u.pm * 256 + wr * 64 + fr) * (unsigned)D + (unsigned)(u.pn * 256 + wc * 32 + 8 * fq);
        const unsigned sso = (unsigned)(u.pm * 256 + wr * 64 + fr);
#pragma unroll
        for (int ai = 0; ai < 2; ++ai)
#pragma unroll
            for (int m = 0; m < 4; ++m) {
                float sq = 0.f;
#pragma unroll
                for (int bj = 0; bj < 2; ++bj) {
                    const unsigned off = off0 + (unsigned)((ai * 128 + m * 16) * D + bj * 128);
                    const f32x4 b0 = *(const f32x4*)(base + off), b1 = *(const f32x4*)(base + off + 4);
                    const f32x4 v0 = b0 + acc[ai][bj][m][0] * alpha, v1 = b1 + acc[ai][bj][m][1] * alpha;
                    *(f32x4*)(out + off) = v0; *(f32x4*)(out + off + 4) = v1;
                    if (xb) *(u32x4*)(xb + off) = pack8(v0, v1);
                    sq += (v0[0] * v0[0] + v0[1] * v0[1]) + (v0[2] * v0[2] + v0[3] * v0[3]) + (v1[0] * v1[0] + v1[1] * v1[1]) + (v1[2] * v1[2] + v1[3] * v1[3]);
                }
                sq += __shfl_xor(sq, 16); sq += __shfl_xor(sq, 32);
                if (fq == 0) __hip_atomic_fetch_add(ss + sso + (unsigned)(ai * 128 + m * 16), sq, __ATOMIC_RELAXED, __HIP_MEMORY_SCOPE_AGENT);
                asm volatile("" ::: "memory");
            }
    }
};
struct EpiWin {
    static constexpr bool PERM = true, AFTER_DRAIN = false;
    bf16_t *U, *V, *Z; const float* ss;
    __device__ __forceinline__ void operator()(const f32x4 (&acc)[2][2][4][2], const Unit& u, int wr, int wc, int fr, int fq) const {
        const int row0 = u.pm * 256 + wr * 64 + fr;
        float r[2][4];
#pragma unroll
        for (int ai = 0; ai < 2; ++ai)
#pragma unroll
            for (int m = 0; m < 4; ++m) r[ai][m] = row_rstd(ss, row0 + ai * 128 + m * 16);
        if (u.pn < 2) {
            const int col0 = u.pn * 256 + wc * 32 + 8 * fq;
#pragma unroll
            for (int ai = 0; ai < 2; ++ai)
#pragma unroll
                for (int m = 0; m < 4; ++m) { const float rr = r[ai][m]; bf16_t* rowp = U + (size_t)(row0 + ai * 128 + m * 16) * AW + col0;
#pragma unroll
                    for (int bj = 0; bj < 2; ++bj) { f32x4 o0, o1;
#pragma unroll
                        for (int e = 0; e < 4; ++e) { o0[e] = gelu_f(acc[ai][bj][m][0][e] * rr); o1[e] = gelu_f(acc[ai][bj][m][1][e] * rr); }
                        *(u32x4*)(rowp + bj * 128) = pack8(o0, o1); } }
        } else if (u.pn < 4) {
            const int colb = 64 * ((u.pn - 2) * 4 + wc) + 8 * fq;
#pragma unroll
            for (int ai = 0; ai < 2; ++ai)
#pragma unroll
                for (int m = 0; m < 4; ++m) { const float rr = r[ai][m]; f32x4 g[2][2]; float sq = 0.f;
#pragma unroll
                    for (int bj = 0; bj < 2; ++bj)
#pragma unroll
                        for (int n = 0; n < 2; ++n)
#pragma unroll
                            for (int e = 0; e < 4; ++e) { const float t = gelu_f(acc[ai][bj][m][n][e] * rr); g[bj][n][e] = t; sq += t * t; }
                    sq += __shfl_xor(sq, 16); sq += __shfl_xor(sq, 32);
                    const float hr = __builtin_amdgcn_rsqf(sq * (1.0f / 64.0f) + EPS);
                    bf16_t* rowp = V + (size_t)(row0 + ai * 128 + m * 16) * AW + colb;
#pragma unroll
                    for (int bj = 0; bj < 2; ++bj) *(u32x4*)(rowp + 32 * bj) = pack8(g[bj][0] * hr, g[bj][1] * hr); }
        } else {
            const int col0 = (u.pn - 4) * 256 + wc * 32 + 8 * fq;
#pragma unroll
            for (int ai = 0; ai < 2; ++ai)
#pragma unroll
                for (int m = 0; m < 4; ++m) { const float rr = r[ai][m]; bf16_t* rowp = Z + (size_t)(row0 + ai * 128 + m * 16) * AW + col0;
#pragma unroll
                    for (int bj = 0; bj < 2; ++bj) *(u32x4*)(rowp + bj * 128) = pack8(acc[ai][bj][m][0] * rr, acc[ai][bj][m][1] * rr); }
        }
    }
};

__device__ __forceinline__ float wave_sum(float v) {
#pragma unroll
    for (int o = 1; o < 64; o <<= 1) v += __shfl_xor(v, o);
    return v;
}
__device__ __forceinline__ void p0_transpose_item(const float* src, int ld, int Kd, int k0, int scol0, bf16_t* dst, int drow0, const float* gk, LAS float* scr, int lane) {
    float tv[32];
#pragma unroll
    for (int i = 0; i < 32; ++i) { const int kk = 2 * i + (lane >> 5); tv[i] = src[(size_t)(k0 + kk) * ld + scol0 + (lane & 31)]; }
    if (gk) {
#pragma unroll
        for (int i = 0; i < 32; ++i) tv[i] *= gk[k0 + 2 * i + (lane >> 5)];
    }
#pragma unroll
    for (int i = 0; i < 32; ++i) scr[(2 * i + (lane >> 5)) * 33 + (lane & 31)] = tv[i];
    asm volatile("s_waitcnt lgkmcnt(0)" ::: "memory");
    const int c = lane & 7;
#pragma unroll
    for (int j = 0; j < 4; ++j) { const int n = (lane >> 3) + 8 * j; const LAS float* s = scr + (8 * c) * 33 + n;
        u32x4 o; o.x = pg8::cvt_pk_bf16(s[0 * 33], s[1 * 33]); o.y = pg8::cvt_pk_bf16(s[2 * 33], s[3 * 33]); o.z = pg8::cvt_pk_bf16(s[4 * 33], s[5 * 33]); o.w = pg8::cvt_pk_bf16(s[6 * 33], s[7 * 33]);
        *(u32x4*)(dst + (size_t)(drow0 + n) * Kd + k0 + 8 * c) = o; }
    asm volatile("s_waitcnt lgkmcnt(0)" ::: "memory");
}

struct Params { const float* in[18]; float* out; unsigned char* ws; int ph_lo, ph_hi; };

__device__ __forceinline__ void p0_prep(const Params& p, LAS unsigned char* lds, int tid, int wave, int lane) {
    unsigned char* ws = p.ws;
    LAS float* scr = (LAS float*)(lds + wave * 16384);
    const int gw = blockIdx.x * 8 + wave, NGW = gridDim.x * 8;
    constexpr int I_A = 16 * 176, I_D = 44 * 32, I_IN = 16 * 32, I_OUT = 16 * 32, I_ZP = 1024;
    constexpr int NITEMS = I_ZP + 2 * (I_A + I_D) + I_IN + I_OUT;
    for (int it = gw; it < NITEMS; it += NGW) {
        int r = it;
        if (r < I_ZP) {
            const int g = r >> 8, kb = (r >> 4) & 15, jb = r & 15, k = 64 * kb + lane;
            const float* __restrict__ wrow = p.in[6] + (size_t)k * NIN + 1024 + 128 * g;
            const float* __restrict__ wp = p.in[10] + (size_t)g * 16384 + 8 * jb;
            float a[8];
#pragma unroll
            for (int j = 0; j < 8; ++j) a[j] = 0.f;
#pragma unroll
            for (int b = 0; b < 4; ++b) { f32x4 w4[8];
#pragma unroll
                for (int q = 0; q < 8; ++q) w4[q] = *(const f32x4*)(wrow + 32 * b + 4 * q);
#pragma unroll
                for (int q = 0; q < 8; ++q)
#pragma unroll
                    for (int e = 0; e < 4; ++e) { const float* wpi = wp + (size_t)(32 * b + 4 * q + e) * 128;
#pragma unroll
                        for (int j = 0; j < 8; ++j) a[j] += w4[q][e] * wpi[j]; } }
            const float gm = p.in[5][k];
            bf16_t* dst = (bf16_t*)(ws + WS_WIN) + (size_t)(1024 + 128 * g + 8 * jb) * D + k;
#pragma unroll
            for (int j = 0; j < 8; ++j) dst[(size_t)j * D] = (bf16_t)(pg8::cvt_pk_bf16(a[j] * gm, 0.f) & 0xffffu);
            continue;
        }
        r -= I_ZP;
        if (r < 2 * (I_A + I_D)) {
            const int l = r >= (I_A + I_D); if (l) r -= (I_A + I_D);
            const float* nrm = l ? p.in[13] : p.in[1]; const float* wg = l ? p.in[14] : p.in[2]; const float* wu = l ? p.in[15] : p.in[3]; const float* wd = l ? p.in[16] : p.in[4];
            bf16_t* dA = (bf16_t*)(ws + (l ? WS_W2A : WS_W1A)); bf16_t* dD = (bf16_t*)(ws + (l ? WS_W2D : WS_W1D));
            if (r < I_A) { const int kb = r / 176, rb = r % 176, pn = rb >> 3, bj = (rb >> 2) & 1, c0 = (rb & 3) * 32;
                p0_transpose_item(bj ? wu : wg, FF, D, 64 * kb, 128 * pn + c0, dA, 32 * rb, nrm, scr, lane); }
            else { r -= I_A; const int kb = r / 32, rb = r % 32; p0_transpose_item(wd, D, FF, 64 * kb, 32 * rb, dD, 32 * rb, nullptr, scr, lane); }
            continue;
        }
        r -= 2 * (I_A + I_D);
        if (r < I_IN) { const int kb = r / 32, rb = r % 32; int sc;
            if (rb < 16) sc = 32 * rb; else { const int q = rb - 16, pn = q >> 3, bj = (q >> 2) & 1, wc = q & 3; sc = 512 + 64 * (4 * pn + wc) + 32 * bj; }
            p0_transpose_item(p.in[6], NIN, D, 64 * kb, sc, (bf16_t*)(ws + WS_WIN), 32 * rb, p.in[5], scr, lane); continue; }
        r -= I_IN;
        { const int kb = r / 32, rb = r % 32; p0_transpose_item(p.in[12], D, D, 64 * kb, 32 * rb, (bf16_t*)(ws + WS_WOUT), 32 * rb, nullptr, scr, lane); }
    }
    for (int e8 = blockIdx.x * 512 + tid; e8 < 8 * 128 * 128 / 8; e8 += gridDim.x * 512) {
        const int e = e8 * 8, t = (e >> 7) & 127, s0 = e & 127;
        const f32x4 a = *(const f32x4*)(p.in[8] + e), b = *(const f32x4*)(p.in[8] + e + 4); f32x4 ma, mb;
#pragma unroll
        for (int j = 0; j < 4; ++j) { ma[j] = (s0 + j <= t) ? a[j] : 0.f; mb[j] = (s0 + 4 + j <= t) ? b[j] : 0.f; }
        *(u32x4*)((bf16_t*)(ws + WS_WM) + e) = pack8(ma, mb);
    }
    bf16_t* XB = (bf16_t*)(ws + WS_XB); float* ss = (float*)(ws + WS_SS);
    for (int i = blockIdx.x * 512 + tid; i < 3 * M / 4; i += gridDim.x * 512) ((f32x4*)(ss + SS_STRIDE))[i] = (f32x4){0.f, 0.f, 0.f, 0.f};
    for (int m = gw; m < M; m += 4 * NGW) {
        f32x4 v[4][4];
#pragma unroll
        for (int q = 0; q < 4; ++q) { const int mq = (m + q * NGW < M) ? m + q * NGW : m; const f32x4* xr = (const f32x4*)(p.in[0] + (size_t)mq * D) + lane;
#pragma unroll
            for (int j = 0; j < 4; ++j) v[q][j] = __builtin_nontemporal_load(xr + 64 * j); }
#pragma unroll
        for (int q = 0; q < 4; ++q) { const int mq = m + q * NGW; if (mq < M) {
            float sq = 0.f;
#pragma unroll
            for (int j = 0; j < 4; ++j) sq += (v[q][j][0] * v[q][j][0] + v[q][j][1] * v[q][j][1]) + (v[q][j][2] * v[q][j][2] + v[q][j][3] * v[q][j][3]);
            sq = wave_sum(sq);
            u32x2* o = (u32x2*)(XB + (size_t)mq * D) + lane;
#pragma unroll
            for (int j = 0; j < 4; ++j) { u32x2 w; w.x = pg8::cvt_pk_bf16(v[q][j][0], v[q][j][1]); w.y = pg8::cvt_pk_bf16(v[q][j][2], v[q][j][3]); o[64 * j] = w; }
            if (lane == 0) ss[mq] = sq; } }
    }
}

__device__ __forceinline__ void p4_mixer(const Params& p, LAS unsigned char* lds, int tid, int wave, int lane) {
    unsigned char* ws = p.ws;
    const bf16_t* U = (const bf16_t*)(ws + WS_U); const bf16_t* V = (const bf16_t*)(ws + WS_V); const bf16_t* Z = (const bf16_t*)(ws + WS_Z); bf16_t* Y = (bf16_t*)(ws + WS_Y);
    const bf16_t* Wm = (const bf16_t*)(ws + WS_WM); const float* bs = p.in[9]; const float* pscale = p.in[11]; const float* vgain = p.in[7];
    constexpr int P = 136;
    LAS bf16_t* Vt = (LAS bf16_t*)lds;
    const int fr = lane & 15, fq = lane >> 4;
    for (int chunk = blockIdx.x; chunk < M / 128; chunk += gridDim.x) {
        const size_t R0 = (size_t)chunk * 128;
        {
            const int s = tid & 127, cq0 = tid >> 7; const bf16_t* vrow = V + (R0 + s) * AW;
#pragma unroll 4
            for (int it = 0; it < 16; ++it) { const int cq = cq0 + 4 * it; const u32x4 v = *(const u32x4*)(vrow + 8 * cq); LAS bf16_t* d = Vt + (8 * cq) * P + s;
                d[0 * P] = (bf16_t)(v.x & 0xffffu); d[1 * P] = (bf16_t)(v.x >> 16); d[2 * P] = (bf16_t)(v.y & 0xffffu); d[3 * P] = (bf16_t)(v.y >> 16);
                d[4 * P] = (bf16_t)(v.z & 0xffffu); d[5 * P] = (bf16_t)(v.z >> 16); d[6 * P] = (bf16_t)(v.w & 0xffffu); d[7 * P] = (bf16_t)(v.w >> 16); }
        }
        __syncthreads();
        for (int i = 0; i < 8; ++i) {
            const int h = i, ts = (wave + i) & 7, t = 16 * ts + fr, nks = (ts >> 1) + 1;
            f32x4 acc[4];
#pragma unroll
            for (int nb = 0; nb < 4; ++nb) acc[nb] = (f32x4){0.f, 0.f, 0.f, 0.f};
            const bf16_t* wrow = Wm + (size_t)(h * 128 + t) * 128 + 8 * fq;
            for (int ks = 0; ks < nks; ++ks) {
                const bf16x8 wf = *(const bf16x8*)(wrow + 32 * ks);
#pragma unroll
                for (int nb = 0; nb < 4; ++nb) { const bf16x8 vf = *(const LAS bf16x8*)(Vt + (64 * h + 16 * nb + fr) * P + 32 * ks + 8 * fq);
                    acc[nb] = __builtin_amdgcn_mfma_f32_16x16x32_bf16(vf, wf, acc[nb], 0, 0, 0); }
            }
            const float bias = bs[h * 128 + t]; const size_t row = R0 + t;
#pragma unroll
            for (int nb = 0; nb < 4; ++nb) { const int col = 64 * h + 16 * nb + 4 * fq; const u32x2 uu = *(const u32x2*)(U + row * AW + col); const f32x4 gn = *(const f32x4*)(vgain + col);
                u32x2 w; w.x = pg8::cvt_pk_bf16(bf_lo(uu.x) * (acc[nb][0] * gn[0] + bias), bf_hi(uu.x) * (acc[nb][1] * gn[1] + bias)); w.y = pg8::cvt_pk_bf16(bf_lo(uu.y) * (acc[nb][2] * gn[2] + bias), bf_hi(uu.y) * (acc[nb][3] * gn[3] + bias));
                *(u32x2*)(Y + row * D + col) = w; }
        }
        {
            const int cq = tid & 127, rg = tid >> 7, win = 2 << (cq >> 5);
            const int p0 = (chunk & 31) * 128 + 32 * rg; const size_t Rb = R0 + 32 * rg;
            const bf16_t* zc = Z + 4 * cq; const f32x4 sc = *(const f32x4*)(pscale + 4 * cq);
            f32x4 s = (f32x4){0.f, 0.f, 0.f, 0.f};
            for (int w = 1; w < win; ++w) if (p0 - w >= 0) { const u32x2 zz = *(const u32x2*)(zc + (Rb - w) * AW); s += (f32x4){bf_lo(zz.x), bf_hi(zz.x), bf_lo(zz.y), bf_hi(zz.y)}; }
            for (int t = 0; t < 32; ++t) {
                const int pos = p0 + t; const u32x2 zz = *(const u32x2*)(zc + (Rb + t) * AW); const f32x4 zt = (f32x4){bf_lo(zz.x), bf_hi(zz.x), bf_lo(zz.y), bf_hi(zz.y)};
                s += zt; const int cnt = (pos + 1 < win) ? pos + 1 : win; const float inv = 1.0f / (float)cnt;
                const f32x4 o = (s * inv - zt) * sc;
                u32x2 w; w.x = pg8::cvt_pk_bf16(o[0], o[1]); w.y = pg8::cvt_pk_bf16(o[2], o[3]);
                *(u32x2*)(Y + (Rb + t) * D + 512 + 4 * cq) = w;
                if (pos - win + 1 >= 0) { const u32x2 zo = *(const u32x2*)(zc + (Rb + t - win + 1) * AW); s -= (f32x4){bf_lo(zo.x), bf_hi(zo.x), bf_lo(zo.y), bf_hi(zo.y)}; }
            }
        }
        __syncthreads();
    }
}

__device__ __forceinline__ void p8_final(const Params& p, int wave, int lane) {
    const float* ss = (const float*)(p.ws + WS_SS) + 3 * SS_STRIDE; const float* g = p.in[17];
    const int gw = blockIdx.x * 8 + wave, NGW = gridDim.x * 8;
    f32x4 gv[4];
#pragma unroll
    for (int j = 0; j < 4; ++j) gv[j] = ((const f32x4*)g)[lane + 64 * j];
    for (int m = gw; m < M; m += 4 * NGW) {
        f32x4 v[4][4]; float sv[4];
#pragma unroll
        for (int q = 0; q < 4; ++q) { const int mq = (m + q * NGW < M) ? m + q * NGW : m; const f32x4* xr = (const f32x4*)(p.out + (size_t)mq * D) + lane;
#pragma unroll
            for (int j = 0; j < 4; ++j) v[q][j] = xr[64 * j];
            sv[q] = ss[mq]; }
#pragma unroll
        for (int q = 0; q < 4; ++q) { const int mq = m + q * NGW; if (mq < M) {
            const float s0 = sv[q];
            const float r0 = __builtin_amdgcn_rsqf(s0 * (1.0f / 1024.0f) + EPS);
            f32x4* xo = (f32x4*)(p.out + (size_t)mq * D) + lane;
#pragma unroll
            for (int j = 0; j < 4; ++j) __builtin_nontemporal_store(v[q][j] * r0 * gv[j], xo + 64 * j); } }
    }
}

template <int PH> __device__ __forceinline__ void run_phase(const Params& p, LAS unsigned char* lds, const int wave0) {
    int tid = wave0 * 64 + (int)__builtin_amdgcn_mbcnt_hi(~0u, __builtin_amdgcn_mbcnt_lo(~0u, 0u)); asm volatile("" : "+v"(tid));
    const int lane = tid & 63, wave = __builtin_amdgcn_readfirstlane(tid >> 6);
    unsigned char* ws = p.ws;
    bf16_t* XB = (bf16_t*)(ws + WS_XB); bf16_t* ACT = (bf16_t*)(ws + WS_ACT); float* ss = (float*)(ws + WS_SS);
    const int G = gridDim.x, c = blockIdx.x;
    if constexpr (PH == 0) p0_prep(p, lds, tid, wave, lane);
    if constexpr (PH == 1 || PH == 6) {
        pg8::Gemm g{XB, (const bf16_t*)(ws + (PH == 1 ? WS_W1A : WS_W2A)), M, 2 * FF, D}; pg8::StaticOrder S; S.init(M, 2 * FF, G, c);
        EpiSwiglu E{ACT, ss + (PH == 1 ? 0 : 2) * SS_STRIDE};
        pg8::gemm_phase<EpiSwiglu, pg8::StaticOrder, true, true>(lds, g, S, E, tid);
    }
    if constexpr (PH == 2 || PH == 7) {
        pg8::Gemm g{ACT, (const bf16_t*)(ws + (PH == 2 ? WS_W1D : WS_W2D)), M, D, FF}; pg8::StaticOrder S; S.init(M, D, G, c);
        EpiRes E{PH == 2 ? p.in[0] : p.out, p.out, PH == 2 ? XB : nullptr, ss + (PH == 2 ? 1 : 3) * SS_STRIDE, 0.5f};
        pg8::gemm_phase<EpiRes, pg8::StaticOrder, true, true>(lds, g, S, E, tid);
    }
    if constexpr (PH == 3) {
        pg8::Gemm g{XB, (const bf16_t*)(ws + WS_WIN), M, NIN, D}; pg8::StaticOrder S; S.init(M, NIN, G, c);
        EpiWin E{(bf16_t*)(ws + WS_U), (bf16_t*)(ws + WS_V), (bf16_t*)(ws + WS_Z), ss + SS_STRIDE};
        pg8::gemm_phase<EpiWin, pg8::StaticOrder, true, true>(lds, g, S, E, tid);
    }
    if constexpr (PH == 4) p4_mixer(p, lds, tid, wave, lane);
    if constexpr (PH == 5) {
        pg8::Gemm g{(const bf16_t*)(ws + WS_Y), (const bf16_t*)(ws + WS_WOUT), M, D, D}; pg8::StaticOrder S; S.init(M, D, G, c);
        EpiRes E{p.out, p.out, XB, ss + 2 * SS_STRIDE, 1.0f};
        pg8::gemm_phase<EpiRes, pg8::StaticOrder, true, true>(lds, g, S, E, tid);
    }
    if constexpr (PH == 8) p8_final(p, wave, lane);
}
__global__ void __launch_bounds__(512, 2) fwd(Params p) {
    extern __shared__ __attribute__((aligned(16))) unsigned char lds_raw[];
    LAS unsigned char* lds = (LAS unsigned char*)lds_raw;
    const int wave0 = __builtin_amdgcn_readfirstlane(threadIdx.x >> 6);
    const int lo = p.ph_lo, hi = p.ph_hi;
#define MK_PHASE(k) if (lo <= (k) && (k) < hi) { if ((PHM >> (k)) & 1) run_phase<k>(p, lds, wave0); if (PROBE_REP == (k)) { cg::this_grid().sync(); run_phase<k>(p, lds, wave0); } if ((k) + 1 < hi) cg::this_grid().sync(); }
    MK_PHASE(0) MK_PHASE(1) MK_PHASE(2) MK_PHASE(3) MK_PHASE(4) MK_PHASE(5) MK_PHASE(6) MK_PHASE(7) MK_PHASE(8)
#undef MK_PHASE
}
}

extern "C" void kernel_launch(void* const* d_in, const int* in_sizes, int n_in, void* d_out, int out_size, void* d_ws, size_t ws_size, hipStream_t stream) {
    static int grid = 0;
    if (grid == 0) {
        if (n_in != 18 || out_size != mk::M * mk::D || ws_size < mk::WS_END) { fprintf(stderr, "kernel_launch: unexpected shapes (n_in %d out %d ws %zu)\n", n_in, out_size, ws_size); grid = -1; return; }
        int dev = 0, cus = 0;
        if (hipGetDevice(&dev) != hipSuccess || hipDeviceGetAttribute(&cus, hipDeviceAttributeMultiprocessorCount, dev) != hipSuccess) { grid = -1; return; }
        if (hipFuncSetAttribute((const void*)mk::fwd, hipFuncAttributeMaxDynamicSharedMemorySize, mk::LDS_BYTES) != hipSuccess) { fprintf(stderr, "kernel_launch: hipFuncSetAttribute failed\n"); grid = -1; return; }
        grid = cus;
    }
    if (grid < 0) return;
    mk::Params p{};
    for (int i = 0; i < 18; ++i) p.in[i] = (const float*)d_in[i];
    p.out = (float*)d_out; p.ws = (unsigned char*)d_ws;
#if MK_LAUNCHES == 1
    p.ph_lo = 0; p.ph_hi = 9;
    void* args[] = {&p};
    hipError_t e = hipLaunchCooperativeKernel((const void*)mk::fwd, dim3(grid), dim3(512), args, mk::LDS_BYTES, stream);
    if (e != hipSuccess) fprintf(stderr, "cooperative launch failed: %s (grid %d)\n", hipGetErrorString(e), grid);
#else
    for (int ph = 0; ph < 9; ++ph) { p.ph_lo = ph; p.ph_hi = ph + 1; hipLaunchKernelGGL(mk::fwd, dim3(grid), dim3(512), mk::LDS_BYTES, stream, p); }
#endif
}
```

```cpp
#include <hip/hip_runtime.h>
#include <hip/hip_cooperative_groups.h>
#include <cstdio>
#include <cstdint>
namespace cg = cooperative_groups;
#ifndef PHM
#define PHM 0x1ff
#endif
#ifndef PROBE_REP
#define PROBE_REP -1
#endif
#ifndef MK_LAUNCHES
#define MK_LAUNCHES 1
#endif
namespace pg8 {
#define PG8_LAS __attribute__((address_space(3)))
typedef unsigned short bf16_t;
typedef short bf16x8 __attribute__((ext_vector_type(8)));
typedef float f32x4 __attribute__((ext_vector_type(4)));
typedef unsigned u32x4 __attribute__((ext_vector_type(4)));
constexpr int BM = 256, BK = 64, HALF = 128, HTB = HALF * BK * 2  , STAGE_BYTES = 8 * HTB, NXCD = 8, WGM = 8;

__host__ __device__ __forceinline__ int lds_byte(int r, int c) { const int st = (r >> 4) * 2 + (c >> 5), rr = r & 15, cc = c & 31, ob = rr * 64 + cc * 2; return st * 1024 + (ob ^ (((ob >> 9) & 1) << 5)); }
__host__ __device__ __forceinline__ void stage_rc(int b, int& R, int& C) { const int st = b / 1024, sb = b % 1024, swz = sb ^ (((sb >> 9) & 1) << 5); R = (st >> 1) * 16 + swz / 64; C = (st & 1) * 32 + (swz % 64) / 2; }
__host__ __device__ __forceinline__ int perm32(int rho) { const int n = rho >> 4, i = rho & 15; return 8 * (i >> 2) + 4 * n + (i & 3); }

struct Unit { int pm, pn; };
struct Gemm { const bf16_t* A; const bf16_t* Bt; int M, N, K; };

struct StaticOrder {
    int nM, nN, nwg, G, c;
    __host__ __device__ void init(int M, int N, int G_, int c_) { nM = M / BM; nN = N / BM; nwg = nM * nN; G = G_; c = c_; }
    __host__ __device__ bool next(int i, Unit& u) const {
        const long L = (long)i * G + c; if (L >= nwg) return false;
        int wgid = (int)L; { const int q = nwg / NXCD, r = nwg % NXCD, xcd = wgid % NXCD, off = wgid / NXCD; wgid = (xcd < r ? xcd * (q + 1) : r * (q + 1) + (xcd - r) * q) + off; }
        const int nig = WGM * nN, gid = wgid / nig, fm = gid * WGM, gsz = (nM - fm) < WGM ? (nM - fm) : WGM;
        u.pm = fm + ((wgid % nig) % gsz); u.pn = (wgid % nig) / gsz; return true;
    }
    __device__ __forceinline__ void a_ready(const Unit&) const {}
    __device__ __forceinline__ void done(const Unit&) const {}
};
__device__ __forceinline__ unsigned cvt_pk_bf16(float lo, float hi) { unsigned r; asm volatile("v_cvt_pk_bf16_f32 %0, %1, %2" : "=v"(r) : "v"(lo), "v"(hi)); return r; }
template <class Epi, class Sched, bool ALIGN_EPI = false, bool SP2 = false>
__device__ __forceinline__ void gemm_phase(PG8_LAS unsigned char* lds, const Gemm g, const Sched& S, const Epi& E, const int tid) {
    const int wid = __builtin_amdgcn_readfirstlane(tid >> 6), lane = tid & 63, wr = wid >> 2, wc = wid & 3, fr = lane & 15, fq = lane >> 4;
    const int K = g.K, nt = K / BK;
    unsigned voffA[2], voffB[2];
#pragma unroll
    for (int i = 0; i < 2; ++i) { int R, C; stage_rc(tid * 16 + i * 8192, R, C); const int Rb = Epi::PERM ? ((R & ~31) + perm32(R & 31)) : R;
        voffA[i] = (unsigned)(R * K + C) * 2u; voffB[i] = (unsigned)(Rb * K + C) * 2u; }
    const size_t kstep = (size_t)(BK * 2);
    const size_t hstep = (size_t)HALF * K * 2;
    const size_t tstep = 2 * hstep;
    const unsigned ldsw = (unsigned)wid * 1024u;
    const int aoff = lds_byte(wr * 64 + fr, fq * 8), boff = lds_byte(wc * 32 + fr, fq * 8);
#define PG8_SA(b, h) (((b) * 2 + (h)) * HTB)
#define PG8_SB(b, h) ((4 + (b) * 2 + (h)) * HTB)
#define PG8_STAGE(bufoff, gbase, voff) do { _Pragma("unroll") for (int _i = 0; _i < 2; ++_i) \
        __builtin_amdgcn_global_load_lds((const unsigned*)((const char*)(gbase) + (voff)[_i]), (PG8_LAS unsigned*)(lds + (bufoff) + ldsw + _i * 8192), 16, 0, 0); } while (0)
#define PG8_LDA(dst, b, h) do { _Pragma("unroll") for (int m = 0; m < 4; ++m) _Pragma("unroll") for (int k = 0; k < 2; ++k) dst[m][k] = *(const PG8_LAS bf16x8*)(lds + PG8_SA(b, h) + aoff + m * 2048 + k * 1024); } while (0)
#define PG8_LDB(dst, b, h) do { _Pragma("unroll") for (int n = 0; n < 2; ++n) _Pragma("unroll") for (int k = 0; k < 2; ++k) dst[n][k] = *(const PG8_LAS bf16x8*)(lds + PG8_SB(b, h) + boff + n * 2048 + k * 1024); } while (0)
#define PG8_MMA(ai, bj, At, Bt) do { __builtin_amdgcn_s_setprio(1); _Pragma("unroll") for (int m = 0; m < 4; ++m) _Pragma("unroll") for (int n = 0; n < 2; ++n) _Pragma("unroll") for (int k = 0; k < 2; ++k) \
        acc[ai][bj][m][n] = __builtin_amdgcn_mfma_f32_16x16x32_bf16(Bt[n][k], At[m][k], acc[ai][bj][m][n], 0, 0, 0); __builtin_amdgcn_s_setprio(0); } while (0)
#define PG8_WAIT_V(n) asm volatile("s_waitcnt vmcnt(" #n ")" ::: "memory")
#define PG8_WAIT_L(n) asm volatile("s_waitcnt lgkmcnt(" #n ")" ::: "memory")
#define PG8_BAR __builtin_amdgcn_s_barrier()
#define PG8_SCHED __builtin_amdgcn_sched_barrier(0)
    Unit cur, nxt; int ui = 0;
    if (!S.next(0, cur)) return;
    f32x4 acc[2][2][4][2];
#pragma unroll
    for (int a = 0; a < 2; ++a)
#pragma unroll
        for (int b = 0; b < 2; ++b)
#pragma unroll
            for (int m = 0; m < 4; ++m)
#pragma unroll
                for (int n = 0; n < 2; ++n) acc[a][b][m][n] = (f32x4){0.f, 0.f, 0.f, 0.f};
    bf16x8 At[4][2], B0[2][2], B1[2][2];
    const char* cA = (const char*)g.A + (size_t)cur.pm * tstep; const char* cB = (const char*)g.Bt + (size_t)cur.pn * tstep;
    S.a_ready(cur);
    if constexpr (SP2) {
        PG8_STAGE(PG8_SB(0, 0), cB, voffB); PG8_STAGE(PG8_SB(0, 1), cB + hstep, voffB); PG8_STAGE(PG8_SA(0, 0), cA, voffA); PG8_STAGE(PG8_SA(0, 1), cA + hstep, voffA);
        if (wr == 1) PG8_BAR;
        PG8_WAIT_V(2); PG8_BAR;
        PG8_STAGE(PG8_SB(1, 0), cB + kstep, voffB); PG8_STAGE(PG8_SA(1, 0), cA + kstep, voffA); PG8_STAGE(PG8_SB(1, 1), cB + hstep + kstep, voffB);
        PG8_WAIT_V(6); PG8_BAR;
    } else {
        PG8_STAGE(PG8_SB(0, 0), cB, voffB); PG8_STAGE(PG8_SA(0, 0), cA, voffA); PG8_STAGE(PG8_SB(0, 1), cB + hstep, voffB); PG8_STAGE(PG8_SA(0, 1), cA + hstep, voffA);
        if (wr == 1) PG8_BAR;
        PG8_WAIT_V(4); PG8_BAR;
        PG8_STAGE(PG8_SB(1, 0), cB + kstep, voffB); PG8_STAGE(PG8_SA(1, 0), cA + kstep, voffA); PG8_STAGE(PG8_SB(1, 1), cB + hstep + kstep, voffB);
        PG8_WAIT_V(6); PG8_BAR;
    }
    for (;;) {
        const bool has_next = S.next(ui + 1, nxt);
        const char* nA = has_next ? (const char*)g.A + (size_t)nxt.pm * tstep : cA; const char* nB = has_next ? (const char*)g.Bt + (size_t)nxt.pn * tstep : cB;
        for (int t = 0; t < nt; t += 2) {
            const bool last = (t == nt - 2);
            const char* a1 = cA + (size_t)(t + 1) * kstep;
            const char* a2 = last ? nA : cA + (size_t)(t + 2) * kstep; const char* b2 = last ? nB : cB + (size_t)(t + 2) * kstep;
            const char* a3 = a2 + kstep; const char* b3 = b2 + kstep;
            if (last && has_next) S.a_ready(nxt);
            if constexpr (SP2) {
            PG8_LDB(B0, 0, 0); PG8_LDB(B1, 0, 1); PG8_SCHED; PG8_LDA(At, 0, 0); PG8_STAGE(PG8_SA(1, 1), a1 + hstep, voffA);
            PG8_WAIT_V(8); PG8_WAIT_L(0); PG8_BAR; PG8_MMA(0, 0, At, B0); PG8_MMA(0, 1, At, B1); PG8_BAR; PG8_SCHED;
            PG8_LDA(At, 0, 1); PG8_STAGE(PG8_SB(0, 0), b2, voffB); PG8_STAGE(PG8_SB(0, 1), b2 + hstep, voffB); PG8_STAGE(PG8_SA(0, 0), a2, voffA);
            PG8_WAIT_V(8); PG8_WAIT_L(0); PG8_BAR; PG8_MMA(1, 0, At, B0); PG8_MMA(1, 1, At, B1); PG8_BAR; PG8_SCHED;
            PG8_LDB(B0, 1, 0); PG8_LDB(B1, 1, 1); PG8_SCHED; PG8_LDA(At, 1, 0); PG8_STAGE(PG8_SA(0, 1), a2 + hstep, voffA);
            PG8_WAIT_V(8); PG8_WAIT_L(0); PG8_BAR; PG8_MMA(0, 0, At, B0); PG8_MMA(0, 1, At, B1); PG8_BAR; PG8_SCHED;
            PG8_LDA(At, 1, 1); PG8_STAGE(PG8_SB(1, 0), b3, voffB); PG8_STAGE(PG8_SB(1, 1), b3 + hstep, voffB); PG8_STAGE(PG8_SA(1, 0), a3, voffA);
            PG8_WAIT_V(8); PG8_WAIT_L(0); PG8_BAR; PG8_MMA(1, 0, At, B0); PG8_MMA(1, 1, At, B1); PG8_BAR; PG8_SCHED;
            } else {
            PG8_LDB(B0, 0, 0); PG8_SCHED; PG8_LDA(At, 0, 0); PG8_STAGE(PG8_SA(1, 1), a1 + hstep, voffA);
            PG8_WAIT_L(8); PG8_BAR; PG8_WAIT_L(0); PG8_MMA(0, 0, At, B0); PG8_BAR; PG8_SCHED;
            PG8_LDB(B1, 0, 1); PG8_STAGE(PG8_SB(0, 0), b2, voffB);
            PG8_BAR; PG8_WAIT_L(0); PG8_MMA(0, 1, At, B1); PG8_BAR;
            PG8_LDA(At, 0, 1); PG8_STAGE(PG8_SA(0, 0), a2, voffA);
            PG8_BAR; PG8_WAIT_L(0); PG8_MMA(1, 0, At, B0); PG8_BAR; PG8_SCHED;
            PG8_STAGE(PG8_SB(0, 1), b2 + hstep, voffB);
            PG8_WAIT_V(6); PG8_BAR; PG8_MMA(1, 1, At, B1); PG8_BAR;
            PG8_LDB(B0, 1, 0); PG8_SCHED; PG8_LDA(At, 1, 0); PG8_STAGE(PG8_SA(0, 1), a2 + hstep, voffA);
            PG8_WAIT_L(8); PG8_BAR; PG8_WAIT_L(0); PG8_MMA(0, 0, At, B0); PG8_BAR; PG8_SCHED;
            PG8_LDB(B1, 1, 1); PG8_STAGE(PG8_SB(1, 0), b3, voffB);
            PG8_BAR; PG8_WAIT_L(0); PG8_MMA(0, 1, At, B1); PG8_BAR;
            PG8_LDA(At, 1, 1); PG8_STAGE(PG8_SA(1, 0), a3, voffA);
            PG8_BAR; PG8_WAIT_L(0); PG8_MMA(1, 0, At, B0); PG8_BAR; PG8_SCHED;
            PG8_STAGE(PG8_SB(1, 1), b3 + hstep, voffB);
            PG8_WAIT_V(6); PG8_BAR; PG8_MMA(1, 1, At, B1); PG8_BAR;
            }
        }
        if constexpr (ALIGN_EPI) { if (wr == 0) PG8_BAR; }
        if constexpr (!Epi::AFTER_DRAIN) { E(acc, cur, wr, wc, fr, fq); S.done(cur); }
        if (!has_next) break;
#pragma unroll
        for (int a = 0; a < 2; ++a)
#pragma unroll
            for (int b = 0; b < 2; ++b)
#pragma unroll
                for (int m = 0; m < 4; ++m)
#pragma unroll
                    for (int n = 0; n < 2; ++n) acc[a][b][m][n] = (f32x4){0.f, 0.f, 0.f, 0.f};
        cur = nxt; cA = nA; cB = nB; ++ui;
        if constexpr (ALIGN_EPI) { if (wr == 1) PG8_BAR; }
    }
    PG8_WAIT_V(0);
    if constexpr (!ALIGN_EPI) { if (wr == 0) PG8_BAR; }
    PG8_BAR;
    if constexpr (Epi::AFTER_DRAIN) { E.fused(acc, cur, wr, wc, fr, fq, lds, wid, lane); S.done(cur); }
#undef PG8_SA
#undef PG8_SB
#undef PG8_STAGE
#undef PG8_LDA
#undef PG8_LDB
#undef PG8_MMA
#undef PG8_WAIT_V
#undef PG8_WAIT_L
#undef PG8_BAR
#undef PG8_SCHED
}
}

namespace mk {
using pg8::bf16_t; using pg8::f32x4; using pg8::u32x4; using pg8::bf16x8; using pg8::Unit;
#define LAS __attribute__((address_space(3)))
typedef unsigned u32x2 __attribute__((ext_vector_type(2)));
constexpr int M = 32768, D = 1024, FF = 2816, NIN = 1536, AW = 512, SEQ = 4096;
constexpr float EPS = 1e-6f;
constexpr int LDS_BYTES = 147456;
constexpr size_t MiB = 1u << 20;
constexpr size_t WS_W1A = 0 * MiB, WS_W1D = 11 * MiB, WS_W2A = 17 * MiB, WS_W2D = 28 * MiB, WS_WIN = 34 * MiB, WS_WOUT = 37 * MiB, WS_WM = 39 * MiB, WS_SS = 40 * MiB,
                 WS_CTL = 41 * MiB, CTL_BYTES = 16384, WS_XB = 42 * MiB, WS_ACT = 106 * MiB, WS_U = WS_ACT, WS_V = WS_ACT + 32 * MiB, WS_Z = WS_ACT + 64 * MiB, WS_Y = WS_ACT + 96 * MiB, WS_END = 282 * MiB;

__device__ __forceinline__ float silu_f(float g) { return g * __builtin_amdgcn_rcpf(1.0f + __builtin_amdgcn_exp2f(-1.4426950409f * g)); }
__device__ __forceinline__ float gelu_f(float v) { const float w = v + 0.044715f * v * v * v; return v * __builtin_amdgcn_rcpf(1.0f + __builtin_amdgcn_exp2f(-2.3022081981f * w)); }
__device__ __forceinline__ float bf_lo(unsigned w) { return __uint_as_float(w << 16); }
__device__ __forceinline__ float bf_hi(unsigned w) { return __uint_as_float(w & 0xffff0000u); }
__device__ __forceinline__ u32x4 pack8(const f32x4 a, const f32x4 b) { u32x4 w; w.x = pg8::cvt_pk_bf16(a[0], a[1]); w.y = pg8::cvt_pk_bf16(a[2], a[3]); w.z = pg8::cvt_pk_bf16(b[0], b[1]); w.w = pg8::cvt_pk_bf16(b[2], b[3]); return w; }
__device__ __forceinline__ float row_rstd(const float* ss, int row) { return __builtin_amdgcn_rsqf(ss[row] * (1.0f / 1024.0f) + EPS); }
constexpr size_t SS_STRIDE = 32768;

struct EpiSwiglu {
    static constexpr bool PERM = true, AFTER_DRAIN = false;
    bf16_t* O; const float* ss;
    __device__ __forceinline__ void operator()(const f32x4 (&acc)[2][2][4][2], const Unit& u, int wr, int wc, int fr, int fq) const {
        const int row0 = u.pm * 256 + wr * 64 + fr, col0 = u.pn * 128 + wc * 32 + 8 * fq;
        float r[2][4];
#pragma unroll
        for (int ai = 0; ai < 2; ++ai)
#pragma unroll
            for (int m = 0; m < 4; ++m) r[ai][m] = row_rstd(ss, row0 + ai * 128 + m * 16);
#pragma unroll
        for (int ai = 0; ai < 2; ++ai)
#pragma unroll
            for (int m = 0; m < 4; ++m) {
                const float rr = r[ai][m];
                f32x4 o0, o1;
#pragma unroll
                for (int e = 0; e < 4; ++e) { o0[e] = silu_f(acc[ai][0][m][0][e] * rr) * (acc[ai][1][m][0][e] * rr); o1[e] = silu_f(acc[ai][0][m][1][e] * rr) * (acc[ai][1][m][1][e] * rr); }
                *(u32x4*)(O + (size_t)(row0 + ai * 128 + m * 16) * FF + col0) = pack8(o0, o1);
            }
    }
};
struct EpiRes {
    static constexpr bool PERM = true, AFTER_DRAIN = false;
    const float* base; float* out; bf16_t* xb; float* ss; float alpha;
    __device__ __forceinline__ void operator()(const f32x4 (&acc)[2][2][4][2], const Unit& u, int wr, int wc, int fr, int fq) const {
        const unsigned off0 = (unsigned)(u.pm * 256 + wr * 64 + fr) * (unsigned)D + (unsigned)(u.pn * 256 + wc * 32 + 8 * fq);
        const unsigned sso = (unsigned)(u.pm * 256 + wr * 64 + fr);
#pragma unroll
        for (int ai = 0; ai < 2; ++ai)
#pragma unroll
            for (int m = 0; m < 4; ++m) {
                float sq = 0.f;
#pragma unroll
                for (int bj = 0; bj < 2; ++bj) {
                    const unsigned off = off0 + (unsigned)((ai * 128 + m * 16) * D + bj * 128);
                    const f32x4 b0 = *(const f32x4*)(base + off), b1 = *(const f32x4*)(base + off + 4);
                    const f32x4 v0 = b0 + acc[ai][bj][m][0] * alpha, v1 = b1 + acc[ai][bj][m][1] * alpha;
                    *(f32x4*)(out + off) = v0; *(f32x4*)(out + off + 4) = v1;
                    if (xb) *(u32x4*)(xb + off) = pack8(v0, v1);
                    sq += (v0[0] * v0[0] + v0[1] * v0[1]) + (v0[2] * v0[2] + v0[3] * v0[3]) + (v1[0] * v1[0] + v1[1] * v1[1]) + (v1[2] * v1[2] + v1[3] * v1[3]);
                }
                sq += __shfl_xor(sq, 16); sq += __shfl_xor(sq, 32);
                if (fq == 0) __hip_atomic_fetch_add(ss + sso + (unsigned)(ai * 128 + m * 16), sq, __ATOMIC_RELAXED, __HIP_MEMORY_SCOPE_AGENT);
                asm volatile("" ::: "memory");
            }
    }
};
struct EpiWin {
    static constexpr bool PERM = true, AFTER_DRAIN = false;
    bf16_t *U, *V, *Z; const float* ss;
    __device__ __forceinline__ void operator()(const f32x4 (&acc)[2][2][4][2], const Unit& u, int wr, int wc, int fr, int fq) const {
        const int row0 = u.pm * 256 + wr * 64 + fr;
        float r[2][4];
#pragma unroll
        for (int ai = 0; ai < 2; ++ai)
#pragma unroll
            for (int m = 0; m < 4; ++m) r[ai][m] = row_rstd(ss, row0 + ai * 128 + m * 16);
        if (u.pn < 2) {
            const int col0 = u.pn * 256 + wc * 32 + 8 * fq;
#pragma unroll
            for (int ai = 0; ai < 2; ++ai)
#pragma unroll
                for (int m = 0; m < 4; ++m) { const float rr = r[ai][m]; bf16_t* rowp = U + (size_t)(row0 + ai * 128 + m * 16) * AW + col0;
#pragma unroll
                    for (int bj = 0; bj < 2; ++bj) { f32x4 o0, o1;
#pragma unroll
                        for (int e = 0; e < 4; ++e) { o0[e] = gelu_f(acc[ai][bj][m][0][e] * rr); o1[e] = gelu_f(acc[ai][bj][m][1][e] * rr); }
                        *(u32x4*)(rowp + bj * 128) = pack8(o0, o1); } }
        } else if (u.pn < 4) {
            const int colb = 64 * ((u.pn - 2) * 4 + wc) + 8 * fq;
#pragma unroll
            for (int ai = 0; ai < 2; ++ai)
#pragma unroll
                for (int m = 0; m < 4; ++m) { const float rr = r[ai][m]; f32x4 g[2][2]; float sq = 0.f;
#pragma unroll
                    for (int bj = 0; bj < 2; ++bj)
#pragma unroll
                        for (int n = 0; n < 2; ++n)
#pragma unroll
                            for (int e = 0; e < 4; ++e) { const float t = gelu_f(acc[ai][bj][m][n][e] * rr); g[bj][n][e] = t; sq += t * t; }
                    sq += __shfl_xor(sq, 16); sq += __shfl_xor(sq, 32);
                    const float hr = __builtin_amdgcn_rsqf(sq * (1.0f / 64.0f) + EPS);
                    bf16_t* rowp = V + (size_t)(row0 + ai * 128 + m * 16) * AW + colb;
#pragma unroll
                    for (int bj = 0; bj < 2; ++bj) *(u32x4*)(rowp + 32 * bj) = pack8(g[bj][0] * hr, g[bj][1] * hr); }
        } else {
            const int col0 = (u.pn - 4) * 256 + wc * 32 + 8 * fq;
#pragma unroll
            for (int ai = 0; ai < 2; ++ai)
#pragma unroll
                for (int m = 0; m < 4; ++m) { const float rr = r[ai][m]; bf16_t* rowp = Z + (size_t)(row0 + ai * 128 + m * 16) * AW + col0;
#pragma unroll
                    for (int bj = 0; bj < 2; ++bj) *(u32x4*)(rowp + bj * 128) = pack8(acc[ai][bj][m][0] * rr, acc[ai][bj][m][1] * rr); }
        }
    }
};

__device__ __forceinline__ float wave_sum(float v) {
#pragma unroll
    for (int o = 1; o < 64; o <<= 1) v += __shfl_xor(v, o);
    return v;
}
__device__ __forceinline__ void p0_transpose_item(const float* src, int ld, int Kd, int k0, int scol0, bf16_t* dst, int drow0, const float* gk, LAS float* scr, int lane) {
    float tv[32];
#pragma unroll
    for (int i = 0; i < 32; ++i) { const int kk = 2 * i + (lane >> 5); tv[i] = src[(size_t)(k0 + kk) * ld + scol0 + (lane & 31)]; }
    if (gk) {
#pragma unroll
        for (int i = 0; i < 32; ++i) tv[i] *= gk[k0 + 2 * i + (lane >> 5)];
    }
#pragma unroll
    for (int i = 0; i < 32; ++i) scr[(2 * i + (lane >> 5)) * 33 + (lane & 31)] = tv[i];
    asm volatile("s_waitcnt lgkmcnt(0)" ::: "memory");
    const int c = lane & 7;
#pragma unroll
    for (int j = 0; j < 4; ++j) { const int n = (lane >> 3) + 8 * j; const LAS float* s = scr + (8 * c) * 33 + n;
        u32x4 o; o.x = pg8::cvt_pk_bf16(s[0 * 33], s[1 * 33]); o.y = pg8::cvt_pk_bf16(s[2 * 33], s[3 * 33]); o.z = pg8::cvt_pk_bf16(s[4 * 33], s[5 * 33]); o.w = pg8::cvt_pk_bf16(s[6 * 33], s[7 * 33]);
        *(u32x4*)(dst + (size_t)(drow0 + n) * Kd + k0 + 8 * c) = o; }
    asm volatile("s_waitcnt lgkmcnt(0)" ::: "memory");
}

struct Params { const float* in[18]; float* out; unsigned char* ws; int ph_lo, ph_hi; };

__device__ __forceinline__ void p0_prep(const Params& p, LAS unsigned char* lds, int tid, int wave, int lane) {
    unsigned char* ws = p.ws;
    LAS float* scr = (LAS float*)(lds + wave * 16384);
    const int gw = blockIdx.x * 8 + wave, NGW = gridDim.x * 8;
    constexpr int I_A = 16 * 176, I_D = 44 * 32, I_IN = 16 * 32, I_OUT = 16 * 32, I_ZP = 1024;
    constexpr int NITEMS = I_ZP + 2 * (I_A + I_D) + I_IN + I_OUT;
    for (int it = gw; it < NITEMS; it += NGW) {
        int r = it;
        if (r < I_ZP) {
            const int g = r >> 8, kb = (r >> 4) & 15, jb = r & 15, k = 64 * kb + lane;
            const float* __restrict__ wrow = p.in[6] + (size_t)k * NIN + 1024 + 128 * g;
            const float* __restrict__ wp = p.in[10] + (size_t)g * 16384 + 8 * jb;
            float a[8];
#pragma unroll
            for (int j = 0; j < 8; ++j) a[j] = 0.f;
#pragma unroll
            for (int b = 0; b < 4; ++b) { f32x4 w4[8];
#pragma unroll
                for (int q = 0; q < 8; ++q) w4[q] = *(const f32x4*)(wrow + 32 * b + 4 * q);
#pragma unroll
                for (int q = 0; q < 8; ++q)
#pragma unroll
                    for (int e = 0; e < 4; ++e) { const float* wpi = wp + (size_t)(32 * b + 4 * q + e) * 128;
#pragma unroll
                        for (int j = 0; j < 8; ++j) a[j] += w4[q][e] * wpi[j]; } }
            const float gm = p.in[5][k];
            bf16_t* dst = (bf16_t*)(ws + WS_WIN) + (size_t)(1024 + 128 * g + 8 * jb) * D + k;
#pragma unroll
            for (int j = 0; j < 8; ++j) dst[(size_t)j * D] = (bf16_t)(pg8::cvt_pk_bf16(a[j] * gm, 0.f) & 0xffffu);
            continue;
        }
        r -= I_ZP;
        if (r < 2 * (I_A + I_D)) {
            const int l = r >= (I_A + I_D); if (l) r -= (I_A + I_D);
            const float* nrm = l ? p.in[13] : p.in[1]; const float* wg = l ? p.in[14] : p.in[2]; const float* wu = l ? p.in[15] : p.in[3]; const float* wd = l ? p.in[16] : p.in[4];
            bf16_t* dA = (bf16_t*)(ws + (l ? WS_W2A : WS_W1A)); bf16_t* dD = (bf16_t*)(ws + (l ? WS_W2D : WS_W1D));
            if (r < I_A) { const int kb = r / 176, rb = r % 176, pn = rb >> 3, bj = (rb >> 2) & 1, c0 = (rb & 3) * 32;
                p0_transpose_item(bj ? wu : wg, FF, D, 64 * kb, 128 * pn + c0, dA, 32 * rb, nrm, scr, lane); }
            else { r -= I_A; const int kb = r / 32, rb = r % 32; p0_transpose_item(wd, D, FF, 64 * kb, 32 * rb, dD, 32 * rb, nullptr, scr, lane); }
            continue;
        }
        r -= 2 * (I_A + I_D);
        if (r < I_IN) { const int kb = r / 32, rb = r % 32; int sc;
            if (rb < 16) sc = 32 * rb; else { const int q = rb - 16, pn = q >> 3, bj = (q >> 2) & 1, wc = q & 3; sc = 512 + 64 * (4 * pn + wc) + 32 * bj; }
            p0_transpose_item(p.in[6], NIN, D, 64 * kb, sc, (bf16_t*)(ws + WS_WIN), 32 * rb, p.in[5], scr, lane); continue; }
        r -= I_IN;
        { const int kb = r / 32, rb = r % 32; p0_transpose_item(p.in[12], D, D, 64 * kb, 32 * rb, (bf16_t*)(ws + WS_WOUT), 32 * rb, nullptr, scr, lane); }
    }
    for (int e8 = blockIdx.x * 512 + tid; e8 < 8 * 128 * 128 / 8; e8 += gridDim.x * 512) {
        const int e = e8 * 8, t = (e >> 7) & 127, s0 = e & 127;
        const f32x4 a = *(const f32x4*)(p.in[8] + e), b = *(const f32x4*)(p.in[8] + e + 4); f32x4 ma, mb;
#pragma unroll
        for (int j = 0; j < 4; ++j) { ma[j] = (s0 + j <= t) ? a[j] : 0.f; mb[j] = (s0 + 4 + j <= t) ? b[j] : 0.f; }
        *(u32x4*)((bf16_t*)(ws + WS_WM) + e) = pack8(ma, mb);
    }
    bf16_t* XB = (bf16_t*)(ws + WS_XB); float* ss = (float*)(ws + WS_SS);
    for (int i = blockIdx.x * 512 + tid; i < 3 * M / 4; i += gridDim.x * 512) ((f32x4*)(ss + SS_STRIDE))[i] = (f32x4){0.f, 0.f, 0.f, 0.f};
    for (int m = gw; m < M; m += 4 * NGW) {
        f32x4 v[4][4];
#pragma unroll
        for (int q = 0; q < 4; ++q) { const int mq = (m + q * NGW < M) ? m + q * NGW : m; const f32x4* xr = (const f32x4*)(p.in[0] + (size_t)mq * D) + lane;
#pragma unroll
            for (int j = 0; j < 4; ++j) v[q][j] = __builtin_nontemporal_load(xr + 64 * j); }
#pragma unroll
        for (int q = 0; q < 4; ++q) { const int mq = m + q * NGW; if (mq < M) {
            float sq = 0.f;
#pragma unroll
            for (int j = 0; j < 4; ++j) sq += (v[q][j][0] * v[q][j][0] + v[q][j][1] * v[q][j][1]) + (v[q][j][2] * v[q][j][2] + v[q][j][3] * v[q][j][3]);
            sq = wave_sum(sq);
            u32x2* o = (u32x2*)(XB + (size_t)mq * D) + lane;
#pragma unroll
            for (int j = 0; j < 4; ++j) { u32x2 w; w.x = pg8::cvt_pk_bf16(v[q][j][0], v[q][j][1]); w.y = pg8::cvt_pk_bf16(v[q][j][2], v[q][j][3]); o[64 * j] = w; }
            if (lane == 0) ss[mq] = sq; } }
    }
}

__device__ __forceinline__ f32x4 unpack4(const u32x2 z) { return (f32x4){bf_lo(z.x), bf_hi(z.x), bf_lo(z.y), bf_hi(z.y)}; }
template <int WIN> __device__ __forceinline__ void pool_task(const bf16_t* __restrict__ zc, bf16_t* __restrict__ yc, const size_t Rt, const int pos0, const f32x4 sc) {
    constexpr int H = WIN - 1;
    u32x2 raw[H + 8];
#pragma unroll
    for (int i = 0; i < H + 8; ++i) { const bool ok = pos0 - H + i >= 0; raw[i] = *(const u32x2*)(zc + (ok ? Rt - H + i : Rt) * AW); if (!ok) raw[i] = (u32x2){0u, 0u}; }
    f32x4 s = (f32x4){0.f, 0.f, 0.f, 0.f};
#pragma unroll
    for (int i = 0; i < H; ++i) s += unpack4(raw[i]);
#pragma unroll
    for (int t = 0; t < 8; ++t) {
        const f32x4 zt = unpack4(raw[H + t]); s += zt;
        const int pos = pos0 + t, cnt = (pos + 1 < WIN) ? pos + 1 : WIN; const float inv = 1.0f / (float)cnt;
        const f32x4 o = (s * inv - zt) * sc;
        u32x2 w; w.x = pg8::cvt_pk_bf16(o[0], o[1]); w.y = pg8::cvt_pk_bf16(o[2], o[3]);
        *(u32x2*)(yc + (Rt + t) * D) = w;
        s -= unpack4(raw[t]);
    }
}
__device__ __forceinline__ void p4_mixer(const Params& p, LAS unsigned char* lds, int tid, int wave, int lane) {
    unsigned char* ws = p.ws;
    const bf16_t* __restrict__ U = (const bf16_t*)(ws + WS_U); const bf16_t* __restrict__ V = (const bf16_t*)(ws + WS_V); const bf16_t* __restrict__ Z = (const bf16_t*)(ws + WS_Z); bf16_t* __restrict__ Y = (bf16_t*)(ws + WS_Y);
    const bf16_t* __restrict__ Wm = (const bf16_t*)(ws + WS_WM); const float* __restrict__ bs = p.in[9]; const float* __restrict__ pscale = p.in[11]; const float* __restrict__ vgain = p.in[7];
    constexpr int P = 136;
    LAS bf16_t* Vt = (LAS bf16_t*)lds;
    const int fr = lane & 15, fq = lane >> 4;
    for (int chunk = blockIdx.x; chunk < M / 128; chunk += gridDim.x) {
        const size_t R0 = (size_t)chunk * 128;
        {
            const int s = tid & 127, cq0 = tid >> 7; const bf16_t* vrow = V + (R0 + s) * AW + 8 * cq0; u32x4 v[16];
#pragma unroll
            for (int it = 0; it < 16; ++it) v[it] = *(const u32x4*)(vrow + 32 * it);
#pragma unroll
            for (int it = 0; it < 16; ++it) { LAS bf16_t* d = Vt + (8 * (cq0 + 4 * it)) * P + s;
                d[0 * P] = (bf16_t)(v[it].x & 0xffffu); d[1 * P] = (bf16_t)(v[it].x >> 16); d[2 * P] = (bf16_t)(v[it].y & 0xffffu); d[3 * P] = (bf16_t)(v[it].y >> 16);
                d[4 * P] = (bf16_t)(v[it].z & 0xffffu); d[5 * P] = (bf16_t)(v[it].z >> 16); d[6 * P] = (bf16_t)(v[it].w & 0xffffu); d[7 * P] = (bf16_t)(v[it].w >> 16); }
        }
        __syncthreads();
#pragma unroll 2
        for (int i = 0; i < 8; ++i) {
            const int h = i, ts = (wave + i) & 7, t = 16 * ts + fr;
            const size_t row = R0 + t;
            const bf16_t* wrow = Wm + (size_t)(h * 128 + t) * 128 + 8 * fq;
            bf16x8 wf[4];
#pragma unroll
            for (int ks = 0; ks < 4; ++ks) wf[ks] = *(const bf16x8*)(wrow + 32 * ks);
            const float bias = bs[h * 128 + t];
            u32x2 uu[4]; f32x4 gn[4];
#pragma unroll
            for (int nb = 0; nb < 4; ++nb) { const int col = 64 * h + 16 * nb + 4 * fq; uu[nb] = *(const u32x2*)(U + row * AW + col); gn[nb] = *(const f32x4*)(vgain + col); }
            f32x4 acc[4];
#pragma unroll
            for (int nb = 0; nb < 4; ++nb) acc[nb] = (f32x4){0.f, 0.f, 0.f, 0.f};
            const int nks = (ts >> 1) + 1;
#pragma unroll
            for (int ks = 0; ks < 4; ++ks) if (ks < nks) {
#pragma unroll
                for (int nb = 0; nb < 4; ++nb) { const bf16x8 vf = *(const LAS bf16x8*)(Vt + (64 * h + 16 * nb + fr) * P + 32 * ks + 8 * fq);
                    acc[nb] = __builtin_amdgcn_mfma_f32_16x16x32_bf16(vf, wf[ks], acc[nb], 0, 0, 0); }
            }
#pragma unroll
            for (int nb = 0; nb < 4; ++nb) { const int col = 64 * h + 16 * nb + 4 * fq;
                u32x2 w; w.x = pg8::cvt_pk_bf16(bf_lo(uu[nb].x) * (acc[nb][0] * gn[nb][0] + bias), bf_hi(uu[nb].x) * (acc[nb][1] * gn[nb][1] + bias));
                w.y = pg8::cvt_pk_bf16(bf_lo(uu[nb].y) * (acc[nb][2] * gn[nb][2] + bias), bf_hi(uu[nb].y) * (acc[nb][3] * gn[nb][3] + bias));
                *(u32x2*)(Y + row * D + col) = w; }
        }
        {
            const int g = wave & 3, cq = 32 * g + (lane & 31), q4 = (wave >> 2) * 2 + (lane >> 5);
            const bf16_t* zc = Z + 4 * cq; bf16_t* yc = Y + 512 + 4 * cq; const f32x4 sc = *(const f32x4*)(pscale + 4 * cq);
            const int pb = (chunk & 31) * 128 + 32 * q4; const size_t Rb = R0 + 32 * q4;
#pragma unroll 1
            for (int k = 0; k < 4; ++k) {
                if (g == 0) pool_task<2>(zc, yc, Rb + 8 * k, pb + 8 * k, sc);
                else if (g == 1) pool_task<4>(zc, yc, Rb + 8 * k, pb + 8 * k, sc);
                else if (g == 2) pool_task<8>(zc, yc, Rb + 8 * k, pb + 8 * k, sc);
                else pool_task<16>(zc, yc, Rb + 8 * k, pb + 8 * k, sc);
            }
        }
        __syncthreads();
    }
}

__device__ __forceinline__ void p8_final(const Params& p, int wave, int lane) {
    const float* ss = (const float*)(p.ws + WS_SS) + 3 * SS_STRIDE; const float* g = p.in[17];
    const int gw = blockIdx.x * 8 + wave, NGW = gridDim.x * 8;
    f32x4 gv[4];
#pragma unroll
    for (int j = 0; j < 4; ++j) gv[j] = ((const f32x4*)g)[lane + 64 * j];
    for (int m = gw; m < M; m += 4 * NGW) {
        f32x4 v[4][4]; float sv[4];
#pragma unroll
        for (int q = 0; q < 4; ++q) { const int mq = (m + q * NGW < M) ? m + q * NGW : m; const f32x4* xr = (const f32x4*)(p.out + (size_t)mq * D) + lane;
#pragma unroll
            for (int j = 0; j < 4; ++j) v[q][j] = xr[64 * j];
            sv[q] = ss[mq]; }
#pragma unroll
        for (int q = 0; q < 4; ++q) { const int mq = m + q * NGW; if (mq < M) {
            const float s0 = sv[q];
            const float r0 = __builtin_amdgcn_rsqf(s0 * (1.0f / 1024.0f) + EPS);
            f32x4* xo = (f32x4*)(p.out + (size_t)mq * D) + lane;
#pragma unroll
            for (int j = 0; j < 4; ++j) __builtin_nontemporal_store(v[q][j] * r0 * gv[j], xo + 64 * j); } }
    }
}

#define XB_TMO      128
#define XB_XCNT(j)  (256  + 64 * (j))
#define XB_XSUB(j)  (1280 + 64 * (j))
#define XB_XGEN(j)  (2304 + 64 * (j))
#define XB_TOP      3328
#define XB_TOPGEN   3392
#define XCD_BAR_WORDS 3456
#define XB_SPIN_CAP (1u << 18)

__device__ __forceinline__ unsigned xb_ld(unsigned* p)              { return __hip_atomic_load(p, __ATOMIC_RELAXED, __HIP_MEMORY_SCOPE_AGENT); }
__device__ __forceinline__ unsigned xb_add(unsigned* p, unsigned v) { return __hip_atomic_fetch_add(p, v, __ATOMIC_RELAXED, __HIP_MEMORY_SCOPE_AGENT); }
__device__ __forceinline__ unsigned xb_xcc_id() { return (unsigned)__builtin_amdgcn_s_getreg((3 << 11) | 20) & 0xFu; }
#define XB_SPIN(cond, bar) do { unsigned _sp = 0; while (cond) { __builtin_amdgcn_s_sleep(1); \
    if ((++_sp & 255u) == 0u) { if (xb_ld(&(bar)[XB_TMO])) break; if (_sp > XB_SPIN_CAP) { atomicAdd(&(bar)[XB_TMO], 1u); break; } } } } while (0)

struct XcdBarrier {
    unsigned* bar; unsigned x;
    volatile __attribute__((address_space(3))) unsigned* st;
};

__device__ __forceinline__ XcdBarrier xcd_barrier_post(unsigned* bar, volatile __attribute__((address_space(3))) unsigned* st) {
    XcdBarrier b; b.bar = bar; b.x = xb_xcc_id(); b.st = st;
    if (threadIdx.x == 0) (void)xb_add(&bar[XB_XCNT(b.x)], 1u);
    return b;
}
__device__ __forceinline__ void xcd_barrier_complete(unsigned* bar, unsigned x, unsigned& nloc, unsigned& nx) {
    const unsigned G = gridDim.x * gridDim.y * gridDim.z;
    unsigned sum, cnt, mine, sp = 0u;
    for (;;) {
        sum = 0u; cnt = 0u; mine = 0u;
#pragma unroll
        for (unsigned j = 0; j < 16; ++j) { const unsigned c = xb_ld(&bar[XB_XCNT(j)]); sum += c; cnt += (c > 0u) ? 1u : 0u; mine = (j == x) ? c : mine; }
        if (sum == G) break;
        __builtin_amdgcn_s_sleep(1);
        if ((++sp & 255u) == 0u) { if (xb_ld(&bar[XB_TMO])) break; if (sp > XB_SPIN_CAP) { atomicAdd(&bar[XB_TMO], 1u); break; } }
    }
    nloc = mine > 0u ? mine : 1u; nx = cnt > 0u ? cnt : 1u;
}

__device__ __forceinline__ void xcd_barrier(const XcdBarrier& b) {
    asm volatile("s_waitcnt vmcnt(0)" ::: "memory");
    __syncthreads();
    if (threadIdx.x == 0) {
        unsigned* bar = b.bar;
        __builtin_amdgcn_s_waitcnt(0);
        unsigned nloc = b.st[0], nx = b.st[1];
        if (nloc == 0u) { xcd_barrier_complete(bar, b.x, nloc, nx); b.st[0] = nloc; b.st[1] = nx; }
        const unsigned old = xb_add(&bar[XB_XSUB(b.x)], 1u);
        const unsigned gen = old / nloc;
        if (old + 1u == (gen + 1u) * nloc) {
            __builtin_amdgcn_fence(__ATOMIC_RELEASE, "agent");
            asm volatile("s_waitcnt vmcnt(0)" ::: "memory");
            const unsigned og = xb_add(&bar[XB_TOP], 1u);
            const unsigned tg = og / nx;
            if (og + 1u == (tg + 1u) * nx) xb_add(&bar[XB_TOPGEN], 1u);
            else XB_SPIN(xb_ld(&bar[XB_TOPGEN]) == tg, bar);
            __builtin_amdgcn_fence(__ATOMIC_ACQUIRE, "agent");
            xb_add(&bar[XB_XGEN(b.x)], 1u);
            asm volatile("s_waitcnt vmcnt(0)" ::: "memory");
        } else {
            XB_SPIN(xb_ld(&bar[XB_XGEN(b.x)]) == gen, bar);
            __builtin_amdgcn_fence(__ATOMIC_ACQUIRE, "agent");
            asm volatile("s_waitcnt vmcnt(0)" ::: "memory");
        }
    }
    __syncthreads();
}

template <int PH> __device__ __forceinline__ void run_phase(const Params& p, LAS unsigned char* lds, const int wave0) {
    int tid = wave0 * 64 + (int)__builtin_amdgcn_mbcnt_hi(~0u, __builtin_amdgcn_mbcnt_lo(~0u, 0u)); asm volatile("" : "+v"(tid));
    const int lane = tid & 63, wave = __builtin_amdgcn_readfirstlane(tid >> 6);
    unsigned char* ws = p.ws;
    bf16_t* XB = (bf16_t*)(ws + WS_XB); bf16_t* ACT = (bf16_t*)(ws + WS_ACT); float* ss = (float*)(ws + WS_SS);
    const int G = gridDim.x, c = blockIdx.x;
    if constexpr (PH == 0) p0_prep(p, lds, tid, wave, lane);
    if constexpr (PH == 1 || PH == 6) {
        pg8::Gemm g{XB, (const bf16_t*)(ws + (PH == 1 ? WS_W1A : WS_W2A)), M, 2 * FF, D}; pg8::StaticOrder S; S.init(M, 2 * FF, G, c);
        EpiSwiglu E{ACT, ss + (PH == 1 ? 0 : 2) * SS_STRIDE};
        pg8::gemm_phase<EpiSwiglu, pg8::StaticOrder, true, true>(lds, g, S, E, tid);
    }
    if constexpr (PH == 2 || PH == 7) {
        pg8::Gemm g{ACT, (const bf16_t*)(ws + (PH == 2 ? WS_W1D : WS_W2D)), M, D, FF}; pg8::StaticOrder S; S.init(M, D, G, c);
        EpiRes E{PH == 2 ? p.in[0] : p.out, p.out, PH == 2 ? XB : nullptr, ss + (PH == 2 ? 1 : 3) * SS_STRIDE, 0.5f};
        pg8::gemm_phase<EpiRes, pg8::StaticOrder, true, true>(lds, g, S, E, tid);
    }
    if constexpr (PH == 3) {
        pg8::Gemm g{XB, (const bf16_t*)(ws + WS_WIN), M, NIN, D}; pg8::StaticOrder S; S.init(M, NIN, G, c);
        EpiWin E{(bf16_t*)(ws + WS_U), (bf16_t*)(ws + WS_V), (bf16_t*)(ws + WS_Z), ss + SS_STRIDE};
        pg8::gemm_phase<EpiWin, pg8::StaticOrder, true, true>(lds, g, S, E, tid);
    }
    if constexpr (PH == 4) p4_mixer(p, lds, tid, wave, lane);
    if constexpr (PH == 5) {
        pg8::Gemm g{(const bf16_t*)(ws + WS_Y), (const bf16_t*)(ws + WS_WOUT), M, D, D}; pg8::StaticOrder S; S.init(M, D, G, c);
        EpiRes E{p.out, p.out, XB, ss + 2 * SS_STRIDE, 1.0f};
        pg8::gemm_phase<EpiRes, pg8::StaticOrder, true, true>(lds, g, S, E, tid);
    }
    if constexpr (PH == 8) p8_final(p, wave, lane);
}
__global__ void __launch_bounds__(512, 2) fwd(Params p) {
    extern __shared__ __attribute__((aligned(16))) unsigned char lds_raw[];
    LAS unsigned char* lds = (LAS unsigned char*)lds_raw;
    const int wave0 = __builtin_amdgcn_readfirstlane(threadIdx.x >> 6);
    const int lo = p.ph_lo, hi = p.ph_hi;
    volatile LAS unsigned* st = (volatile LAS unsigned*)(lds + LDS_BYTES - 64);
    if (threadIdx.x < 2) st[threadIdx.x] = 0u;
    __syncthreads();
    XcdBarrier bar; bar.bar = (unsigned*)(p.ws + WS_CTL); bar.x = 0; bar.st = st;
    const bool use_cg = hi > 9;
    if (hi - lo > 1 && !use_cg) bar = xcd_barrier_post((unsigned*)(p.ws + WS_CTL), st);
#define MK_SEAM() do { if (use_cg) cg::this_grid().sync(); else xcd_barrier(bar); } while (0)
#define MK_PHASE(k) if (lo <= (k) && (k) < hi) { if ((PHM >> (k)) & 1) run_phase<k>(p, lds, wave0); if (PROBE_REP == (k)) { MK_SEAM(); run_phase<k>(p, lds, wave0); } if ((k) + 1 < hi) MK_SEAM(); }
    MK_PHASE(0) MK_PHASE(1) MK_PHASE(2) MK_PHASE(3) MK_PHASE(4) MK_PHASE(5) MK_PHASE(6) MK_PHASE(7) MK_PHASE(8)
#undef MK_SEAM
#undef MK_PHASE
}
}

extern "C" void kernel_launch(void* const* d_in, const int* in_sizes, int n_in, void* d_out, int out_size, void* d_ws, size_t ws_size, hipStream_t stream) {
    static int grid = 0;
    if (grid == 0) {
        if (n_in != 18 || out_size != mk::M * mk::D || ws_size < mk::WS_END) { fprintf(stderr, "kernel_launch: unexpected shapes (n_in %d out %d ws %zu)\n", n_in, out_size, ws_size); grid = -1; return; }
        int dev = 0, cus = 0;
        if (hipGetDevice(&dev) != hipSuccess || hipDeviceGetAttribute(&cus, hipDeviceAttributeMultiprocessorCount, dev) != hipSuccess) { grid = -1; return; }
        if (hipFuncSetAttribute((const void*)mk::fwd, hipFuncAttributeMaxDynamicSharedMemorySize, mk::LDS_BYTES) != hipSuccess) { fprintf(stderr, "kernel_launch: hipFuncSetAttribute failed\n"); grid = -1; return; }
        grid = cus;
    }
    if (grid < 0) return;
    mk::Params p{};
    for (int i = 0; i < 18; ++i) p.in[i] = (const float*)d_in[i];
    p.out = (float*)d_out; p.ws = (unsigned char*)d_ws;
#if MK_LAUNCHES == 1
    if (hipMemsetAsync((char*)d_ws + mk::WS_CTL, 0, mk::CTL_BYTES, stream) != hipSuccess) { fprintf(stderr, "kernel_launch: memset of the barrier words failed\n"); return; }
    p.ph_lo = 0; p.ph_hi = 9;
    void* args[] = {&p};
    hipError_t e = hipLaunchCooperativeKernel((const void*)mk::fwd, dim3(grid), dim3(512), args, mk::LDS_BYTES, stream);
    if (e != hipSuccess) fprintf(stderr, "cooperative launch failed: %s (grid %d)\n", hipGetErrorString(e), grid);
#else
    for (int ph = 0; ph < 9; ++ph) { p.ph_lo = ph; p.ph_hi = ph + 1; hipLaunchKernelGGL(mk::fwd, dim3(grid), dim3(512), mk::LDS_BYTES, stream, p); }
#endif
}
```

```cpp
#include <hip/hip_runtime.h>
#include <hip/hip_cooperative_groups.h>
#include <cstdio>
#include <cstdint>
namespace cg = cooperative_groups;
#ifndef PHM
#define PHM 0x1ff
#endif
#ifndef PROBE_REP
#define PROBE_REP -1
#endif
#ifndef MK_LAUNCHES
#define MK_LAUNCHES 1
#endif
namespace pg8 {
#define PG8_LAS __attribute__((address_space(3)))
typedef unsigned short bf16_t;
typedef short bf16x8 __attribute__((ext_vector_type(8)));
typedef float f32x4 __attribute__((ext_vector_type(4)));
typedef unsigned u32x4 __attribute__((ext_vector_type(4)));
constexpr int BM = 256, BK = 64, HALF = 128, HTB = HALF * BK * 2  , STAGE_BYTES = 8 * HTB, NXCD = 8, WGM = 8;

__host__ __device__ __forceinline__ int lds_byte(int r, int c) { const int st = (r >> 4) * 2 + (c >> 5), rr = r & 15, cc = c & 31, ob = rr * 64 + cc * 2; return st * 1024 + (ob ^ (((ob >> 9) & 1) << 5)); }
__host__ __device__ __forceinline__ void stage_rc(int b, int& R, int& C) { const int st = b / 1024, sb = b % 1024, swz = sb ^ (((sb >> 9) & 1) << 5); R = (st >> 1) * 16 + swz / 64; C = (st & 1) * 32 + (swz % 64) / 2; }
__host__ __device__ __forceinline__ int perm32(int rho) { const int n = rho >> 4, i = rho & 15; return 8 * (i >> 2) + 4 * n + (i & 3); }

struct Unit { int pm, pn; };
struct Gemm { const bf16_t* A; const bf16_t* Bt; int M, N, K; };

struct StaticOrder {
    int nM, nN, nwg, G, c;
    __host__ __device__ void init(int M, int N, int G_, int c_) { nM = M / BM; nN = N / BM; nwg = nM * nN; G = G_; c = c_; }
    __host__ __device__ bool next(int i, Unit& u) const {
        const long L = (long)i * G + c; if (L >= nwg) return false;
        int wgid = (int)L; { const int q = nwg / NXCD, r = nwg % NXCD, xcd = wgid % NXCD, off = wgid / NXCD; wgid = (xcd < r ? xcd * (q + 1) : r * (q + 1) + (xcd - r) * q) + off; }
        const int nig = WGM * nN, gid = wgid / nig, fm = gid * WGM, gsz = (nM - fm) < WGM ? (nM - fm) : WGM;
        u.pm = fm + ((wgid % nig) % gsz); u.pn = (wgid % nig) / gsz; return true;
    }
    __device__ __forceinline__ void a_ready(const Unit&) const {}
    __device__ __forceinline__ void done(const Unit&) const {}
};
__device__ __forceinline__ unsigned cvt_pk_bf16(float lo, float hi) { unsigned r; asm volatile("v_cvt_pk_bf16_f32 %0, %1, %2" : "=v"(r) : "v"(lo), "v"(hi)); return r; }
template <class Epi, class Sched, bool ALIGN_EPI = false, bool SP2 = false>
__device__ __forceinline__ void gemm_phase(PG8_LAS unsigned char* lds, const Gemm g, const Sched& S, const Epi& E, const int tid) {
    const int wid = __builtin_amdgcn_readfirstlane(tid >> 6), lane = tid & 63, wr = wid >> 2, wc = wid & 3, fr = lane & 15, fq = lane >> 4;
    const int K = g.K, nt = K / BK;
    unsigned voffA[2], voffB[2];
#pragma unroll
    for (int i = 0; i < 2; ++i) { int R, C; stage_rc(tid * 16 + i * 8192, R, C); const int Rb = Epi::PERM ? ((R & ~31) + perm32(R & 31)) : R;
        voffA[i] = (unsigned)(R * K + C) * 2u; voffB[i] = (unsigned)(Rb * K + C) * 2u; }
    const size_t kstep = (size_t)(BK * 2);
    const size_t hstep = (size_t)HALF * K * 2;
    const size_t tstep = 2 * hstep;
    const unsigned ldsw = (unsigned)wid * 1024u;
    const int aoff = lds_byte(wr * 64 + fr, fq * 8), boff = lds_byte(wc * 32 + fr, fq * 8);
#define PG8_SA(b, h) (((b) * 2 + (h)) * HTB)
#define PG8_SB(b, h) ((4 + (b) * 2 + (h)) * HTB)
#define PG8_STAGE(bufoff, gbase, voff) do { _Pragma("unroll") for (int _i = 0; _i < 2; ++_i) \
        __builtin_amdgcn_global_load_lds((const unsigned*)((const char*)(gbase) + (voff)[_i]), (PG8_LAS unsigned*)(lds + (bufoff) + ldsw + _i * 8192), 16, 0, 0); } while (0)
#define PG8_LDA(dst, b, h) do { _Pragma("unroll") for (int m = 0; m < 4; ++m) _Pragma("unroll") for (int k = 0; k < 2; ++k) dst[m][k] = *(const PG8_LAS bf16x8*)(lds + PG8_SA(b, h) + aoff + m * 2048 + k * 1024); } while (0)
#define PG8_LDB(dst, b, h) do { _Pragma("unroll") for (int n = 0; n < 2; ++n) _Pragma("unroll") for (int k = 0; k < 2; ++k) dst[n][k] = *(const PG8_LAS bf16x8*)(lds + PG8_SB(b, h) + boff + n * 2048 + k * 1024); } while (0)
#define PG8_MMA(ai, bj, At, Bt) do { __builtin_amdgcn_s_setprio(1); _Pragma("unroll") for (int m = 0; m < 4; ++m) _Pragma("unroll") for (int n = 0; n < 2; ++n) _Pragma("unroll") for (int k = 0; k < 2; ++k) \
        acc[ai][bj][m][n] = __builtin_amdgcn_mfma_f32_16x16x32_bf16(Bt[n][k], At[m][k], acc[ai][bj][m][n], 0, 0, 0); __builtin_amdgcn_s_setprio(0); } while (0)
#define PG8_WAIT_V(n) asm volatile("s_waitcnt vmcnt(" #n ")" ::: "memory")
#define PG8_WAIT_L(n) asm volatile("s_waitcnt lgkmcnt(" #n ")" ::: "memory")
#define PG8_BAR __builtin_amdgcn_s_barrier()
#define PG8_SCHED __builtin_amdgcn_sched_barrier(0)
    Unit cur, nxt; int ui = 0;
    if (!S.next(0, cur)) return;
    f32x4 acc[2][2][4][2];
#pragma unroll
    for (int a = 0; a < 2; ++a)
#pragma unroll
        for (int b = 0; b < 2; ++b)
#pragma unroll
            for (int m = 0; m < 4; ++m)
#pragma unroll
                for (int n = 0; n < 2; ++n) acc[a][b][m][n] = (f32x4){0.f, 0.f, 0.f, 0.f};
    bf16x8 At[4][2], B0[2][2], B1[2][2];
    const char* cA = (const char*)g.A + (size_t)cur.pm * tstep; const char* cB = (const char*)g.Bt + (size_t)cur.pn * tstep;
    S.a_ready(cur);
    if constexpr (SP2) {
        PG8_STAGE(PG8_SB(0, 0), cB, voffB); PG8_STAGE(PG8_SB(0, 1), cB + hstep, voffB); PG8_STAGE(PG8_SA(0, 0), cA, voffA); PG8_STAGE(PG8_SA(0, 1), cA + hstep, voffA);
        if (wr == 1) PG8_BAR;
        PG8_WAIT_V(2); PG8_BAR;
        PG8_STAGE(PG8_SB(1, 0), cB + kstep, voffB); PG8_STAGE(PG8_SA(1, 0), cA + kstep, voffA); PG8_STAGE(PG8_SB(1, 1), cB + hstep + kstep, voffB);
        PG8_WAIT_V(6); PG8_BAR;
    } else {
        PG8_STAGE(PG8_SB(0, 0), cB, voffB); PG8_STAGE(PG8_SA(0, 0), cA, voffA); PG8_STAGE(PG8_SB(0, 1), cB + hstep, voffB); PG8_STAGE(PG8_SA(0, 1), cA + hstep, voffA);
        if (wr == 1) PG8_BAR;
        PG8_WAIT_V(4); PG8_BAR;
        PG8_STAGE(PG8_SB(1, 0), cB + kstep, voffB); PG8_STAGE(PG8_SA(1, 0), cA + kstep, voffA); PG8_STAGE(PG8_SB(1, 1), cB + hstep + kstep, voffB);
        PG8_WAIT_V(6); PG8_BAR;
    }
    for (;;) {
        const bool has_next = S.next(ui + 1, nxt);
        const char* nA = has_next ? (const char*)g.A + (size_t)nxt.pm * tstep : cA; const char* nB = has_next ? (const char*)g.Bt + (size_t)nxt.pn * tstep : cB;
        for (int t = 0; t < nt; t += 2) {
            const bool last = (t == nt - 2);
            const char* a1 = cA + (size_t)(t + 1) * kstep;
            const char* a2 = last ? nA : cA + (size_t)(t + 2) * kstep; const char* b2 = last ? nB : cB + (size_t)(t + 2) * kstep;
            const char* a3 = a2 + kstep; const char* b3 = b2 + kstep;
            if (last && has_next) S.a_ready(nxt);
            if constexpr (SP2) {
            PG8_LDB(B0, 0, 0); PG8_LDB(B1, 0, 1); PG8_SCHED; PG8_LDA(At, 0, 0); PG8_STAGE(PG8_SA(1, 1), a1 + hstep, voffA);
            PG8_WAIT_V(8); PG8_WAIT_L(0); PG8_BAR; PG8_MMA(0, 0, At, B0); PG8_MMA(0, 1, At, B1); PG8_BAR; PG8_SCHED;
            PG8_LDA(At, 0, 1); PG8_STAGE(PG8_SB(0, 0), b2, voffB); PG8_STAGE(PG8_SB(0, 1), b2 + hstep, voffB); PG8_STAGE(PG8_SA(0, 0), a2, voffA);
            PG8_WAIT_V(8); PG8_WAIT_L(0); PG8_BAR; PG8_MMA(1, 0, At, B0); PG8_MMA(1, 1, At, B1); PG8_BAR; PG8_SCHED;
            PG8_LDB(B0, 1, 0); PG8_LDB(B1, 1, 1); PG8_SCHED; PG8_LDA(At, 1, 0); PG8_STAGE(PG8_SA(0, 1), a2 + hstep, voffA);
            PG8_WAIT_V(8); PG8_WAIT_L(0); PG8_BAR; PG8_MMA(0, 0, At, B0); PG8_MMA(0, 1, At, B1); PG8_BAR; PG8_SCHED;
            PG8_LDA(At, 1, 1); PG8_STAGE(PG8_SB(1, 0), b3, voffB); PG8_STAGE(PG8_SB(1, 1), b3 + hstep, voffB); PG8_STAGE(PG8_SA(1, 0), a3, voffA);
            PG8_WAIT_V(8); PG8_WAIT_L(0); PG8_BAR; PG8_MMA(1, 0, At, B0); PG8_MMA(1, 1, At, B1); PG8_BAR; PG8_SCHED;
            } else {
            PG8_LDB(B0, 0, 0); PG8_SCHED; PG8_LDA(At, 0, 0); PG8_STAGE(PG8_SA(1, 1), a1 + hstep, voffA);
            PG8_WAIT_L(8); PG8_BAR; PG8_WAIT_L(0); PG8_MMA(0, 0, At, B0); PG8_BAR; PG8_SCHED;
            PG8_LDB(B1, 0, 1); PG8_STAGE(PG8_SB(0, 0), b2, voffB);
            PG8_BAR; PG8_WAIT_L(0); PG8_MMA(0, 1, At, B1); PG8_BAR;
            PG8_LDA(At, 0, 1); PG8_STAGE(PG8_SA(0, 0), a2, voffA);
            PG8_BAR; PG8_WAIT_L(0); PG8_MMA(1, 0, At, B0); PG8_BAR; PG8_SCHED;
            PG8_STAGE(PG8_SB(0, 1), b2 + hstep, voffB);
            PG8_WAIT_V(6); PG8_BAR; PG8_MMA(1, 1, At, B1); PG8_BAR;
            PG8_LDB(B0, 1, 0); PG8_SCHED; PG8_LDA(At, 1, 0); PG8_STAGE(PG8_SA(0, 1), a2 + hstep, voffA);
            PG8_WAIT_L(8); PG8_BAR; PG8_WAIT_L(0); PG8_MMA(0, 0, At, B0); PG8_BAR; PG8_SCHED;
            PG8_LDB(B1, 1, 1); PG8_STAGE(PG8_SB(1, 0), b3, voffB);
            PG8_BAR; PG8_WAIT_L(0); PG8_MMA(0, 1, At, B1); PG8_BAR;
            PG8_LDA(At, 1, 1); PG8_STAGE(PG8_SA(1, 0), a3, voffA);
            PG8_BAR; PG8_WAIT_L(0); PG8_MMA(1, 0, At, B0); PG8_BAR; PG8_SCHED;
            PG8_STAGE(PG8_SB(1, 1), b3 + hstep, voffB);
            PG8_WAIT_V(6); PG8_BAR; PG8_MMA(1, 1, At, B1); PG8_BAR;
            }
        }
        if constexpr (ALIGN_EPI) { if (wr == 0) PG8_BAR; }
        if constexpr (!Epi::AFTER_DRAIN) { E(acc, cur, wr, wc, fr, fq); S.done(cur); }
        if (!has_next) break;
#pragma unroll
        for (int a = 0; a < 2; ++a)
#pragma unroll
            for (int b = 0; b < 2; ++b)
#pragma unroll
                for (int m = 0; m < 4; ++m)
#pragma unroll
                    for (int n = 0; n < 2; ++n) acc[a][b][m][n] = (f32x4){0.f, 0.f, 0.f, 0.f};
        cur = nxt; cA = nA; cB = nB; ++ui;
        if constexpr (ALIGN_EPI) { if (wr == 1) PG8_BAR; }
    }
    PG8_WAIT_V(0);
    if constexpr (!ALIGN_EPI) { if (wr == 0) PG8_BAR; }
    PG8_BAR;
    if constexpr (Epi::AFTER_DRAIN) { E.fused(acc, cur, wr, wc, fr, fq, lds, wid, lane); S.done(cur); }
#undef PG8_SA
#undef PG8_SB
#undef PG8_STAGE
#undef PG8_LDA
#undef PG8_LDB
#undef PG8_MMA
#undef PG8_WAIT_V
#undef PG8_WAIT_L
#undef PG8_BAR
#undef PG8_SCHED
}
}

namespace mk {
using pg8::bf16_t; using pg8::f32x4; using pg8::u32x4; using pg8::bf16x8; using pg8::Unit;
#define LAS __attribute__((address_space(3)))
typedef unsigned u32x2 __attribute__((ext_vector_type(2)));
constexpr int M = 32768, D = 1024, FF = 2816, NIN = 1536, AW = 512, SEQ = 4096;
constexpr float EPS = 1e-6f;
constexpr int LDS_BYTES = 147456;
constexpr size_t MiB = 1u << 20;
constexpr size_t WS_W1A = 0 * MiB, WS_W1D = 11 * MiB, WS_W2A = 17 * MiB, WS_W2D = 28 * MiB, WS_WIN = 34 * MiB, WS_WOUT = 37 * MiB, WS_WM = 39 * MiB, WS_SS = 40 * MiB,
                 WS_CTL = 41 * MiB, CTL_BYTES = 65536,  WS_XB = 42 * MiB, WS_ACT = 106 * MiB, WS_U = WS_ACT, WS_V = WS_ACT + 32 * MiB, WS_Z = WS_ACT + 64 * MiB, WS_Y = WS_ACT + 96 * MiB, WS_END = 282 * MiB;

__device__ __forceinline__ float silu_f(float g) { return g * __builtin_amdgcn_rcpf(1.0f + __builtin_amdgcn_exp2f(-1.4426950409f * g)); }
__device__ __forceinline__ float gelu_f(float v) { const float w = v + 0.044715f * v * v * v; return v * __builtin_amdgcn_rcpf(1.0f + __builtin_amdgcn_exp2f(-2.3022081981f * w)); }
__device__ __forceinline__ float bf_lo(unsigned w) { return __uint_as_float(w << 16); }
__device__ __forceinline__ float bf_hi(unsigned w) { return __uint_as_float(w & 0xffff0000u); }
__device__ __forceinline__ u32x4 pack8(const f32x4 a, const f32x4 b) { u32x4 w; w.x = pg8::cvt_pk_bf16(a[0], a[1]); w.y = pg8::cvt_pk_bf16(a[2], a[3]); w.z = pg8::cvt_pk_bf16(b[0], b[1]); w.w = pg8::cvt_pk_bf16(b[2], b[3]); return w; }
__device__ __forceinline__ float row_rstd(const float* ss, int row) { return __builtin_amdgcn_rsqf(ss[row] * (1.0f / 1024.0f) + EPS); }
constexpr size_t SS_STRIDE = 32768;
constexpr int CNT_WORD0 = 4096;

struct EpiSwiglu {
    static constexpr bool PERM = true, AFTER_DRAIN = false;
    bf16_t* O; const float* ss;
    __device__ __forceinline__ void operator()(const f32x4 (&acc)[2][2][4][2], const Unit& u, int wr, int wc, int fr, int fq) const {
        const int row0 = u.pm * 256 + wr * 64 + fr, col0 = u.pn * 128 + wc * 32 + 8 * fq;
        float r[2][4];
#pragma unroll
        for (int ai = 0; ai < 2; ++ai)
#pragma unroll
            for (int m = 0; m < 4; ++m) r[ai][m] = row_rstd(ss, row0 + ai * 128 + m * 16);
#pragma unroll
        for (int ai = 0; ai < 2; ++ai)
#pragma unroll
            for (int m = 0; m < 4; ++m) {
                const float rr = r[ai][m];
                f32x4 o0, o1;
#pragma unroll
                for (int e = 0; e < 4; ++e) { o0[e] = silu_f(acc[ai][0][m][0][e] * rr) * (acc[ai][1][m][0][e] * rr); o1[e] = silu_f(acc[ai][0][m][1][e] * rr) * (acc[ai][1][m][1][e] * rr); }
                *(u32x4*)(O + (size_t)(row0 + ai * 128 + m * 16) * FF + col0) = pack8(o0, o1);
            }
    }
};
template <bool BASE_F32> struct EpiRes {
    static constexpr bool PERM = true, AFTER_DRAIN = false;
    const float* basef; bf16_t* xb; float* ss; float alpha;
    __device__ __forceinline__ void operator()(const f32x4 (&acc)[2][2][4][2], const Unit& u, int wr, int wc, int fr, int fq) const {
        const unsigned off0 = (unsigned)(u.pm * 256 + wr * 64 + fr) * (unsigned)D + (unsigned)(u.pn * 256 + wc * 32 + 8 * fq);
        const unsigned sso = (unsigned)(u.pm * 256 + wr * 64 + fr);
#pragma unroll
        for (int ai = 0; ai < 2; ++ai)
#pragma unroll
            for (int m = 0; m < 4; ++m) {
                float sq = 0.f;
#pragma unroll
                for (int bj = 0; bj < 2; ++bj) {
                    const unsigned off = off0 + (unsigned)((ai * 128 + m * 16) * D + bj * 128);
                    f32x4 b0, b1;
                    if constexpr (BASE_F32) { b0 = *(const f32x4*)(basef + off); b1 = *(const f32x4*)(basef + off + 4); }
                    else { const u32x4 w = *(const u32x4*)(xb + off); b0 = (f32x4){bf_lo(w.x), bf_hi(w.x), bf_lo(w.y), bf_hi(w.y)}; b1 = (f32x4){bf_lo(w.z), bf_hi(w.z), bf_lo(w.w), bf_hi(w.w)}; }
                    const f32x4 v0 = b0 + acc[ai][bj][m][0] * alpha, v1 = b1 + acc[ai][bj][m][1] * alpha;
                    *(u32x4*)(xb + off) = pack8(v0, v1);
                    sq += (v0[0] * v0[0] + v0[1] * v0[1]) + (v0[2] * v0[2] + v0[3] * v0[3]) + (v1[0] * v1[0] + v1[1] * v1[1]) + (v1[2] * v1[2] + v1[3] * v1[3]);
                }
                sq += __shfl_xor(sq, 16); sq += __shfl_xor(sq, 32);
                if (fq == 0) __hip_atomic_fetch_add(ss + sso + (unsigned)(ai * 128 + m * 16), sq, __ATOMIC_RELAXED, __HIP_MEMORY_SCOPE_AGENT);
                if (m & 1) asm volatile("" ::: "memory");
            }
    }
};
struct EpiResFinal {
    static constexpr bool PERM = true, AFTER_DRAIN = false;
    const bf16_t* xb; float* out; float* ss; unsigned* cnt; const float* gfin; float alpha;
    __device__ __forceinline__ void operator()(f32x4 (&acc)[2][2][4][2], const Unit& u, int wr, int wc, int fr, int fq) const {
        const unsigned off0 = (unsigned)(u.pm * 256 + wr * 64 + fr) * (unsigned)D + (unsigned)(u.pn * 256 + wc * 32 + 8 * fq);
        const unsigned sso = (unsigned)(u.pm * 256 + wr * 64 + fr);
#pragma unroll
        for (int ai = 0; ai < 2; ++ai)
#pragma unroll
            for (int m = 0; m < 4; ++m) {
                float sq = 0.f;
#pragma unroll
                for (int bj = 0; bj < 2; ++bj) {
                    const unsigned off = off0 + (unsigned)((ai * 128 + m * 16) * D + bj * 128);
                    const u32x4 w = *(const u32x4*)(xb + off);
                    const f32x4 b0 = (f32x4){bf_lo(w.x), bf_hi(w.x), bf_lo(w.y), bf_hi(w.y)}, b1 = (f32x4){bf_lo(w.z), bf_hi(w.z), bf_lo(w.w), bf_hi(w.w)};
                    const f32x4 v0 = b0 + acc[ai][bj][m][0] * alpha, v1 = b1 + acc[ai][bj][m][1] * alpha;
                    acc[ai][bj][m][0] = v0; acc[ai][bj][m][1] = v1;
                    sq += (v0[0] * v0[0] + v0[1] * v0[1]) + (v0[2] * v0[2] + v0[3] * v0[3]) + (v1[0] * v1[0] + v1[1] * v1[1]) + (v1[2] * v1[2] + v1[3] * v1[3]);
                }
                sq += __shfl_xor(sq, 16); sq += __shfl_xor(sq, 32);
                if (fq == 0) __hip_atomic_fetch_add(ss + sso + (unsigned)(ai * 128 + m * 16), sq, __ATOMIC_RELAXED, __HIP_MEMORY_SCOPE_AGENT);
                asm volatile("" ::: "memory");
            }
        asm volatile("s_waitcnt vmcnt(0)" ::: "memory");
        unsigned* c = cnt + 64 * u.pm;
        if (fr == 0 && fq == 0) __hip_atomic_fetch_add(c, 1u, __ATOMIC_RELAXED, __HIP_MEMORY_SCOPE_AGENT);
        unsigned spins = 0;
        while ((unsigned)__builtin_amdgcn_readfirstlane(__hip_atomic_load(c, __ATOMIC_RELAXED, __HIP_MEMORY_SCOPE_AGENT)) < 32u) { __builtin_amdgcn_s_sleep(2); if (++spins > (1u << 20)) break; }
        f32x4 gv[2][2];
#pragma unroll
        for (int bj = 0; bj < 2; ++bj)
#pragma unroll
            for (int n = 0; n < 2; ++n) gv[bj][n] = *(const f32x4*)(gfin + u.pn * 256 + bj * 128 + wc * 32 + 8 * fq + 4 * n);
        float tot[2][4];
#pragma unroll
        for (int ai = 0; ai < 2; ++ai)
#pragma unroll
            for (int m = 0; m < 4; ++m) tot[ai][m] = __hip_atomic_load(ss + sso + (unsigned)(ai * 128 + m * 16), __ATOMIC_RELAXED, __HIP_MEMORY_SCOPE_AGENT);
#pragma unroll
        for (int ai = 0; ai < 2; ++ai)
#pragma unroll
            for (int m = 0; m < 4; ++m) { const float r = __builtin_amdgcn_rsqf(tot[ai][m] * (1.0f / 1024.0f) + EPS);
#pragma unroll
                for (int bj = 0; bj < 2; ++bj) { const unsigned off = off0 + (unsigned)((ai * 128 + m * 16) * D + bj * 128);
                    __builtin_nontemporal_store(acc[ai][bj][m][0] * r * gv[bj][0], (f32x4*)(out + off)); __builtin_nontemporal_store(acc[ai][bj][m][1] * r * gv[bj][1], (f32x4*)(out + off + 4)); } }
    }
};
struct EpiWin {
    static constexpr bool PERM = true, AFTER_DRAIN = false;
    bf16_t *U, *V, *Z; const float* ss;
    __device__ __forceinline__ void operator()(const f32x4 (&acc)[2][2][4][2], const Unit& u, int wr, int wc, int fr, int fq) const {
        const int row0 = u.pm * 256 + wr * 64 + fr;
        float r[2][4];
#pragma unroll
        for (int ai = 0; ai < 2; ++ai)
#pragma unroll
            for (int m = 0; m < 4; ++m) r[ai][m] = row_rstd(ss, row0 + ai * 128 + m * 16);
        if (u.pn < 2) {
            const int col0 = u.pn * 256 + wc * 32 + 8 * fq;
#pragma unroll
            for (int ai = 0; ai < 2; ++ai)
#pragma unroll
                for (int m = 0; m < 4; ++m) { const float rr = r[ai][m]; bf16_t* rowp = U + (size_t)(row0 + ai * 128 + m * 16) * AW + col0;
#pragma unroll
                    for (int bj = 0; bj < 2; ++bj) { f32x4 o0, o1;
#pragma unroll
                        for (int e = 0; e < 4; ++e) { o0[e] = gelu_f(acc[ai][bj][m][0][e] * rr); o1[e] = gelu_f(acc[ai][bj][m][1][e] * rr); }
                        *(u32x4*)(rowp + bj * 128) = pack8(o0, o1); } }
        } else if (u.pn < 4) {
            const int colb = 64 * ((u.pn - 2) * 4 + wc) + 8 * fq;
#pragma unroll
            for (int ai = 0; ai < 2; ++ai)
#pragma unroll
                for (int m = 0; m < 4; ++m) { const float rr = r[ai][m]; f32x4 g[2][2]; float sq = 0.f;
#pragma unroll
                    for (int bj = 0; bj < 2; ++bj)
#pragma unroll
                        for (int n = 0; n < 2; ++n)
#pragma unroll
                            for (int e = 0; e < 4; ++e) { const float t = gelu_f(acc[ai][bj][m][n][e] * rr); g[bj][n][e] = t; sq += t * t; }
                    sq += __shfl_xor(sq, 16); sq += __shfl_xor(sq, 32);
                    const float hr = __builtin_amdgcn_rsqf(sq * (1.0f / 64.0f) + EPS);
                    bf16_t* rowp = V + (size_t)(row0 + ai * 128 + m * 16) * AW + colb;
#pragma unroll
                    for (int bj = 0; bj < 2; ++bj) *(u32x4*)(rowp + 32 * bj) = pack8(g[bj][0] * hr, g[bj][1] * hr); }
        } else {
            const int col0 = (u.pn - 4) * 256 + wc * 32 + 8 * fq;
#pragma unroll
            for (int ai = 0; ai < 2; ++ai)
#pragma unroll
                for (int m = 0; m < 4; ++m) { const float rr = r[ai][m]; bf16_t* rowp = Z + (size_t)(row0 + ai * 128 + m * 16) * AW + col0;
#pragma unroll
                    for (int bj = 0; bj < 2; ++bj) *(u32x4*)(rowp + bj * 128) = pack8(acc[ai][bj][m][0] * rr, acc[ai][bj][m][1] * rr); }
        }
    }
};

__device__ __forceinline__ float wave_sum(float v) {
#pragma unroll
    for (int o = 1; o < 64; o <<= 1) v += __shfl_xor(v, o);
    return v;
}
__device__ __forceinline__ void p0_transpose_item(const float* src, int ld, int Kd, int k0, int scol0, bf16_t* dst, int drow0, const float* gk, LAS float* scr, int lane) {
    float tv[32];
#pragma unroll
    for (int i = 0; i < 32; ++i) { const int kk = 2 * i + (lane >> 5); tv[i] = src[(size_t)(k0 + kk) * ld + scol0 + (lane & 31)]; }
    if (gk) {
#pragma unroll
        for (int i = 0; i < 32; ++i) tv[i] *= gk[k0 + 2 * i + (lane >> 5)];
    }
#pragma unroll
    for (int i = 0; i < 32; ++i) scr[(2 * i + (lane >> 5)) * 33 + (lane & 31)] = tv[i];
    asm volatile("s_waitcnt lgkmcnt(0)" ::: "memory");
    const int c = lane & 7;
#pragma unroll
    for (int j = 0; j < 4; ++j) { const int n = (lane >> 3) + 8 * j; const LAS float* s = scr + (8 * c) * 33 + n;
        u32x4 o; o.x = pg8::cvt_pk_bf16(s[0 * 33], s[1 * 33]); o.y = pg8::cvt_pk_bf16(s[2 * 33], s[3 * 33]); o.z = pg8::cvt_pk_bf16(s[4 * 33], s[5 * 33]); o.w = pg8::cvt_pk_bf16(s[6 * 33], s[7 * 33]);
        *(u32x4*)(dst + (size_t)(drow0 + n) * Kd + k0 + 8 * c) = o; }
    asm volatile("s_waitcnt lgkmcnt(0)" ::: "memory");
}

struct Params { const float* in[18]; float* out; unsigned char* ws; int ph_lo, ph_hi; };

__device__ __forceinline__ void p0_prep(const Params& p, LAS unsigned char* lds, int tid, int wave, int lane) {
    unsigned char* ws = p.ws;
    LAS float* scr = (LAS float*)(lds + wave * 16384);
    const int gw = blockIdx.x * 8 + wave, NGW = gridDim.x * 8;
    constexpr int I_A = 16 * 176, I_D = 44 * 32, I_IN = 16 * 32, I_OUT = 16 * 32, I_ZP = 1024;
    constexpr int NITEMS = I_ZP + 2 * (I_A + I_D) + I_IN + I_OUT;
    for (int it = gw; it < NITEMS; it += NGW) {
        int r = it;
        if (r < I_ZP) {
            const int g = r >> 8, kb = (r >> 4) & 15, jb = r & 15, k = 64 * kb + lane;
            const float* __restrict__ wrow = p.in[6] + (size_t)k * NIN + 1024 + 128 * g;
            const float* __restrict__ wp = p.in[10] + (size_t)g * 16384 + 8 * jb;
            float a[8];
#pragma unroll
            for (int j = 0; j < 8; ++j) a[j] = 0.f;
#pragma unroll
            for (int b = 0; b < 4; ++b) { f32x4 w4[8];
#pragma unroll
                for (int q = 0; q < 8; ++q) w4[q] = *(const f32x4*)(wrow + 32 * b + 4 * q);
#pragma unroll
                for (int q = 0; q < 8; ++q)
#pragma unroll
                    for (int e = 0; e < 4; ++e) { const float* wpi = wp + (size_t)(32 * b + 4 * q + e) * 128;
#pragma unroll
                        for (int j = 0; j < 8; ++j) a[j] += w4[q][e] * wpi[j]; } }
            const float gm = p.in[5][k];
            bf16_t* dst = (bf16_t*)(ws + WS_WIN) + (size_t)(1024 + 128 * g + 8 * jb) * D + k;
#pragma unroll
            for (int j = 0; j < 8; ++j) dst[(size_t)j * D] = (bf16_t)(pg8::cvt_pk_bf16(a[j] * gm, 0.f) & 0xffffu);
            continue;
        }
        r -= I_ZP;
        if (r < 2 * (I_A + I_D)) {
            const int l = r >= (I_A + I_D); if (l) r -= (I_A + I_D);
            const float* nrm = l ? p.in[13] : p.in[1]; const float* wg = l ? p.in[14] : p.in[2]; const float* wu = l ? p.in[15] : p.in[3]; const float* wd = l ? p.in[16] : p.in[4];
            bf16_t* dA = (bf16_t*)(ws + (l ? WS_W2A : WS_W1A)); bf16_t* dD = (bf16_t*)(ws + (l ? WS_W2D : WS_W1D));
            if (r < I_A) { const int kb = r / 176, rb = r % 176, pn = rb >> 3, bj = (rb >> 2) & 1, c0 = (rb & 3) * 32;
                p0_transpose_item(bj ? wu : wg, FF, D, 64 * kb, 128 * pn + c0, dA, 32 * rb, nrm, scr, lane); }
            else { r -= I_A; const int kb = r / 32, rb = r % 32; p0_transpose_item(wd, D, FF, 64 * kb, 32 * rb, dD, 32 * rb, nullptr, scr, lane); }
            continue;
        }
        r -= 2 * (I_A + I_D);
        if (r < I_IN) { const int kb = r / 32, rb = r % 32; int sc;
            if (rb < 16) sc = 32 * rb; else { const int q = rb - 16, pn = q >> 3, bj = (q >> 2) & 1, wc = q & 3; sc = 512 + 64 * (4 * pn + wc) + 32 * bj; }
            p0_transpose_item(p.in[6], NIN, D, 64 * kb, sc, (bf16_t*)(ws + WS_WIN), 32 * rb, p.in[5], scr, lane); continue; }
        r -= I_IN;
        { const int kb = r / 32, rb = r % 32; p0_transpose_item(p.in[12], D, D, 64 * kb, 32 * rb, (bf16_t*)(ws + WS_WOUT), 32 * rb, nullptr, scr, lane); }
    }
    for (int e8 = blockIdx.x * 512 + tid; e8 < 8 * 128 * 128 / 8; e8 += gridDim.x * 512) {
        const int e = e8 * 8, t = (e >> 7) & 127, s0 = e & 127;
        const f32x4 a = *(const f32x4*)(p.in[8] + e), b = *(const f32x4*)(p.in[8] + e + 4); f32x4 ma, mb;
#pragma unroll
        for (int j = 0; j < 4; ++j) { ma[j] = (s0 + j <= t) ? a[j] : 0.f; mb[j] = (s0 + 4 + j <= t) ? b[j] : 0.f; }
        *(u32x4*)((bf16_t*)(ws + WS_WM) + e) = pack8(ma, mb);
    }
    bf16_t* XB = (bf16_t*)(ws + WS_XB); float* ss = (float*)(ws + WS_SS);
    for (int i = blockIdx.x * 512 + tid; i < 3 * M / 4; i += gridDim.x * 512) ((f32x4*)(ss + SS_STRIDE))[i] = (f32x4){0.f, 0.f, 0.f, 0.f};
    for (int m = gw; m < M; m += 4 * NGW) {
        f32x4 v[4][4];
#pragma unroll
        for (int q = 0; q < 4; ++q) { const int mq = (m + q * NGW < M) ? m + q * NGW : m; const f32x4* xr = (const f32x4*)(p.in[0] + (size_t)mq * D) + lane;
#pragma unroll
            for (int j = 0; j < 4; ++j) v[q][j] = __builtin_nontemporal_load(xr + 64 * j); }
#pragma unroll
        for (int q = 0; q < 4; ++q) { const int mq = m + q * NGW; if (mq < M) {
            float sq = 0.f;
#pragma unroll
            for (int j = 0; j < 4; ++j) sq += (v[q][j][0] * v[q][j][0] + v[q][j][1] * v[q][j][1]) + (v[q][j][2] * v[q][j][2] + v[q][j][3] * v[q][j][3]);
            sq = wave_sum(sq);
            u32x2* o = (u32x2*)(XB + (size_t)mq * D) + lane;
#pragma unroll
            for (int j = 0; j < 4; ++j) { u32x2 w; w.x = pg8::cvt_pk_bf16(v[q][j][0], v[q][j][1]); w.y = pg8::cvt_pk_bf16(v[q][j][2], v[q][j][3]); o[64 * j] = w; }
            if (lane == 0) ss[mq] = sq; } }
    }
}

__device__ __forceinline__ f32x4 unpack4(const u32x2 z) { return (f32x4){bf_lo(z.x), bf_hi(z.x), bf_lo(z.y), bf_hi(z.y)}; }
template <int WIN> __device__ __forceinline__ void pool_task(const bf16_t* __restrict__ zc, bf16_t* __restrict__ yc, const size_t Rt, const int pos0, const f32x4 sc) {
    constexpr int H = WIN - 1;
    u32x2 raw[H + 8];
#pragma unroll
    for (int i = 0; i < H + 8; ++i) { const bool ok = pos0 - H + i >= 0; raw[i] = *(const u32x2*)(zc + (ok ? Rt - H + i : Rt) * AW); if (!ok) raw[i] = (u32x2){0u, 0u}; }
    f32x4 s = (f32x4){0.f, 0.f, 0.f, 0.f};
#pragma unroll
    for (int i = 0; i < H; ++i) s += unpack4(raw[i]);
#pragma unroll
    for (int t = 0; t < 8; ++t) {
        const f32x4 zt = unpack4(raw[H + t]); s += zt;
        const int pos = pos0 + t, cnt = (pos + 1 < WIN) ? pos + 1 : WIN; const float inv = 1.0f / (float)cnt;
        const f32x4 o = (s * inv - zt) * sc;
        u32x2 w; w.x = pg8::cvt_pk_bf16(o[0], o[1]); w.y = pg8::cvt_pk_bf16(o[2], o[3]);
        *(u32x2*)(yc + (Rt + t) * D) = w;
        s -= unpack4(raw[t]);
    }
}
__device__ __forceinline__ void p4_mixer(const Params& p, LAS unsigned char* lds, int tid, int wave, int lane) {
    unsigned char* ws = p.ws;
    const bf16_t* __restrict__ U = (const bf16_t*)(ws + WS_U); const bf16_t* __restrict__ V = (const bf16_t*)(ws + WS_V); const bf16_t* __restrict__ Z = (const bf16_t*)(ws + WS_Z); bf16_t* __restrict__ Y = (bf16_t*)(ws + WS_Y);
    const bf16_t* __restrict__ Wm = (const bf16_t*)(ws + WS_WM); const float* __restrict__ bs = p.in[9]; const float* __restrict__ pscale = p.in[11]; const float* __restrict__ vgain = p.in[7];
    constexpr int P = 136;
    LAS bf16_t* Vt = (LAS bf16_t*)lds;
    const int fr = lane & 15, fq = lane >> 4;
    for (int chunk = blockIdx.x; chunk < M / 128; chunk += gridDim.x) {
        const size_t R0 = (size_t)chunk * 128;
        {
            const int s = tid & 127, cq0 = tid >> 7; const bf16_t* vrow = V + (R0 + s) * AW + 8 * cq0; u32x4 v[16];
#pragma unroll
            for (int it = 0; it < 16; ++it) v[it] = *(const u32x4*)(vrow + 32 * it);
#pragma unroll
            for (int it = 0; it < 16; ++it) { LAS bf16_t* d = Vt + (8 * (cq0 + 4 * it)) * P + s;
                d[0 * P] = (bf16_t)(v[it].x & 0xffffu); d[1 * P] = (bf16_t)(v[it].x >> 16); d[2 * P] = (bf16_t)(v[it].y & 0xffffu); d[3 * P] = (bf16_t)(v[it].y >> 16);
                d[4 * P] = (bf16_t)(v[it].z & 0xffffu); d[5 * P] = (bf16_t)(v[it].z >> 16); d[6 * P] = (bf16_t)(v[it].w & 0xffffu); d[7 * P] = (bf16_t)(v[it].w >> 16); }
        }
        __syncthreads();
#pragma unroll 2
        for (int i = 0; i < 8; ++i) {
            const int h = i, ts = (wave + i) & 7, t = 16 * ts + fr;
            const size_t row = R0 + t;
            const bf16_t* wrow = Wm + (size_t)(h * 128 + t) * 128 + 8 * fq;
            bf16x8 wf[4];
#pragma unroll
            for (int ks = 0; ks < 4; ++ks) wf[ks] = *(const bf16x8*)(wrow + 32 * ks);
            const float bias = bs[h * 128 + t];
            u32x2 uu[4]; f32x4 gn[4];
#pragma unroll
            for (int nb = 0; nb < 4; ++nb) { const int col = 64 * h + 16 * nb + 4 * fq; uu[nb] = *(const u32x2*)(U + row * AW + col); gn[nb] = *(const f32x4*)(vgain + col); }
            f32x4 acc[4];
#pragma unroll
            for (int nb = 0; nb < 4; ++nb) acc[nb] = (f32x4){0.f, 0.f, 0.f, 0.f};
            const int nks = (ts >> 1) + 1;
#pragma unroll
            for (int ks = 0; ks < 4; ++ks) if (ks < nks) {
#pragma unroll
                for (int nb = 0; nb < 4; ++nb) { const bf16x8 vf = *(const LAS bf16x8*)(Vt + (64 * h + 16 * nb + fr) * P + 32 * ks + 8 * fq);
                    acc[nb] = __builtin_amdgcn_mfma_f32_16x16x32_bf16(vf, wf[ks], acc[nb], 0, 0, 0); }
            }
#pragma unroll
            for (int nb = 0; nb < 4; ++nb) { const int col = 64 * h + 16 * nb + 4 * fq;
                u32x2 w; w.x = pg8::cvt_pk_bf16(bf_lo(uu[nb].x) * (acc[nb][0] * gn[nb][0] + bias), bf_hi(uu[nb].x) * (acc[nb][1] * gn[nb][1] + bias));
                w.y = pg8::cvt_pk_bf16(bf_lo(uu[nb].y) * (acc[nb][2] * gn[nb][2] + bias), bf_hi(uu[nb].y) * (acc[nb][3] * gn[nb][3] + bias));
                *(u32x2*)(Y + row * D + col) = w; }
        }
        {
            const int g = wave & 3, cq = 32 * g + (lane & 31), q4 = (wave >> 2) * 2 + (lane >> 5);
            const bf16_t* zc = Z + 4 * cq; bf16_t* yc = Y + 512 + 4 * cq; const f32x4 sc = *(const f32x4*)(pscale + 4 * cq);
            const int pb = (chunk & 31) * 128 + 32 * q4; const size_t Rb = R0 + 32 * q4;
#pragma unroll 1
            for (int k = 0; k < 4; ++k) {
                if (g == 0) pool_task<2>(zc, yc, Rb + 8 * k, pb + 8 * k, sc);
                else if (g == 1) pool_task<4>(zc, yc, Rb + 8 * k, pb + 8 * k, sc);
                else if (g == 2) pool_task<8>(zc, yc, Rb + 8 * k, pb + 8 * k, sc);
                else pool_task<16>(zc, yc, Rb + 8 * k, pb + 8 * k, sc);
            }
        }
        __syncthreads();
    }
}

#define XB_TMO      128
#define XB_XCNT(j)  (256  + 64 * (j))
#define XB_XSUB(j)  (1280 + 64 * (j))
#define XB_XGEN(j)  (2304 + 64 * (j))
#define XB_TOP      3328
#define XB_TOPGEN   3392
#define XCD_BAR_WORDS 3456
#define XB_SPIN_CAP (1u << 18)

__device__ __forceinline__ unsigned xb_ld(unsigned* p)              { return __hip_atomic_load(p, __ATOMIC_RELAXED, __HIP_MEMORY_SCOPE_AGENT); }
__device__ __forceinline__ unsigned xb_add(unsigned* p, unsigned v) { return __hip_atomic_fetch_add(p, v, __ATOMIC_RELAXED, __HIP_MEMORY_SCOPE_AGENT); }
__device__ __forceinline__ unsigned xb_xcc_id() { return (unsigned)__builtin_amdgcn_s_getreg((3 << 11) | 20) & 0xFu; }
#define XB_SPIN(cond, bar) do { unsigned _sp = 0; while (cond) { __builtin_amdgcn_s_sleep(1); \
    if ((++_sp & 255u) == 0u) { if (xb_ld(&(bar)[XB_TMO])) break; if (_sp > XB_SPIN_CAP) { atomicAdd(&(bar)[XB_TMO], 1u); break; } } } } while (0)

struct XcdBarrier {
    unsigned* bar; unsigned x;
    volatile __attribute__((address_space(3))) unsigned* st;
};

__device__ __forceinline__ XcdBarrier xcd_barrier_post(unsigned* bar, volatile __attribute__((address_space(3))) unsigned* st) {
    XcdBarrier b; b.bar = bar; b.x = xb_xcc_id(); b.st = st;
    if (threadIdx.x == 0) (void)xb_add(&bar[XB_XCNT(b.x)], 1u);
    return b;
}
__device__ __forceinline__ void xcd_barrier_complete(unsigned* bar, unsigned x, unsigned& nloc, unsigned& nx) {
    const unsigned G = gridDim.x * gridDim.y * gridDim.z;
    unsigned sum, cnt, mine, sp = 0u;
    for (;;) {
        sum = 0u; cnt = 0u; mine = 0u;
#pragma unroll
        for (unsigned j = 0; j < 16; ++j) { const unsigned c = xb_ld(&bar[XB_XCNT(j)]); sum += c; cnt += (c > 0u) ? 1u : 0u; mine = (j == x) ? c : mine; }
        if (sum == G) break;
        __builtin_amdgcn_s_sleep(1);
        if ((++sp & 255u) == 0u) { if (xb_ld(&bar[XB_TMO])) break; if (sp > XB_SPIN_CAP) { atomicAdd(&bar[XB_TMO], 1u); break; } }
    }
    nloc = mine > 0u ? mine : 1u; nx = cnt > 0u ? cnt : 1u;
}

__device__ __forceinline__ void xcd_barrier(const XcdBarrier& b) {
    asm volatile("s_waitcnt vmcnt(0)" ::: "memory");
    __syncthreads();
    if (threadIdx.x == 0) {
        unsigned* bar = b.bar;
        __builtin_amdgcn_s_waitcnt(0);
        unsigned nloc = b.st[0], nx = b.st[1];
        if (nloc == 0u) { xcd_barrier_complete(bar, b.x, nloc, nx); b.st[0] = nloc; b.st[1] = nx; }
        const unsigned old = xb_add(&bar[XB_XSUB(b.x)], 1u);
        const unsigned gen = old / nloc;
        if (old + 1u == (gen + 1u) * nloc) {
            __builtin_amdgcn_fence(__ATOMIC_RELEASE, "agent");
            asm volatile("s_waitcnt vmcnt(0)" ::: "memory");
            const unsigned og = xb_add(&bar[XB_TOP], 1u);
            const unsigned tg = og / nx;
            if (og + 1u == (tg + 1u) * nx) xb_add(&bar[XB_TOPGEN], 1u);
            else XB_SPIN(xb_ld(&bar[XB_TOPGEN]) == tg, bar);
            __builtin_amdgcn_fence(__ATOMIC_ACQUIRE, "agent");
            xb_add(&bar[XB_XGEN(b.x)], 1u);
            asm volatile("s_waitcnt vmcnt(0)" ::: "memory");
        } else {
            XB_SPIN(xb_ld(&bar[XB_XGEN(b.x)]) == gen, bar);
            __builtin_amdgcn_fence(__ATOMIC_ACQUIRE, "agent");
            asm volatile("s_waitcnt vmcnt(0)" ::: "memory");
        }
    }
    __syncthreads();
}

template <int PH> __device__ __forceinline__ void run_phase(const Params& p, LAS unsigned char* lds, const int wave0) {
    int tid = wave0 * 64 + (int)__builtin_amdgcn_mbcnt_hi(~0u, __builtin_amdgcn_mbcnt_lo(~0u, 0u)); asm volatile("" : "+v"(tid));
    const int lane = tid & 63, wave = __builtin_amdgcn_readfirstlane(tid >> 6);
    unsigned char* ws = p.ws;
    bf16_t* XB = (bf16_t*)(ws + WS_XB); bf16_t* ACT = (bf16_t*)(ws + WS_ACT); float* ss = (float*)(ws + WS_SS);
    const int G = gridDim.x, c = blockIdx.x;
    if constexpr (PH == 0) p0_prep(p, lds, tid, wave, lane);
    if constexpr (PH == 1 || PH == 6) {
        pg8::Gemm g{XB, (const bf16_t*)(ws + (PH == 1 ? WS_W1A : WS_W2A)), M, 2 * FF, D}; pg8::StaticOrder S; S.init(M, 2 * FF, G, c);
        EpiSwiglu E{ACT, ss + (PH == 1 ? 0 : 2) * SS_STRIDE};
        pg8::gemm_phase<EpiSwiglu, pg8::StaticOrder, true, true>(lds, g, S, E, tid);
    }
    if constexpr (PH == 2) {
        pg8::Gemm g{ACT, (const bf16_t*)(ws + WS_W1D), M, D, FF}; pg8::StaticOrder S; S.init(M, D, G, c);
        EpiRes<true> E{p.in[0], XB, ss + SS_STRIDE, 0.5f};
        pg8::gemm_phase<EpiRes<true>, pg8::StaticOrder, true, true>(lds, g, S, E, tid);
    }
    if constexpr (PH == 7) {
        pg8::Gemm g{ACT, (const bf16_t*)(ws + WS_W2D), M, D, FF}; pg8::StaticOrder S; S.init(M, D, G, c);
        EpiResFinal E{XB, p.out, ss + 3 * SS_STRIDE, (unsigned*)(ws + WS_CTL) + CNT_WORD0, p.in[17], 0.5f};
        pg8::gemm_phase<EpiResFinal, pg8::StaticOrder, true, true>(lds, g, S, E, tid);
    }
    if constexpr (PH == 3) {
        pg8::Gemm g{XB, (const bf16_t*)(ws + WS_WIN), M, NIN, D}; pg8::StaticOrder S; S.init(M, NIN, G, c);
        EpiWin E{(bf16_t*)(ws + WS_U), (bf16_t*)(ws + WS_V), (bf16_t*)(ws + WS_Z), ss + SS_STRIDE};
        pg8::gemm_phase<EpiWin, pg8::StaticOrder, true, true>(lds, g, S, E, tid);
    }
    if constexpr (PH == 4) p4_mixer(p, lds, tid, wave, lane);
    if constexpr (PH == 5) {
        pg8::Gemm g{(const bf16_t*)(ws + WS_Y), (const bf16_t*)(ws + WS_WOUT), M, D, D}; pg8::StaticOrder S; S.init(M, D, G, c);
        EpiRes<false> E{nullptr, XB, ss + 2 * SS_STRIDE, 1.0f};
        pg8::gemm_phase<EpiRes<false>, pg8::StaticOrder, true, true>(lds, g, S, E, tid);
    }
}
__global__ void __launch_bounds__(512, 2) fwd(Params p) {
    extern __shared__ __attribute__((aligned(16))) unsigned char lds_raw[];
    LAS unsigned char* lds = (LAS unsigned char*)lds_raw;
    const int wave0 = __builtin_amdgcn_readfirstlane(threadIdx.x >> 6);
    const int lo = p.ph_lo, hi = p.ph_hi;
    volatile LAS unsigned* st = (volatile LAS unsigned*)(lds + LDS_BYTES - 64);
    if (threadIdx.x < 2) st[threadIdx.x] = 0u;
    __syncthreads();
    XcdBarrier bar; bar.bar = (unsigned*)(p.ws + WS_CTL); bar.x = 0; bar.st = st;
    const bool use_cg = hi > 8;
    if (hi - lo > 1 && !use_cg) bar = xcd_barrier_post((unsigned*)(p.ws + WS_CTL), st);
#define MK_SEAM() do { if (use_cg) cg::this_grid().sync(); else xcd_barrier(bar); } while (0)
#define MK_PHASE(k) if (lo <= (k) && (k) < hi) { if ((PHM >> (k)) & 1) run_phase<k>(p, lds, wave0); if (PROBE_REP == (k)) { MK_SEAM(); run_phase<k>(p, lds, wave0); } if ((k) + 1 < hi) MK_SEAM(); }
    MK_PHASE(0) MK_PHASE(1) MK_PHASE(2) MK_PHASE(3) MK_PHASE(4) MK_PHASE(5) MK_PHASE(6) MK_PHASE(7)
#undef MK_SEAM
#undef MK_PHASE
}
}

extern "C" void kernel_launch(void* const* d_in, const int* in_sizes, int n_in, void* d_out, int out_size, void* d_ws, size_t ws_size, hipStream_t stream) {
    static int grid = 0;
    if (grid == 0) {
        if (n_in != 18 || out_size != mk::M * mk::D || ws_size < mk::WS_END) { fprintf(stderr, "kernel_launch: unexpected shapes (n_in %d out %d ws %zu)\n", n_in, out_size, ws_size); grid = -1; return; }
        int dev = 0, cus = 0;
        if (hipGetDevice(&dev) != hipSuccess || hipDeviceGetAttribute(&cus, hipDeviceAttributeMultiprocessorCount, dev) != hipSuccess) { grid = -1; return; }
        if (hipFuncSetAttribute((const void*)mk::fwd, hipFuncAttributeMaxDynamicSharedMemorySize, mk::LDS_BYTES) != hipSuccess) { fprintf(stderr, "kernel_launch: hipFuncSetAttribute failed\n"); grid = -1; return; }
        grid = cus;
    }
    if (grid < 0) return;
    mk::Params p{};
    for (int i = 0; i < 18; ++i) p.in[i] = (const float*)d_in[i];
    p.out = (float*)d_out; p.ws = (unsigned char*)d_ws;
    if (hipMemsetAsync((char*)d_ws + mk::WS_CTL, 0, mk::CTL_BYTES, stream) != hipSuccess) { fprintf(stderr, "kernel_launch: memset of the barrier words failed\n"); return; }
#if MK_LAUNCHES == 1
    p.ph_lo = 0; p.ph_hi = 8;
    void* args[] = {&p};
    hipError_t e = hipLaunchCooperativeKernel((const void*)mk::fwd, dim3(grid), dim3(512), args, mk::LDS_BYTES, stream);
    if (e != hipSuccess) fprintf(stderr, "cooperative launch failed: %s (grid %d)\n", hipGetErrorString(e), grid);
#else
    for (int ph = 0; ph < 8; ++ph) { p.ph_lo = ph; p.ph_hi = ph + 1; hipLaunchKernelGGL(mk::fwd, dim3(grid), dim3(512), mk::LDS_BYTES, stream, p); }
#endif
}
```

```cpp
#include <hip/hip_runtime.h>
#include <hip/hip_cooperative_groups.h>
#include <cstdio>
#include <cstdint>
namespace cg = cooperative_groups;
#ifndef PHM
#define PHM 0x1ff
#endif
#ifndef PROBE_REP
#define PROBE_REP -1
#endif
#ifndef MK_LAUNCHES
#define MK_LAUNCHES 1
#endif
namespace pg8 {
#define PG8_LAS __attribute__((address_space(3)))
typedef unsigned short bf16_t;
typedef short bf16x8 __attribute__((ext_vector_type(8)));
typedef float f32x4 __attribute__((ext_vector_type(4)));
typedef unsigned u32x4 __attribute__((ext_vector_type(4)));
constexpr int BM = 256, BK = 64, HALF = 128, HTB = HALF * BK * 2  , STAGE_BYTES = 8 * HTB, NXCD = 8, WGM = 8;

__host__ __device__ __forceinline__ int lds_byte(int r, int c) { const int st = (r >> 4) * 2 + (c >> 5), rr = r & 15, cc = c & 31, ob = rr * 64 + cc * 2; return st * 1024 + (ob ^ (((ob >> 9) & 1) << 5)); }
__host__ __device__ __forceinline__ void stage_rc(int b, int& R, int& C) { const int st = b / 1024, sb = b % 1024, swz = sb ^ (((sb >> 9) & 1) << 5); R = (st >> 1) * 16 + swz / 64; C = (st & 1) * 32 + (swz % 64) / 2; }
__host__ __device__ __forceinline__ int perm32(int rho) { const int n = rho >> 4, i = rho & 15; return 8 * (i >> 2) + 4 * n + (i & 3); }

struct Unit { int pm, pn; };
struct Gemm { const bf16_t* A; const bf16_t* Bt; int M, N, K; };

struct StaticOrder {
    int nM, nN, nwg, G, c;
    __host__ __device__ void init(int M, int N, int G_, int c_) { nM = M / BM; nN = N / BM; nwg = nM * nN; G = G_; c = c_; }
    __host__ __device__ bool next(int i, Unit& u) const {
        const long L = (long)i * G + c; if (L >= nwg) return false;
        int wgid = (int)L; { const int q = nwg / NXCD, r = nwg % NXCD, xcd = wgid % NXCD, off = wgid / NXCD; wgid = (xcd < r ? xcd * (q + 1) : r * (q + 1) + (xcd - r) * q) + off; }
        const int nig = WGM * nN, gid = wgid / nig, fm = gid * WGM, gsz = (nM - fm) < WGM ? (nM - fm) : WGM;
        u.pm = fm + ((wgid % nig) % gsz); u.pn = (wgid % nig) / gsz; return true;
    }
    __device__ __forceinline__ void a_ready(const Unit&) const {}
    __device__ __forceinline__ void done(const Unit&) const {}
};
__device__ __forceinline__ unsigned cvt_pk_bf16(float lo, float hi) { unsigned r; asm volatile("v_cvt_pk_bf16_f32 %0, %1, %2" : "=v"(r) : "v"(lo), "v"(hi)); return r; }
template <class Epi, class Sched, bool ALIGN_EPI = false, bool SP2 = false>
__device__ __forceinline__ void gemm_phase(PG8_LAS unsigned char* lds, const Gemm g, const Sched& S, const Epi& E, const int tid) {
    const int wid = __builtin_amdgcn_readfirstlane(tid >> 6), lane = tid & 63, wr = wid >> 2, wc = wid & 3, fr = lane & 15, fq = lane >> 4;
    const int K = g.K, nt = K / BK;
    unsigned voffA[2], voffB[2];
#pragma unroll
    for (int i = 0; i < 2; ++i) { int R, C; stage_rc(tid * 16 + i * 8192, R, C); const int Rb = Epi::PERM ? ((R & ~31) + perm32(R & 31)) : R;
        voffA[i] = (unsigned)(R * K + C) * 2u; voffB[i] = (unsigned)(Rb * K + C) * 2u; }
    const size_t kstep = (size_t)(BK * 2);
    const size_t hstep = (size_t)HALF * K * 2;
    const size_t tstep = 2 * hstep;
    const unsigned ldsw = (unsigned)wid * 1024u;
    const int aoff = lds_byte(wr * 64 + fr, fq * 8), boff = lds_byte(wc * 32 + fr, fq * 8);
#define PG8_SA(b, h) (((b) * 2 + (h)) * HTB)
#define PG8_SB(b, h) ((4 + (b) * 2 + (h)) * HTB)
#define PG8_STAGE(bufoff, gbase, voff) do { _Pragma("unroll") for (int _i = 0; _i < 2; ++_i) \
        __builtin_amdgcn_global_load_lds((const unsigned*)((const char*)(gbase) + (voff)[_i]), (PG8_LAS unsigned*)(lds + (bufoff) + ldsw + _i * 8192), 16, 0, 0); } while (0)
#define PG8_LDA(dst, b, h) do { _Pragma("unroll") for (int m = 0; m < 4; ++m) _Pragma("unroll") for (int k = 0; k < 2; ++k) dst[m][k] = *(const PG8_LAS bf16x8*)(lds + PG8_SA(b, h) + aoff + m * 2048 + k * 1024); } while (0)
#define PG8_LDB(dst, b, h) do { _Pragma("unroll") for (int n = 0; n < 2; ++n) _Pragma("unroll") for (int k = 0; k < 2; ++k) dst[n][k] = *(const PG8_LAS bf16x8*)(lds + PG8_SB(b, h) + boff + n * 2048 + k * 1024); } while (0)
#define PG8_MMA(ai, bj, At, Bt) do { __builtin_amdgcn_s_setprio(1); _Pragma("unroll") for (int m = 0; m < 4; ++m) _Pragma("unroll") for (int n = 0; n < 2; ++n) _Pragma("unroll") for (int k = 0; k < 2; ++k) \
        acc[ai][bj][m][n] = __builtin_amdgcn_mfma_f32_16x16x32_bf16(Bt[n][k], At[m][k], acc[ai][bj][m][n], 0, 0, 0); __builtin_amdgcn_s_setprio(0); } while (0)
#define PG8_WAIT_V(n) asm volatile("s_waitcnt vmcnt(" #n ")" ::: "memory")
#define PG8_WAIT_L(n) asm volatile("s_waitcnt lgkmcnt(" #n ")" ::: "memory")
#define PG8_BAR __builtin_amdgcn_s_barrier()
#define PG8_SCHED __builtin_amdgcn_sched_barrier(0)
    Unit cur, nxt; int ui = 0;
    if (!S.next(0, cur)) return;
    f32x4 acc[2][2][4][2];
#pragma unroll
    for (int a = 0; a < 2; ++a)
#pragma unroll
        for (int b = 0; b < 2; ++b)
#pragma unroll
            for (int m = 0; m < 4; ++m)
#pragma unroll
                for (int n = 0; n < 2; ++n) acc[a][b][m][n] = (f32x4){0.f, 0.f, 0.f, 0.f};
    bf16x8 At[4][2], B0[2][2], B1[2][2];
    float epre[Epi::NPRE];
    const char* cA = (const char*)g.A + (size_t)cur.pm * tstep; const char* cB = (const char*)g.Bt + (size_t)cur.pn * tstep;
    S.a_ready(cur);
    if constexpr (SP2) {
        PG8_STAGE(PG8_SB(0, 0), cB, voffB); PG8_STAGE(PG8_SB(0, 1), cB + hstep, voffB); PG8_STAGE(PG8_SA(0, 0), cA, voffA); PG8_STAGE(PG8_SA(0, 1), cA + hstep, voffA);
        if (wr == 1) PG8_BAR;
        PG8_WAIT_V(2); PG8_BAR;
        PG8_STAGE(PG8_SB(1, 0), cB + kstep, voffB); PG8_STAGE(PG8_SA(1, 0), cA + kstep, voffA); PG8_STAGE(PG8_SB(1, 1), cB + hstep + kstep, voffB);
        PG8_WAIT_V(6); PG8_BAR;
    } else {
        PG8_STAGE(PG8_SB(0, 0), cB, voffB); PG8_STAGE(PG8_SA(0, 0), cA, voffA); PG8_STAGE(PG8_SB(0, 1), cB + hstep, voffB); PG8_STAGE(PG8_SA(0, 1), cA + hstep, voffA);
        if (wr == 1) PG8_BAR;
        PG8_WAIT_V(4); PG8_BAR;
        PG8_STAGE(PG8_SB(1, 0), cB + kstep, voffB); PG8_STAGE(PG8_SA(1, 0), cA + kstep, voffA); PG8_STAGE(PG8_SB(1, 1), cB + hstep + kstep, voffB);
        PG8_WAIT_V(6); PG8_BAR;
    }
    for (;;) {
        const bool has_next = S.next(ui + 1, nxt);
        const char* nA = has_next ? (const char*)g.A + (size_t)nxt.pm * tstep : cA; const char* nB = has_next ? (const char*)g.Bt + (size_t)nxt.pn * tstep : cB;
        for (int t = 0; t < nt; t += 2) {
            const bool last = (t == nt - 2);
            const char* a1 = cA + (size_t)(t + 1) * kstep;
            const char* a2 = last ? nA : cA + (size_t)(t + 2) * kstep; const char* b2 = last ? nB : cB + (size_t)(t + 2) * kstep;
            const char* a3 = a2 + kstep; const char* b3 = b2 + kstep;
            if (last && has_next) S.a_ready(nxt);
            if (last) E.pre(epre, cur, wr, wc, fr, fq);
            if constexpr (SP2) {
            PG8_LDB(B0, 0, 0); PG8_LDB(B1, 0, 1); PG8_SCHED; PG8_LDA(At, 0, 0); PG8_STAGE(PG8_SA(1, 1), a1 + hstep, voffA);
            PG8_WAIT_V(8); PG8_WAIT_L(0); PG8_BAR; PG8_MMA(0, 0, At, B0); PG8_MMA(0, 1, At, B1); PG8_BAR; PG8_SCHED;
            PG8_LDA(At, 0, 1); PG8_STAGE(PG8_SB(0, 0), b2, voffB); PG8_STAGE(PG8_SB(0, 1), b2 + hstep, voffB); PG8_STAGE(PG8_SA(0, 0), a2, voffA);
            PG8_WAIT_V(8); PG8_WAIT_L(0); PG8_BAR; PG8_MMA(1, 0, At, B0); PG8_MMA(1, 1, At, B1); PG8_BAR; PG8_SCHED;
            PG8_LDB(B0, 1, 0); PG8_LDB(B1, 1, 1); PG8_SCHED; PG8_LDA(At, 1, 0); PG8_STAGE(PG8_SA(0, 1), a2 + hstep, voffA);
            PG8_WAIT_V(8); PG8_WAIT_L(0); PG8_BAR; PG8_MMA(0, 0, At, B0); PG8_MMA(0, 1, At, B1); PG8_BAR; PG8_SCHED;
            PG8_LDA(At, 1, 1); PG8_STAGE(PG8_SB(1, 0), b3, voffB); PG8_STAGE(PG8_SB(1, 1), b3 + hstep, voffB); PG8_STAGE(PG8_SA(1, 0), a3, voffA);
            PG8_WAIT_V(8); PG8_WAIT_L(0); PG8_BAR; PG8_MMA(1, 0, At, B0); PG8_MMA(1, 1, At, B1); PG8_BAR; PG8_SCHED;
            } else {
            PG8_LDB(B0, 0, 0); PG8_SCHED; PG8_LDA(At, 0, 0); PG8_STAGE(PG8_SA(1, 1), a1 + hstep, voffA);
            PG8_WAIT_L(8); PG8_BAR; PG8_WAIT_L(0); PG8_MMA(0, 0, At, B0); PG8_BAR; PG8_SCHED;
            PG8_LDB(B1, 0, 1); PG8_STAGE(PG8_SB(0, 0), b2, voffB);
            PG8_BAR; PG8_WAIT_L(0); PG8_MMA(0, 1, At, B1); PG8_BAR;
            PG8_LDA(At, 0, 1); PG8_STAGE(PG8_SA(0, 0), a2, voffA);
            PG8_BAR; PG8_WAIT_L(0); PG8_MMA(1, 0, At, B0); PG8_BAR; PG8_SCHED;
            PG8_STAGE(PG8_SB(0, 1), b2 + hstep, voffB);
            PG8_WAIT_V(6); PG8_BAR; PG8_MMA(1, 1, At, B1); PG8_BAR;
            PG8_LDB(B0, 1, 0); PG8_SCHED; PG8_LDA(At, 1, 0); PG8_STAGE(PG8_SA(0, 1), a2 + hstep, voffA);
            PG8_WAIT_L(8); PG8_BAR; PG8_WAIT_L(0); PG8_MMA(0, 0, At, B0); PG8_BAR; PG8_SCHED;
            PG8_LDB(B1, 1, 1); PG8_STAGE(PG8_SB(1, 0), b3, voffB);
            PG8_BAR; PG8_WAIT_L(0); PG8_MMA(0, 1, At, B1); PG8_BAR;
            PG8_LDA(At, 1, 1); PG8_STAGE(PG8_SA(1, 0), a3, voffA);
            PG8_BAR; PG8_WAIT_L(0); PG8_MMA(1, 0, At, B0); PG8_BAR; PG8_SCHED;
            PG8_STAGE(PG8_SB(1, 1), b3 + hstep, voffB);
            PG8_WAIT_V(6); PG8_BAR; PG8_MMA(1, 1, At, B1); PG8_BAR;
            }
        }
        if constexpr (ALIGN_EPI) { if (wr == 0) PG8_BAR; }
        if constexpr (!Epi::AFTER_DRAIN) { E(acc, epre, cur, wr, wc, fr, fq); S.done(cur); }
        if (!has_next) break;
#pragma unroll
        for (int a = 0; a < 2; ++a)
#pragma unroll
            for (int b = 0; b < 2; ++b)
#pragma unroll
                for (int m = 0; m < 4; ++m)
#pragma unroll
                    for (int n = 0; n < 2; ++n) acc[a][b][m][n] = (f32x4){0.f, 0.f, 0.f, 0.f};
        cur = nxt; cA = nA; cB = nB; ++ui;
        if constexpr (ALIGN_EPI) { if (wr == 1) PG8_BAR; }
    }
    PG8_WAIT_V(0);
    if constexpr (!ALIGN_EPI) { if (wr == 0) PG8_BAR; }
    PG8_BAR;
    if constexpr (Epi::AFTER_DRAIN) { E.fused(acc, cur, wr, wc, fr, fq, lds, wid, lane); S.done(cur); }
#undef PG8_SA
#undef PG8_SB
#undef PG8_STAGE
#undef PG8_LDA
#undef PG8_LDB
#undef PG8_MMA
#undef PG8_WAIT_V
#undef PG8_WAIT_L
#undef PG8_BAR
#undef PG8_SCHED
}
}

namespace mk {
using pg8::bf16_t; using pg8::f32x4; using pg8::u32x4; using pg8::bf16x8; using pg8::Unit;
#define LAS __attribute__((address_space(3)))
typedef unsigned u32x2 __attribute__((ext_vector_type(2)));
typedef float f32x2 __attribute__((ext_vector_type(2)));
constexpr int M = 32768, D = 1024, FF = 2816, NIN = 1536, AW = 512, SEQ = 4096;
constexpr float EPS = 1e-6f;
constexpr int LDS_BYTES = 147456;
constexpr size_t MiB = 1u << 20;
constexpr size_t WS_W1A = 0 * MiB, WS_W1D = 11 * MiB, WS_W2A = 17 * MiB, WS_W2D = 28 * MiB, WS_WIN = 34 * MiB, WS_WOUT = 37 * MiB, WS_WM = 39 * MiB, WS_SS = 40 * MiB,
                 WS_CTL = 41 * MiB, CTL_BYTES = 65536,  WS_XB = 42 * MiB, WS_ACT = 106 * MiB,
                 WS_U = 282 * MiB, WS_V = 314 * MiB, WS_Z = 346 * MiB, WS_Y = 378 * MiB, WS_END = 442 * MiB;

__device__ __forceinline__ float silu_f(float g) { return g * __builtin_amdgcn_rcpf(1.0f + __builtin_amdgcn_exp2f(-1.4426950409f * g)); }
__device__ __forceinline__ float gelu_f(float v) { const float w = v + 0.044715f * v * v * v; return v * __builtin_amdgcn_rcpf(1.0f + __builtin_amdgcn_exp2f(-2.3022081981f * w)); }
__device__ __forceinline__ f32x2 gelu2(const f32x2 a2, const float rr) {
    const f32x2 v2 = a2 * rr, w2 = v2 * v2, p2 = w2 * (-2.3022081981f * 0.044715f) + (-2.3022081981f), g2 = v2 * p2;
    f32x2 e2; e2.x = __builtin_amdgcn_exp2f(g2.x); e2.y = __builtin_amdgcn_exp2f(g2.y);
    const f32x2 d2 = e2 + 1.0f; f32x2 q2; q2.x = __builtin_amdgcn_rcpf(d2.x); q2.y = __builtin_amdgcn_rcpf(d2.y);
    return v2 * q2;
}
__device__ __forceinline__ float bf_lo(unsigned w) { return __uint_as_float(w << 16); }
__device__ __forceinline__ float bf_hi(unsigned w) { return __uint_as_float(w & 0xffff0000u); }
__device__ __forceinline__ u32x4 pack8(const f32x4 a, const f32x4 b) { u32x4 w; w.x = pg8::cvt_pk_bf16(a[0], a[1]); w.y = pg8::cvt_pk_bf16(a[2], a[3]); w.z = pg8::cvt_pk_bf16(b[0], b[1]); w.w = pg8::cvt_pk_bf16(b[2], b[3]); return w; }
__device__ __forceinline__ float row_rstd(const float* ss, int row) { return __builtin_amdgcn_rsqf(ss[row] * (1.0f / 1024.0f) + EPS); }
constexpr size_t SS_STRIDE = 32768;
constexpr int CNT_WORD0 = 4096;

__device__ __forceinline__ void epi_pre_wait(float (&e)[8]) { asm volatile("s_waitcnt vmcnt(8)" : "+v"(e[0]), "+v"(e[1]), "+v"(e[2]), "+v"(e[3]), "+v"(e[4]), "+v"(e[5]), "+v"(e[6]), "+v"(e[7]) :: "memory"); }
struct EpiSwiglu {
    static constexpr bool PERM = true, AFTER_DRAIN = false;
    bf16_t* O; const float* ss;
    static constexpr int NPRE = 8;
    __device__ __forceinline__ void pre(float (&e)[8], const Unit& u, int wr, int wc, int fr, int fq) const {
        const float* p0 = ss + (u.pm * 256 + wr * 64 + fr);
#pragma unroll
        for (int i = 0; i < 8; ++i) asm volatile("global_load_dword %0, %1, off offset:%2" : "=v"(e[i]) : "v"(p0), "i"(((i >> 2) * 128 + (i & 3) * 16) * 4) : "memory");
    }
    __device__ __forceinline__ void operator()(const f32x4 (&acc)[2][2][4][2], float (&e)[8], const Unit& u, int wr, int wc, int fr, int fq) const {
        const int row0 = u.pm * 256 + wr * 64 + fr, col0 = u.pn * 128 + wc * 32 + 8 * fq;
        epi_pre_wait(e);
        float r[2][4];
#pragma unroll
        for (int ai = 0; ai < 2; ++ai)
#pragma unroll
            for (int m = 0; m < 4; ++m) r[ai][m] = __builtin_amdgcn_rsqf(e[ai * 4 + m] * (1.0f / 1024.0f) + EPS);
#pragma unroll
        for (int ai = 0; ai < 2; ++ai)
#pragma unroll
            for (int m = 0; m < 4; ++m) {
                const float rr = r[ai][m], c1 = -1.4426950409f * rr, r2 = rr * rr;
                f32x4 o[2];
#pragma unroll
                for (int n = 0; n < 2; ++n)
#pragma unroll
                    for (int h = 0; h < 2; ++h) {
                        const f32x2 g2 = (f32x2){acc[ai][0][m][n][2 * h], acc[ai][0][m][n][2 * h + 1]}, u2 = (f32x2){acc[ai][1][m][n][2 * h], acc[ai][1][m][n][2 * h + 1]};
                        const f32x2 a2 = g2 * c1; f32x2 e2; e2.x = __builtin_amdgcn_exp2f(a2.x); e2.y = __builtin_amdgcn_exp2f(a2.y);
                        const f32x2 d2 = e2 + 1.0f; f32x2 q2; q2.x = __builtin_amdgcn_rcpf(d2.x); q2.y = __builtin_amdgcn_rcpf(d2.y);
                        const f32x2 t2 = ((g2 * u2) * r2) * q2;
                        o[n][2 * h] = t2.x; o[n][2 * h + 1] = t2.y; }
                *(u32x4*)(O + (size_t)(row0 + ai * 128 + m * 16) * FF + col0) = pack8(o[0], o[1]);
            }
    }
};
template <bool BASE_F32> struct EpiRes {
    static constexpr bool PERM = true, AFTER_DRAIN = false;
    const float* basef; bf16_t* xb; float* ss; float alpha;
    static constexpr int NPRE = 1;
    __device__ __forceinline__ void pre(float (&)[1], const Unit&, int, int, int, int) const {}
    __device__ __forceinline__ void operator()(const f32x4 (&acc)[2][2][4][2], float (&)[1], const Unit& u, int wr, int wc, int fr, int fq) const {
        const unsigned off0 = (unsigned)(u.pm * 256 + wr * 64 + fr) * (unsigned)D + (unsigned)(u.pn * 256 + wc * 32 + 8 * fq);
        const unsigned sso = (unsigned)(u.pm * 256 + wr * 64 + fr);
        u32x4 bw[2][4][2];
        if constexpr (!BASE_F32) {
#pragma unroll
            for (int ai = 0; ai < 2; ++ai)
#pragma unroll
                for (int m = 0; m < 4; ++m)
#pragma unroll
                    for (int bj = 0; bj < 2; ++bj) bw[ai][m][bj] = *(const u32x4*)(xb + off0 + (unsigned)((ai * 128 + m * 16) * D + bj * 128));
        }
#pragma unroll
        for (int ai = 0; ai < 2; ++ai)
#pragma unroll
            for (int m = 0; m < 4; ++m) {
                float sq = 0.f;
#pragma unroll
                for (int bj = 0; bj < 2; ++bj) {
                    const unsigned off = off0 + (unsigned)((ai * 128 + m * 16) * D + bj * 128);
                    f32x4 b0, b1;
                    if constexpr (BASE_F32) { b0 = *(const f32x4*)(basef + off); b1 = *(const f32x4*)(basef + off + 4); }
                    else { const u32x4 w = bw[ai][m][bj]; b0 = (f32x4){bf_lo(w.x), bf_hi(w.x), bf_lo(w.y), bf_hi(w.y)}; b1 = (f32x4){bf_lo(w.z), bf_hi(w.z), bf_lo(w.w), bf_hi(w.w)}; }
                    const f32x4 v0 = b0 + acc[ai][bj][m][0] * alpha, v1 = b1 + acc[ai][bj][m][1] * alpha;
                    *(u32x4*)(xb + off) = pack8(v0, v1);
                    sq += (v0[0] * v0[0] + v0[1] * v0[1]) + (v0[2] * v0[2] + v0[3] * v0[3]) + (v1[0] * v1[0] + v1[1] * v1[1]) + (v1[2] * v1[2] + v1[3] * v1[3]);
                }
                sq += __shfl_xor(sq, 16); sq += __shfl_xor(sq, 32);
                if (fq == 0) __hip_atomic_fetch_add(ss + sso + (unsigned)(ai * 128 + m * 16), sq, __ATOMIC_RELAXED, __HIP_MEMORY_SCOPE_AGENT);
                if (BASE_F32 && (m & 1)) asm volatile("" ::: "memory");
            }
    }
};
struct EpiResFinal {
    static constexpr bool PERM = true, AFTER_DRAIN = false;
    const bf16_t* xb; float* out; float* ss; unsigned* cnt; const float* gfin; float alpha;
    static constexpr int NPRE = 1;
    __device__ __forceinline__ void pre(float (&)[1], const Unit&, int, int, int, int) const {}
    __device__ __forceinline__ void operator()(f32x4 (&acc)[2][2][4][2], float (&)[1], const Unit& u, int wr, int wc, int fr, int fq) const {
        const unsigned off0 = (unsigned)(u.pm * 256 + wr * 64 + fr) * (unsigned)D + (unsigned)(u.pn * 256 + wc * 32 + 8 * fq);
        const unsigned sso = (unsigned)(u.pm * 256 + wr * 64 + fr);
        u32x4 bw[2][4][2];
#pragma unroll
        for (int ai = 0; ai < 2; ++ai)
#pragma unroll
            for (int m = 0; m < 4; ++m)
#pragma unroll
                for (int bj = 0; bj < 2; ++bj) bw[ai][m][bj] = *(const u32x4*)(xb + off0 + (unsigned)((ai * 128 + m * 16) * D + bj * 128));
#pragma unroll
        for (int ai = 0; ai < 2; ++ai)
#pragma unroll
            for (int m = 0; m < 4; ++m) {
                float sq = 0.f;
#pragma unroll
                for (int bj = 0; bj < 2; ++bj) {
                    const u32x4 w = bw[ai][m][bj];
                    const f32x4 b0 = (f32x4){bf_lo(w.x), bf_hi(w.x), bf_lo(w.y), bf_hi(w.y)}, b1 = (f32x4){bf_lo(w.z), bf_hi(w.z), bf_lo(w.w), bf_hi(w.w)};
                    const f32x4 v0 = b0 + acc[ai][bj][m][0] * alpha, v1 = b1 + acc[ai][bj][m][1] * alpha;
                    acc[ai][bj][m][0] = v0; acc[ai][bj][m][1] = v1;
                    sq += (v0[0] * v0[0] + v0[1] * v0[1]) + (v0[2] * v0[2] + v0[3] * v0[3]) + (v1[0] * v1[0] + v1[1] * v1[1]) + (v1[2] * v1[2] + v1[3] * v1[3]);
                }
                sq += __shfl_xor(sq, 16); sq += __shfl_xor(sq, 32);
                if (fq == 0) __hip_atomic_fetch_add(ss + sso + (unsigned)(ai * 128 + m * 16), sq, __ATOMIC_RELAXED, __HIP_MEMORY_SCOPE_AGENT);
            }
        asm volatile("s_waitcnt vmcnt(0)" ::: "memory");
        unsigned* c = cnt + 64 * u.pm;
        if (fr == 0 && fq == 0) __hip_atomic_fetch_add(c, 1u, __ATOMIC_RELAXED, __HIP_MEMORY_SCOPE_AGENT);
        unsigned spins = 0;
        while ((unsigned)__builtin_amdgcn_readfirstlane(__hip_atomic_load(c, __ATOMIC_RELAXED, __HIP_MEMORY_SCOPE_AGENT)) < 32u) { __builtin_amdgcn_s_sleep(2); if (++spins > (1u << 20)) break; }
        f32x4 gv[2][2];
#pragma unroll
        for (int bj = 0; bj < 2; ++bj)
#pragma unroll
            for (int n = 0; n < 2; ++n) gv[bj][n] = *(const f32x4*)(gfin + u.pn * 256 + bj * 128 + wc * 32 + 8 * fq + 4 * n);
        float tot[2][4];
#pragma unroll
        for (int ai = 0; ai < 2; ++ai)
#pragma unroll
            for (int m = 0; m < 4; ++m) tot[ai][m] = __hip_atomic_load(ss + sso + (unsigned)(ai * 128 + m * 16), __ATOMIC_RELAXED, __HIP_MEMORY_SCOPE_AGENT);
#pragma unroll
        for (int ai = 0; ai < 2; ++ai)
#pragma unroll
            for (int m = 0; m < 4; ++m) { const float r = __builtin_amdgcn_rsqf(tot[ai][m] * (1.0f / 1024.0f) + EPS);
#pragma unroll
                for (int bj = 0; bj < 2; ++bj) { const unsigned off = off0 + (unsigned)((ai * 128 + m * 16) * D + bj * 128);
                    __builtin_nontemporal_store(acc[ai][bj][m][0] * r * gv[bj][0], (f32x4*)(out + off)); __builtin_nontemporal_store(acc[ai][bj][m][1] * r * gv[bj][1], (f32x4*)(out + off + 4)); } }
    }
};
struct EpiWin {
    static constexpr bool PERM = true, AFTER_DRAIN = false;
    bf16_t *U, *V, *Z; const float* ss;
    static constexpr int NPRE = 8;
    __device__ __forceinline__ void pre(float (&e)[8], const Unit& u, int wr, int wc, int fr, int fq) const {
        const float* p0 = ss + (u.pm * 256 + wr * 64 + fr);
#pragma unroll
        for (int i = 0; i < 8; ++i) asm volatile("global_load_dword %0, %1, off offset:%2" : "=v"(e[i]) : "v"(p0), "i"(((i >> 2) * 128 + (i & 3) * 16) * 4) : "memory");
    }
    __device__ __forceinline__ void operator()(const f32x4 (&acc)[2][2][4][2], float (&e)[8], const Unit& u, int wr, int wc, int fr, int fq) const {
        const int row0 = u.pm * 256 + wr * 64 + fr;
        epi_pre_wait(e);
        float r[2][4];
#pragma unroll
        for (int ai = 0; ai < 2; ++ai)
#pragma unroll
            for (int m = 0; m < 4; ++m) r[ai][m] = __builtin_amdgcn_rsqf(e[ai * 4 + m] * (1.0f / 1024.0f) + EPS);
        if (u.pn < 2) {
            const int col0 = u.pn * 256 + wc * 32 + 8 * fq;
#pragma unroll
            for (int ai = 0; ai < 2; ++ai)
#pragma unroll
                for (int m = 0; m < 4; ++m) { const float rr = r[ai][m]; bf16_t* rowp = U + (size_t)(row0 + ai * 128 + m * 16) * AW + col0;
#pragma unroll
                    for (int bj = 0; bj < 2; ++bj) { f32x4 o0, o1;
#pragma unroll
                        for (int h = 0; h < 2; ++h) { const f32x2 x0 = gelu2((f32x2){acc[ai][bj][m][0][2 * h], acc[ai][bj][m][0][2 * h + 1]}, rr), x1 = gelu2((f32x2){acc[ai][bj][m][1][2 * h], acc[ai][bj][m][1][2 * h + 1]}, rr);
                            o0[2 * h] = x0.x; o0[2 * h + 1] = x0.y; o1[2 * h] = x1.x; o1[2 * h + 1] = x1.y; }
                        *(u32x4*)(rowp + bj * 128) = pack8(o0, o1); } }
        } else if (u.pn < 4) {
            const int colb = 64 * ((u.pn - 2) * 4 + wc) + 8 * fq;
#pragma unroll
            for (int ai = 0; ai < 2; ++ai)
#pragma unroll
                for (int m = 0; m < 4; ++m) { const float rr = r[ai][m]; f32x4 g[2][2]; float sq = 0.f;
#pragma unroll
                    for (int bj = 0; bj < 2; ++bj)
#pragma unroll
                        for (int n = 0; n < 2; ++n)
#pragma unroll
                            for (int h = 0; h < 2; ++h) { const f32x2 t = gelu2((f32x2){acc[ai][bj][m][n][2 * h], acc[ai][bj][m][n][2 * h + 1]}, rr); g[bj][n][2 * h] = t.x; g[bj][n][2 * h + 1] = t.y; sq += t.x * t.x + t.y * t.y; }
                    sq += __shfl_xor(sq, 16); sq += __shfl_xor(sq, 32);
                    const float hr = __builtin_amdgcn_rsqf(sq * (1.0f / 64.0f) + EPS);
                    bf16_t* rowp = V + (size_t)(row0 + ai * 128 + m * 16) * AW + colb;
#pragma unroll
                    for (int bj = 0; bj < 2; ++bj) *(u32x4*)(rowp + 32 * bj) = pack8(g[bj][0] * hr, g[bj][1] * hr); }
        } else {
            const int col0 = (u.pn - 4) * 256 + wc * 32 + 8 * fq;
#pragma unroll
            for (int ai = 0; ai < 2; ++ai)
#pragma unroll
                for (int m = 0; m < 4; ++m) { const float rr = r[ai][m]; bf16_t* rowp = Z + (size_t)(row0 + ai * 128 + m * 16) * AW + col0;
#pragma unroll
                    for (int bj = 0; bj < 2; ++bj) *(u32x4*)(rowp + bj * 128) = pack8(acc[ai][bj][m][0] * rr, acc[ai][bj][m][1] * rr); }
        }
    }
};

__device__ __forceinline__ float wave_sum(float v) {
#pragma unroll
    for (int o = 1; o < 64; o <<= 1) v += __shfl_xor(v, o);
    return v;
}
__device__ __forceinline__ void p0_transpose_item(const float* src, int ld, int Kd, int k0, int scol0, bf16_t* dst, int drow0, const float* gk, LAS float* scr, int lane) {
    float tv[32];
#pragma unroll
    for (int i = 0; i < 32; ++i) { const int kk = 2 * i + (lane >> 5); tv[i] = src[(size_t)(k0 + kk) * ld + scol0 + (lane & 31)]; }
    if (gk) {
#pragma unroll
        for (int i = 0; i < 32; ++i) tv[i] *= gk[k0 + 2 * i + (lane >> 5)];
    }
#pragma unroll
    for (int i = 0; i < 32; ++i) scr[(2 * i + (lane >> 5)) * 33 + (lane & 31)] = tv[i];
    asm volatile("s_waitcnt lgkmcnt(0)" ::: "memory");
    const int c = lane & 7;
#pragma unroll
    for (int j = 0; j < 4; ++j) { const int n = (lane >> 3) + 8 * j; const LAS float* s = scr + (8 * c) * 33 + n;
        u32x4 o; o.x = pg8::cvt_pk_bf16(s[0 * 33], s[1 * 33]); o.y = pg8::cvt_pk_bf16(s[2 * 33], s[3 * 33]); o.z = pg8::cvt_pk_bf16(s[4 * 33], s[5 * 33]); o.w = pg8::cvt_pk_bf16(s[6 * 33], s[7 * 33]);
        *(u32x4*)(dst + (size_t)(drow0 + n) * Kd + k0 + 8 * c) = o; }
    asm volatile("s_waitcnt lgkmcnt(0)" ::: "memory");
}

struct Params { const float* in[18]; float* out; unsigned char* ws; int ph_lo, ph_hi; };

__device__ __forceinline__ void p0_prep(const Params& p, LAS unsigned char* lds, int tid, int wave, int lane) {
    unsigned char* ws = p.ws;
    LAS float* scr = (LAS float*)(lds + wave * 16384);
    const int gw = blockIdx.x * 4 + (wave & 3), NGW = gridDim.x * 4;
    constexpr int I_A = 16 * 176, I_D = 44 * 32, I_IN = 16 * 32, I_OUT = 16 * 32, I_ZP = 1024;
    constexpr int NITEMS = I_ZP + 2 * (I_A + I_D) + I_IN + I_OUT;
    bf16_t* XB = (bf16_t*)(ws + WS_XB); float* ss = (float*)(ws + WS_SS);
    if (wave >= 4) {
    for (int it = gw; it < NITEMS; it += NGW) {
        int r = it;
        if (r < I_ZP) {
            const int g = r >> 8, kb = (r >> 4) & 15, jb = r & 15, k = 64 * kb + lane;
            const float* __restrict__ wrow = p.in[6] + (size_t)k * NIN + 1024 + 128 * g;
            const float* __restrict__ wp = p.in[10] + (size_t)g * 16384 + 8 * jb;
            float a[8];
#pragma unroll
            for (int j = 0; j < 8; ++j) a[j] = 0.f;
#pragma unroll
            for (int b = 0; b < 4; ++b) { f32x4 w4[8];
#pragma unroll
                for (int q = 0; q < 8; ++q) w4[q] = *(const f32x4*)(wrow + 32 * b + 4 * q);
#pragma unroll
                for (int q = 0; q < 8; ++q)
#pragma unroll
                    for (int e = 0; e < 4; ++e) { const float* wpi = wp + (size_t)(32 * b + 4 * q + e) * 128;
#pragma unroll
                        for (int j = 0; j < 8; ++j) a[j] += w4[q][e] * wpi[j]; } }
            const float gm = p.in[5][k];
            bf16_t* dst = (bf16_t*)(ws + WS_WIN) + (size_t)(1024 + 128 * g + 8 * jb) * D + k;
#pragma unroll
            for (int j = 0; j < 8; ++j) dst[(size_t)j * D] = (bf16_t)(pg8::cvt_pk_bf16(a[j] * gm, 0.f) & 0xffffu);
            continue;
        }
        r -= I_ZP;
        if (r < 2 * (I_A + I_D)) {
            const int l = r >= (I_A + I_D); if (l) r -= (I_A + I_D);
            const float* nrm = l ? p.in[13] : p.in[1]; const float* wg = l ? p.in[14] : p.in[2]; const float* wu = l ? p.in[15] : p.in[3]; const float* wd = l ? p.in[16] : p.in[4];
            bf16_t* dA = (bf16_t*)(ws + (l ? WS_W2A : WS_W1A)); bf16_t* dD = (bf16_t*)(ws + (l ? WS_W2D : WS_W1D));
            if (r < I_A) { const int kb = r / 176, rb = r % 176, pn = rb >> 3, bj = (rb >> 2) & 1, c0 = (rb & 3) * 32;
                p0_transpose_item(bj ? wu : wg, FF, D, 64 * kb, 128 * pn + c0, dA, 32 * rb, nrm, scr, lane); }
            else { r -= I_A; const int kb = r / 32, rb = r % 32; p0_transpose_item(wd, D, FF, 64 * kb, 32 * rb, dD, 32 * rb, nullptr, scr, lane); }
            continue;
        }
        r -= 2 * (I_A + I_D);
        if (r < I_IN) { const int kb = r / 32, rb = r % 32; int sc;
            if (rb < 16) sc = 32 * rb; else { const int q = rb - 16, pn = q >> 3, bj = (q >> 2) & 1, wc = q & 3; sc = 512 + 64 * (4 * pn + wc) + 32 * bj; }
            p0_transpose_item(p.in[6], NIN, D, 64 * kb, sc, (bf16_t*)(ws + WS_WIN), 32 * rb, p.in[5], scr, lane); continue; }
        r -= I_IN;
        { const int kb = r / 32, rb = r % 32; p0_transpose_item(p.in[12], D, D, 64 * kb, 32 * rb, (bf16_t*)(ws + WS_WOUT), 32 * rb, nullptr, scr, lane); }
    }
    for (int e8 = blockIdx.x * 256 + (tid - 256); e8 < 8 * 128 * 128 / 8; e8 += gridDim.x * 256) {
        const int e = e8 * 8, t = (e >> 7) & 127, s0 = e & 127;
        const f32x4 a = *(const f32x4*)(p.in[8] + e), b = *(const f32x4*)(p.in[8] + e + 4); f32x4 ma, mb;
#pragma unroll
        for (int j = 0; j < 4; ++j) { ma[j] = (s0 + j <= t) ? a[j] : 0.f; mb[j] = (s0 + 4 + j <= t) ? b[j] : 0.f; }
        *(u32x4*)((bf16_t*)(ws + WS_WM) + e) = pack8(ma, mb);
    }
    for (int i = blockIdx.x * 256 + (tid - 256); i < 3 * M / 4; i += gridDim.x * 256) ((f32x4*)(ss + SS_STRIDE))[i] = (f32x4){0.f, 0.f, 0.f, 0.f};
    return;
    }
    for (int m = gw; m < M; m += 4 * NGW) {
        f32x4 v[4][4];
#pragma unroll
        for (int q = 0; q < 4; ++q) { const int mq = (m + q * NGW < M) ? m + q * NGW : m; const f32x4* xr = (const f32x4*)(p.in[0] + (size_t)mq * D) + lane;
#pragma unroll
            for (int j = 0; j < 4; ++j) v[q][j] = __builtin_nontemporal_load(xr + 64 * j); }
#pragma unroll
        for (int q = 0; q < 4; ++q) { const int mq = m + q * NGW; if (mq < M) {
            float sq = 0.f;
#pragma unroll
            for (int j = 0; j < 4; ++j) sq += (v[q][j][0] * v[q][j][0] + v[q][j][1] * v[q][j][1]) + (v[q][j][2] * v[q][j][2] + v[q][j][3] * v[q][j][3]);
            sq = wave_sum(sq);
            u32x2* o = (u32x2*)(XB + (size_t)mq * D) + lane;
#pragma unroll
            for (int j = 0; j < 4; ++j) { u32x2 w; w.x = pg8::cvt_pk_bf16(v[q][j][0], v[q][j][1]); w.y = pg8::cvt_pk_bf16(v[q][j][2], v[q][j][3]); o[64 * j] = w; }
            if (lane == 0) ss[mq] = sq; } }
    }
}

__device__ __forceinline__ f32x4 unpack4(const u32x2 z) { return (f32x4){bf_lo(z.x), bf_hi(z.x), bf_lo(z.y), bf_hi(z.y)}; }
template <int WIN> __device__ __forceinline__ void pool_task(const bf16_t* __restrict__ zc, bf16_t* __restrict__ yc, const size_t Rt, const int pos0, const f32x4 sc) {
    constexpr int H = WIN - 1;
    u32x2 raw[H + 8];
#pragma unroll
    for (int i = 0; i < H + 8; ++i) { const bool ok = pos0 - H + i >= 0; raw[i] = *(const u32x2*)(zc + (ok ? Rt - H + i : Rt) * AW); if (!ok) raw[i] = (u32x2){0u, 0u}; }
    f32x4 s = (f32x4){0.f, 0.f, 0.f, 0.f};
#pragma unroll
    for (int i = 0; i < H; ++i) s += unpack4(raw[i]);
#pragma unroll
    for (int t = 0; t < 8; ++t) {
        const f32x4 zt = unpack4(raw[H + t]); s += zt;
        const int pos = pos0 + t, cnt = (pos + 1 < WIN) ? pos + 1 : WIN; const float inv = 1.0f / (float)cnt;
        const f32x4 o = (s * inv - zt) * sc;
        u32x2 w; w.x = pg8::cvt_pk_bf16(o[0], o[1]); w.y = pg8::cvt_pk_bf16(o[2], o[3]);
        *(u32x2*)(yc + (Rt + t) * D) = w;
        s -= unpack4(raw[t]);
    }
}
__device__ __forceinline__ void p4_mixer(const Params& p, LAS unsigned char* lds, int tid, int wave, int lane, int vc) {
    unsigned char* ws = p.ws;
    const bf16_t* __restrict__ U = (const bf16_t*)(ws + WS_U); const bf16_t* __restrict__ V = (const bf16_t*)(ws + WS_V); const bf16_t* __restrict__ Z = (const bf16_t*)(ws + WS_Z); bf16_t* __restrict__ Y = (bf16_t*)(ws + WS_Y);
    const bf16_t* __restrict__ Wm = (const bf16_t*)(ws + WS_WM); const float* __restrict__ bs = p.in[9]; const float* __restrict__ pscale = p.in[11]; const float* __restrict__ vgain = p.in[7];
    constexpr int P = 136;
    LAS bf16_t* Vt = (LAS bf16_t*)lds;
    const int fr = lane & 15, fq = lane >> 4;
    for (int chunk = (gridDim.x == 256) ? 32 * (vc & 7) + (vc >> 3) : (int)blockIdx.x; chunk < M / 128; chunk += gridDim.x) {
        const size_t R0 = (size_t)chunk * 128;
        const int vs = tid & 127, cq0 = tid >> 7; u32x4 vreg[16];
        {
            const bf16_t* vrow = V + (R0 + vs) * AW + 8 * cq0;
#pragma unroll
            for (int it = 0; it < 16; ++it) vreg[it] = *(const u32x4*)(vrow + 32 * it);
        }
        {
            const int g = wave & 3, cq = 32 * g + (lane & 31), q4 = (wave >> 2) * 2 + (lane >> 5);
            const bf16_t* zc = Z + 4 * cq; bf16_t* yc = Y + 512 + 4 * cq; const f32x4 sc = *(const f32x4*)(pscale + 4 * cq);
            const int pb = (chunk & 31) * 128 + 32 * q4; const size_t Rb = R0 + 32 * q4;
#pragma unroll 1
            for (int k = 0; k < 4; ++k) {
                if (g == 0) pool_task<2>(zc, yc, Rb + 8 * k, pb + 8 * k, sc);
                else if (g == 1) pool_task<4>(zc, yc, Rb + 8 * k, pb + 8 * k, sc);
                else if (g == 2) pool_task<8>(zc, yc, Rb + 8 * k, pb + 8 * k, sc);
                else pool_task<16>(zc, yc, Rb + 8 * k, pb + 8 * k, sc);
            }
        }
        {
#pragma unroll
            for (int it = 0; it < 16; ++it) { LAS bf16_t* d = Vt + (8 * (cq0 + 4 * it)) * P + vs;
                d[0 * P] = (bf16_t)(vreg[it].x & 0xffffu); d[1 * P] = (bf16_t)(vreg[it].x >> 16); d[2 * P] = (bf16_t)(vreg[it].y & 0xffffu); d[3 * P] = (bf16_t)(vreg[it].y >> 16);
                d[4 * P] = (bf16_t)(vreg[it].z & 0xffffu); d[5 * P] = (bf16_t)(vreg[it].z >> 16); d[6 * P] = (bf16_t)(vreg[it].w & 0xffffu); d[7 * P] = (bf16_t)(vreg[it].w >> 16); }
        }
        __syncthreads();
#pragma unroll 1
        for (int ib = 0; ib < 8; ib += 4) {
            bf16x8 wf[4][4]; float bias[4]; u32x2 uu[4][4]; f32x4 gn[4][4];
#pragma unroll
            for (int j = 0; j < 4; ++j) { const int h = ib + j, ts = (wave + h) & 7, t = 16 * ts + fr; const size_t row = R0 + t;
                const bf16_t* wrow = Wm + (size_t)(h * 128 + t) * 128 + 8 * fq;
#pragma unroll
                for (int ks = 0; ks < 4; ++ks) wf[j][ks] = *(const bf16x8*)(wrow + 32 * ks);
                bias[j] = bs[h * 128 + t];
#pragma unroll
                for (int nb = 0; nb < 4; ++nb) { const int col = 64 * h + 16 * nb + 4 * fq; uu[j][nb] = *(const u32x2*)(U + row * AW + col); gn[j][nb] = *(const f32x4*)(vgain + col); } }
#pragma unroll
            for (int j = 0; j < 4; ++j) { const int h = ib + j, ts = (wave + h) & 7, t = 16 * ts + fr, nks = (ts >> 1) + 1; const size_t row = R0 + t;
                f32x4 acc[4];
#pragma unroll
                for (int nb = 0; nb < 4; ++nb) acc[nb] = (f32x4){0.f, 0.f, 0.f, 0.f};
#pragma unroll
                for (int ks = 0; ks < 4; ++ks) if (ks < nks) {
#pragma unroll
                    for (int nb = 0; nb < 4; ++nb) { const bf16x8 vf = *(const LAS bf16x8*)(Vt + (64 * h + 16 * nb + fr) * P + 32 * ks + 8 * fq);
                        acc[nb] = __builtin_amdgcn_mfma_f32_16x16x32_bf16(vf, wf[j][ks], acc[nb], 0, 0, 0); }
                }
#pragma unroll
                for (int nb = 0; nb < 4; ++nb) { const int col = 64 * h + 16 * nb + 4 * fq;
                    u32x2 w; w.x = pg8::cvt_pk_bf16(bf_lo(uu[j][nb].x) * (acc[nb][0] * gn[j][nb][0] + bias[j]), bf_hi(uu[j][nb].x) * (acc[nb][1] * gn[j][nb][1] + bias[j]));
                    w.y = pg8::cvt_pk_bf16(bf_lo(uu[j][nb].y) * (acc[nb][2] * gn[j][nb][2] + bias[j]), bf_hi(uu[j][nb].y) * (acc[nb][3] * gn[j][nb][3] + bias[j]));
                    *(u32x2*)(Y + row * D + col) = w; } }
        }
        __syncthreads();
    }
}

#define XB_TMO      128
#define XB_XCNT(j)  (256  + 64 * (j))
#define XB_XSUB(j)  (1280 + 64 * (j))
#define XB_XGEN(j)  (2304 + 64 * (j))
#define XB_TOP      3328
#define XB_TOPGEN   3392
#define XCD_BAR_WORDS 3456
#define XB_SPIN_CAP (1u << 18)

__device__ __forceinline__ unsigned xb_ld(unsigned* p)              { return __hip_atomic_load(p, __ATOMIC_RELAXED, __HIP_MEMORY_SCOPE_AGENT); }
__device__ __forceinline__ unsigned xb_add(unsigned* p, unsigned v) { return __hip_atomic_fetch_add(p, v, __ATOMIC_RELAXED, __HIP_MEMORY_SCOPE_AGENT); }
__device__ __forceinline__ unsigned xb_xcc_id() { return (unsigned)__builtin_amdgcn_s_getreg((3 << 11) | 20) & 0xFu; }
#define XB_SPIN(cond, bar) do { unsigned _sp = 0; while (cond) { __builtin_amdgcn_s_sleep(1); \
    if ((++_sp & 255u) == 0u) { if (xb_ld(&(bar)[XB_TMO])) break; if (_sp > XB_SPIN_CAP) { atomicAdd(&(bar)[XB_TMO], 1u); break; } } } } while (0)

struct XcdBarrier {
    unsigned* bar; unsigned x;
    volatile __attribute__((address_space(3))) unsigned* st;
};

__device__ __forceinline__ XcdBarrier xcd_barrier_post(unsigned* bar, volatile __attribute__((address_space(3))) unsigned* st) {
    XcdBarrier b; b.bar = bar; b.x = xb_xcc_id(); b.st = st;
    if (threadIdx.x == 0) st[2] = xb_add(&bar[XB_XCNT(b.x)], 1u);
    return b;
}
__device__ __forceinline__ void xcd_barrier_complete(unsigned* bar, unsigned x, unsigned& nloc, unsigned& nx) {
    const unsigned G = gridDim.x * gridDim.y * gridDim.z;
    unsigned sum, cnt, mine, sp = 0u;
    for (;;) {
        sum = 0u; cnt = 0u; mine = 0u;
#pragma unroll
        for (unsigned j = 0; j < 16; ++j) { const unsigned c = xb_ld(&bar[XB_XCNT(j)]); sum += c; cnt += (c > 0u) ? 1u : 0u; mine = (j == x) ? c : mine; }
        if (sum == G) break;
        __builtin_amdgcn_s_sleep(1);
        if ((++sp & 255u) == 0u) { if (xb_ld(&bar[XB_TMO])) break; if (sp > XB_SPIN_CAP) { atomicAdd(&bar[XB_TMO], 1u); break; } }
    }
    nloc = mine > 0u ? mine : 1u; nx = cnt > 0u ? cnt : 1u;
}
__device__ __forceinline__ unsigned xcd_census_is_8x32(unsigned* bar) {
    unsigned ok = (gridDim.x == 256u) ? 1u : 0u;
#pragma unroll
    for (unsigned j = 0; j < 16; ++j) { const unsigned c = xb_ld(&bar[XB_XCNT(j)]); if (c != (j < 8u ? 32u : 0u)) ok = 0u; }
    return ok;
}

__device__ __forceinline__ void xcd_barrier(const XcdBarrier& b) {
    asm volatile("s_waitcnt vmcnt(0)" ::: "memory");
    __syncthreads();
    if (threadIdx.x == 0) {
        unsigned* bar = b.bar;
        __builtin_amdgcn_s_waitcnt(0);
        unsigned nloc = b.st[0], nx = b.st[1];
        if (nloc == 0u) { xcd_barrier_complete(bar, b.x, nloc, nx); b.st[0] = nloc; b.st[1] = nx; b.st[3] = xcd_census_is_8x32(bar); }
        const unsigned old = xb_add(&bar[XB_XSUB(b.x)], 1u);
        const unsigned gen = old / nloc;
        if (old + 1u == (gen + 1u) * nloc) {
            __builtin_amdgcn_fence(__ATOMIC_RELEASE, "agent");
            asm volatile("s_waitcnt vmcnt(0)" ::: "memory");
            const unsigned og = xb_add(&bar[XB_TOP], 1u);
            const unsigned tg = og / nx;
            if (og + 1u == (tg + 1u) * nx) xb_add(&bar[XB_TOPGEN], 1u);
            else XB_SPIN(xb_ld(&bar[XB_TOPGEN]) == tg, bar);
            __builtin_amdgcn_fence(__ATOMIC_ACQUIRE, "agent");
            xb_add(&bar[XB_XGEN(b.x)], 1u);
            asm volatile("s_waitcnt vmcnt(0)" ::: "memory");
        } else {
            XB_SPIN(xb_ld(&bar[XB_XGEN(b.x)]) == gen, bar);
            __builtin_amdgcn_fence(__ATOMIC_ACQUIRE, "agent");
            asm volatile("s_waitcnt vmcnt(0)" ::: "memory");
        }
    }
    __syncthreads();
}

#define XB_LSUB(j)  (12288 + 64 * (j))
#define XB_LGEN(j)  (13312 + 64 * (j))
__device__ __forceinline__ void xcd_local_barrier(const XcdBarrier& b) {
    asm volatile("s_waitcnt vmcnt(0)" ::: "memory");
    __syncthreads();
    if (threadIdx.x == 0) {
        unsigned* bar = b.bar;
        __builtin_amdgcn_s_waitcnt(0);
        const unsigned nloc = b.st[0];
        const unsigned old = xb_add(&bar[XB_LSUB(b.x)], 1u);
        const unsigned gen = old / nloc;
        if (old + 1u == (gen + 1u) * nloc) xb_add(&bar[XB_LGEN(b.x)], 1u);
        else XB_SPIN(xb_ld(&bar[XB_LGEN(b.x)]) == gen, bar);
        __builtin_amdgcn_fence(__ATOMIC_ACQUIRE, "agent");
        asm volatile("s_waitcnt vmcnt(0)" ::: "memory");
    }
    __syncthreads();
}

__device__ __forceinline__ void stagger_wait(int c, unsigned ticks) {
    const unsigned g = ((unsigned)c >> 3) & 3u;
    if (g) { const unsigned long long t0 = __builtin_amdgcn_s_memrealtime(); while (__builtin_amdgcn_s_memrealtime() - t0 < (unsigned long long)(g * ticks)) __builtin_amdgcn_s_sleep(8); }
}
template <int PH> __device__ __forceinline__ void run_phase(const Params& p, LAS unsigned char* lds, const int wave0, const int c) {
    int tid = wave0 * 64 + (int)__builtin_amdgcn_mbcnt_hi(~0u, __builtin_amdgcn_mbcnt_lo(~0u, 0u)); asm volatile("" : "+v"(tid));
    const int lane = tid & 63, wave = __builtin_amdgcn_readfirstlane(tid >> 6);
    unsigned char* ws = p.ws;
    bf16_t* XB = (bf16_t*)(ws + WS_XB); bf16_t* ACT = (bf16_t*)(ws + WS_ACT); float* ss = (float*)(ws + WS_SS);
    const int G = gridDim.x;
    if constexpr (PH == 0) p0_prep(p, lds, tid, wave, lane);
    if constexpr (PH == 1 || PH == 6) {
        pg8::Gemm g{XB, (const bf16_t*)(ws + (PH == 1 ? WS_W1A : WS_W2A)), M, 2 * FF, D}; pg8::StaticOrder S; S.init(M, 2 * FF, G, c);
        EpiSwiglu E{ACT, ss + (PH == 1 ? 0 : 2) * SS_STRIDE};
        pg8::gemm_phase<EpiSwiglu, pg8::StaticOrder, true, true>(lds, g, S, E, tid);
    }
    if constexpr (PH == 2) {
        pg8::Gemm g{ACT, (const bf16_t*)(ws + WS_W1D), M, D, FF}; pg8::StaticOrder S; S.init(M, D, G, c);
        EpiRes<false> E{nullptr, XB, ss + SS_STRIDE, 0.5f};
        pg8::gemm_phase<EpiRes<false>, pg8::StaticOrder, true, true>(lds, g, S, E, tid);
    }
    if constexpr (PH == 7) {
        pg8::Gemm g{ACT, (const bf16_t*)(ws + WS_W2D), M, D, FF}; pg8::StaticOrder S; S.init(M, D, G, c);
        EpiResFinal E{XB, p.out, ss + 3 * SS_STRIDE, (unsigned*)(ws + WS_CTL) + CNT_WORD0, p.in[17], 0.5f};
        pg8::gemm_phase<EpiResFinal, pg8::StaticOrder, true, true>(lds, g, S, E, tid);
    }
    if constexpr (PH == 3) {
        pg8::Gemm g{XB, (const bf16_t*)(ws + WS_WIN), M, NIN, D}; pg8::StaticOrder S; S.init(M, NIN, G, c);
        EpiWin E{(bf16_t*)(ws + WS_U), (bf16_t*)(ws + WS_V), (bf16_t*)(ws + WS_Z), ss + SS_STRIDE};
        pg8::gemm_phase<EpiWin, pg8::StaticOrder, true, true>(lds, g, S, E, tid);
    }
    if constexpr (PH == 4) p4_mixer(p, lds, tid, wave, lane, c);
    if constexpr (PH == 5) {
        pg8::Gemm g{(const bf16_t*)(ws + WS_Y), (const bf16_t*)(ws + WS_WOUT), M, D, D}; pg8::StaticOrder S; S.init(M, D, G, c);
        EpiRes<false> E{nullptr, XB, ss + 2 * SS_STRIDE, 1.0f};
        pg8::gemm_phase<EpiRes<false>, pg8::StaticOrder, true, true>(lds, g, S, E, tid);
    }
}
__global__ void __launch_bounds__(512, 2) fwd(Params p) {
    extern __shared__ __attribute__((aligned(16))) unsigned char lds_raw[];
    LAS unsigned char* lds = (LAS unsigned char*)lds_raw;
    const int wave0 = __builtin_amdgcn_readfirstlane(threadIdx.x >> 6);
    const int lo = p.ph_lo, hi = p.ph_hi;
    volatile LAS unsigned* st = (volatile LAS unsigned*)(lds + LDS_BYTES - 64);
    if (threadIdx.x < 4) st[threadIdx.x] = 0u;
    __syncthreads();
    XcdBarrier bar; bar.bar = (unsigned*)(p.ws + WS_CTL); bar.x = 0; bar.st = st;
    const bool use_cg = hi > 8;
    if (hi - lo > 1 && !use_cg) bar = xcd_barrier_post((unsigned*)(p.ws + WS_CTL), st);
    int vc = blockIdx.x; bool local_ok = false;
#define MK_SEAM() do { if (use_cg) cg::this_grid().sync(); else if (local_ok) xcd_local_barrier(bar); else xcd_barrier(bar); } while (0)
#define MK_PHASE(k) if (lo <= (k) && (k) < hi) { if ((PHM >> (k)) & 1) run_phase<k>(p, lds, wave0, vc); if (PROBE_REP == (k)) { MK_SEAM(); run_phase<k>(p, lds, wave0, vc); } if ((k) + 1 < hi) MK_SEAM(); }
    MK_PHASE(0)
    if (hi - lo > 1 && !use_cg && lo == 0) { local_ok = __builtin_amdgcn_readfirstlane((int)st[3]) != 0; if (local_ok) vc = __builtin_amdgcn_readfirstlane((int)(st[2] * 8u + bar.x)); }
    MK_PHASE(1) MK_PHASE(2) MK_PHASE(3) MK_PHASE(4) MK_PHASE(5) MK_PHASE(6) MK_PHASE(7)
#undef MK_SEAM
#undef MK_PHASE
}
}

extern "C" void kernel_launch(void* const* d_in, const int* in_sizes, int n_in, void* d_out, int out_size, void* d_ws, size_t ws_size, hipStream_t stream) {
    static int grid = 0;
    if (grid == 0) {
        if (n_in != 18 || out_size != mk::M * mk::D || ws_size < mk::WS_END) { fprintf(stderr, "kernel_launch: unexpected shapes (n_in %d out %d ws %zu)\n", n_in, out_size, ws_size); grid = -1; return; }
        int dev = 0, cus = 0;
        if (hipGetDevice(&dev) != hipSuccess || hipDeviceGetAttribute(&cus, hipDeviceAttributeMultiprocessorCount, dev) != hipSuccess) { grid = -1; return; }
        if (hipFuncSetAttribute((const void*)mk::fwd, hipFuncAttributeMaxDynamicSharedMemorySize, mk::LDS_BYTES) != hipSuccess) { fprintf(stderr, "kernel_launch: hipFuncSetAttribute failed\n"); grid = -1; return; }
        grid = cus;
    }
    if (grid < 0) return;
    mk::Params p{};
    for (int i = 0; i < 18; ++i) p.in[i] = (const float*)d_in[i];
    p.out = (float*)d_out; p.ws = (unsigned char*)d_ws;
    if (hipMemsetAsync((char*)d_ws + mk::WS_CTL, 0, mk::CTL_BYTES, stream) != hipSuccess) { fprintf(stderr, "kernel_launch: memset of the barrier words failed\n"); return; }
#if MK_LAUNCHES == 1
    p.ph_lo = 0; p.ph_hi = 8;
    void* args[] = {&p};
    hipError_t e = hipLaunchCooperativeKernel((const void*)mk::fwd, dim3(grid), dim3(512), args, mk::LDS_BYTES, stream);
    if (e != hipSuccess) fprintf(stderr, "cooperative launch failed: %s (grid %d)\n", hipGetErrorString(e), grid);
#else
    for (int ph = 0; ph < 8; ++ph) { p.ph_lo = ph; p.ph_hi = ph + 1; hipLaunchKernelGGL(mk::fwd, dim3(grid), dim3(512), mk::LDS_BYTES, stream, p); }
#endif
}
```

```cpp
#include <hip/hip_runtime.h>
#include <hip/hip_cooperative_groups.h>
#include <cstdio>
#include <cstdint>
namespace cg = cooperative_groups;
#ifndef PHM
#define PHM 0x1ff
#endif
#ifndef PROBE_REP
#define PROBE_REP -1
#endif
#ifndef MK_LAUNCHES
#define MK_LAUNCHES 1
#endif
namespace pg8 {
#define PG8_LAS __attribute__((address_space(3)))
typedef unsigned short bf16_t;
typedef short bf16x8 __attribute__((ext_vector_type(8)));
typedef float f32x4 __attribute__((ext_vector_type(4)));
typedef unsigned u32x4 __attribute__((ext_vector_type(4)));
constexpr int BM = 256, BK = 64, HALF = 128, HTB = HALF * BK * 2  , STAGE_BYTES = 8 * HTB, NXCD = 8, WGM = 8;

__host__ __device__ __forceinline__ int lds_byte(int r, int c) { const int st = (r >> 4) * 2 + (c >> 5), rr = r & 15, cc = c & 31, ob = rr * 64 + cc * 2; return st * 1024 + (ob ^ (((ob >> 9) & 1) << 5)); }
__host__ __device__ __forceinline__ void stage_rc(int b, int& R, int& C) { const int st = b / 1024, sb = b % 1024, swz = sb ^ (((sb >> 9) & 1) << 5); R = (st >> 1) * 16 + swz / 64; C = (st & 1) * 32 + (swz % 64) / 2; }
__host__ __device__ __forceinline__ int perm32(int rho) { const int n = rho >> 4, i = rho & 15; return 8 * (i >> 2) + 4 * n + (i & 3); }

struct Unit { int pm, pn; };
struct Gemm { const bf16_t* A; const bf16_t* Bt; int M, N, K; int lda = 0; };

struct StaticOrder {
    int nM, nN, nwg, G, c;
    __host__ __device__ void init(int M, int N, int G_, int c_) { nM = M / BM; nN = N / BM; nwg = nM * nN; G = G_; c = c_; }
    __host__ __device__ bool next(int i, Unit& u) const {
        const long L = (long)i * G + c; if (L >= nwg) return false;
        int wgid = (int)L; { const int q = nwg / NXCD, r = nwg % NXCD, xcd = wgid % NXCD, off = wgid / NXCD; wgid = (xcd < r ? xcd * (q + 1) : r * (q + 1) + (xcd - r) * q) + off; }
        const int nig = WGM * nN, gid = wgid / nig, fm = gid * WGM, gsz = (nM - fm) < WGM ? (nM - fm) : WGM;
        u.pm = fm + ((wgid % nig) % gsz); u.pn = (wgid % nig) / gsz; return true;
    }
    __device__ __forceinline__ void a_ready(const Unit&) const {}
    __device__ __forceinline__ void done(const Unit&) const {}
};
__device__ __forceinline__ unsigned cvt_pk_bf16(float lo, float hi) { unsigned r; asm volatile("v_cvt_pk_bf16_f32 %0, %1, %2" : "=v"(r) : "v"(lo), "v"(hi)); return r; }
template <class Epi, class Sched, bool ALIGN_EPI = false, bool SP2 = false>
__device__ __forceinline__ void gemm_phase(PG8_LAS unsigned char* lds, const Gemm g, const Sched& S, const Epi& E, const int tid) {
    const int wid = __builtin_amdgcn_readfirstlane(tid >> 6), lane = tid & 63, wr = wid >> 2, wc = wid & 3, fr = lane & 15, fq = lane >> 4;
    const int K = g.K, nt = K / BK, lda = g.lda ? g.lda : g.K;
    unsigned voffA[2], voffB[2];
#pragma unroll
    for (int i = 0; i < 2; ++i) { int R, C; stage_rc(tid * 16 + i * 8192, R, C); const int Rb = Epi::PERM ? ((R & ~31) + perm32(R & 31)) : R;
        voffA[i] = (unsigned)(R * lda + C) * 2u; voffB[i] = (unsigned)(Rb * K + C) * 2u; }
    const size_t kstep = (size_t)(BK * 2);
    const size_t hstep = (size_t)HALF * K * 2;
    const size_t tstep = 2 * hstep;
    const size_t hstepA = (size_t)HALF * lda * 2, tstepA = 2 * hstepA;
    const unsigned ldsw = (unsigned)wid * 1024u;
    const int aoff = lds_byte(wr * 64 + fr, fq * 8), boff = lds_byte(wc * 32 + fr, fq * 8);
#define PG8_SA(b, h) (((b) * 2 + (h)) * HTB)
#define PG8_SB(b, h) ((4 + (b) * 2 + (h)) * HTB)
#define PG8_STAGE(bufoff, gbase, voff) do { _Pragma("unroll") for (int _i = 0; _i < 2; ++_i) \
        __builtin_amdgcn_global_load_lds((const unsigned*)((const char*)(gbase) + (voff)[_i]), (PG8_LAS unsigned*)(lds + (bufoff) + ldsw + _i * 8192), 16, 0, 0); } while (0)
#define PG8_LDA(dst, b, h) do { _Pragma("unroll") for (int m = 0; m < 4; ++m) _Pragma("unroll") for (int k = 0; k < 2; ++k) dst[m][k] = *(const PG8_LAS bf16x8*)(lds + PG8_SA(b, h) + aoff + m * 2048 + k * 1024); } while (0)
#define PG8_LDB(dst, b, h) do { _Pragma("unroll") for (int n = 0; n < 2; ++n) _Pragma("unroll") for (int k = 0; k < 2; ++k) dst[n][k] = *(const PG8_LAS bf16x8*)(lds + PG8_SB(b, h) + boff + n * 2048 + k * 1024); } while (0)
#define PG8_MMA(ai, bj, At, Bt) do { __builtin_amdgcn_s_setprio(1); _Pragma("unroll") for (int m = 0; m < 4; ++m) _Pragma("unroll") for (int n = 0; n < 2; ++n) _Pragma("unroll") for (int k = 0; k < 2; ++k) \
        acc[ai][bj][m][n] = __builtin_amdgcn_mfma_f32_16x16x32_bf16(Bt[n][k], At[m][k], acc[ai][bj][m][n], 0, 0, 0); __builtin_amdgcn_s_setprio(0); } while (0)
#define PG8_WAIT_V(n) asm volatile("s_waitcnt vmcnt(" #n ")" ::: "memory")
#define PG8_WAIT_L(n) asm volatile("s_waitcnt lgkmcnt(" #n ")" ::: "memory")
#define PG8_BAR __builtin_amdgcn_s_barrier()
#define PG8_SCHED __builtin_amdgcn_sched_barrier(0)
    Unit cur, nxt; int ui = 0;
    if (!S.next(0, cur)) return;
    f32x4 acc[2][2][4][2];
#pragma unroll
    for (int a = 0; a < 2; ++a)
#pragma unroll
        for (int b = 0; b < 2; ++b)
#pragma unroll
            for (int m = 0; m < 4; ++m)
#pragma unroll
                for (int n = 0; n < 2; ++n) acc[a][b][m][n] = (f32x4){0.f, 0.f, 0.f, 0.f};
    bf16x8 At[4][2], B0[2][2], B1[2][2];
    float epre[Epi::NPRE];
    const char* cA = (const char*)g.A + (size_t)cur.pm * tstepA; const char* cB = (const char*)g.Bt + (size_t)cur.pn * tstep;
    S.a_ready(cur);
    if constexpr (SP2) {
        PG8_STAGE(PG8_SB(0, 0), cB, voffB); PG8_STAGE(PG8_SB(0, 1), cB + hstep, voffB); PG8_STAGE(PG8_SA(0, 0), cA, voffA); PG8_STAGE(PG8_SA(0, 1), cA + hstepA, voffA);
        if (wr == 1) PG8_BAR;
        PG8_WAIT_V(2); PG8_BAR;
        PG8_STAGE(PG8_SB(1, 0), cB + kstep, voffB); PG8_STAGE(PG8_SA(1, 0), cA + kstep, voffA); PG8_STAGE(PG8_SB(1, 1), cB + hstep + kstep, voffB);
        PG8_WAIT_V(6); PG8_BAR;
    } else {
        PG8_STAGE(PG8_SB(0, 0), cB, voffB); PG8_STAGE(PG8_SA(0, 0), cA, voffA); PG8_STAGE(PG8_SB(0, 1), cB + hstep, voffB); PG8_STAGE(PG8_SA(0, 1), cA + hstepA, voffA);
        if (wr == 1) PG8_BAR;
        PG8_WAIT_V(4); PG8_BAR;
        PG8_STAGE(PG8_SB(1, 0), cB + kstep, voffB); PG8_STAGE(PG8_SA(1, 0), cA + kstep, voffA); PG8_STAGE(PG8_SB(1, 1), cB + hstep + kstep, voffB);
        PG8_WAIT_V(6); PG8_BAR;
    }
    for (;;) {
        const bool has_next = S.next(ui + 1, nxt);
        const char* nA = has_next ? (const char*)g.A + (size_t)nxt.pm * tstepA : cA; const char* nB = has_next ? (const char*)g.Bt + (size_t)nxt.pn * tstep : cB;
        for (int t = 0; t < nt; t += 2) {
            const bool last = (t == nt - 2);
            const char* a1 = cA + (size_t)(t + 1) * kstep;
            const char* a2 = last ? nA : cA + (size_t)(t + 2) * kstep; const char* b2 = last ? nB : cB + (size_t)(t + 2) * kstep;
            const char* a3 = a2 + kstep; const char* b3 = b2 + kstep;
            if (last && has_next) S.a_ready(nxt);
            if (last) E.pre(epre, cur, wr, wc, fr, fq);
            if constexpr (SP2) {
            PG8_LDB(B0, 0, 0); PG8_LDB(B1, 0, 1); PG8_SCHED; PG8_LDA(At, 0, 0); PG8_STAGE(PG8_SA(1, 1), a1 + hstepA, voffA);
            PG8_WAIT_V(8); PG8_WAIT_L(0); PG8_BAR; PG8_MMA(0, 0, At, B0); PG8_MMA(0, 1, At, B1); PG8_BAR; PG8_SCHED;
            PG8_LDA(At, 0, 1); PG8_STAGE(PG8_SB(0, 0), b2, voffB); PG8_STAGE(PG8_SB(0, 1), b2 + hstep, voffB); PG8_STAGE(PG8_SA(0, 0), a2, voffA);
            PG8_WAIT_V(8); PG8_WAIT_L(0); PG8_BAR; PG8_MMA(1, 0, At, B0); PG8_MMA(1, 1, At, B1); PG8_BAR; PG8_SCHED;
            PG8_LDB(B0, 1, 0); PG8_LDB(B1, 1, 1); PG8_SCHED; PG8_LDA(At, 1, 0); PG8_STAGE(PG8_SA(0, 1), a2 + hstepA, voffA);
            PG8_WAIT_V(8); PG8_WAIT_L(0); PG8_BAR; PG8_MMA(0, 0, At, B0); PG8_MMA(0, 1, At, B1); PG8_BAR; PG8_SCHED;
            PG8_LDA(At, 1, 1); PG8_STAGE(PG8_SB(1, 0), b3, voffB); PG8_STAGE(PG8_SB(1, 1), b3 + hstep, voffB); PG8_STAGE(PG8_SA(1, 0), a3, voffA);
            PG8_WAIT_V(8); PG8_WAIT_L(0); PG8_BAR; PG8_MMA(1, 0, At, B0); PG8_MMA(1, 1, At, B1); PG8_BAR; PG8_SCHED;
            } else {
            PG8_LDB(B0, 0, 0); PG8_SCHED; PG8_LDA(At, 0, 0); PG8_STAGE(PG8_SA(1, 1), a1 + hstepA, voffA);
            PG8_WAIT_L(8); PG8_BAR; PG8_WAIT_L(0); PG8_MMA(0, 0, At, B0); PG8_BAR; PG8_SCHED;
            PG8_LDB(B1, 0, 1); PG8_STAGE(PG8_SB(0, 0), b2, voffB);
            PG8_BAR; PG8_WAIT_L(0); PG8_MMA(0, 1, At, B1); PG8_BAR;
            PG8_LDA(At, 0, 1); PG8_STAGE(PG8_SA(0, 0), a2, voffA);
            PG8_BAR; PG8_WAIT_L(0); PG8_MMA(1, 0, At, B0); PG8_BAR; PG8_SCHED;
            PG8_STAGE(PG8_SB(0, 1), b2 + hstep, voffB);
            PG8_WAIT_V(6); PG8_BAR; PG8_MMA(1, 1, At, B1); PG8_BAR;
            PG8_LDB(B0, 1, 0); PG8_SCHED; PG8_LDA(At, 1, 0); PG8_STAGE(PG8_SA(0, 1), a2 + hstepA, voffA);
            PG8_WAIT_L(8); PG8_BAR; PG8_WAIT_L(0); PG8_MMA(0, 0, At, B0); PG8_BAR; PG8_SCHED;
            PG8_LDB(B1, 1, 1); PG8_STAGE(PG8_SB(1, 0), b3, voffB);
            PG8_BAR; PG8_WAIT_L(0); PG8_MMA(0, 1, At, B1); PG8_BAR;
            PG8_LDA(At, 1, 1); PG8_STAGE(PG8_SA(1, 0), a3, voffA);
            PG8_BAR; PG8_WAIT_L(0); PG8_MMA(1, 0, At, B0); PG8_BAR; PG8_SCHED;
            PG8_STAGE(PG8_SB(1, 1), b3 + hstep, voffB);
            PG8_WAIT_V(6); PG8_BAR; PG8_MMA(1, 1, At, B1); PG8_BAR;
            }
        }
        if constexpr (ALIGN_EPI) { if (wr == 0) PG8_BAR; }
        if constexpr (!Epi::AFTER_DRAIN) { E(acc, epre, cur, wr, wc, fr, fq); S.done(cur); }
        if (!has_next) break;
#pragma unroll
        for (int a = 0; a < 2; ++a)
#pragma unroll
            for (int b = 0; b < 2; ++b)
#pragma unroll
                for (int m = 0; m < 4; ++m)
#pragma unroll
                    for (int n = 0; n < 2; ++n) acc[a][b][m][n] = (f32x4){0.f, 0.f, 0.f, 0.f};
        cur = nxt; cA = nA; cB = nB; ++ui;
        if constexpr (ALIGN_EPI) { if (wr == 1) PG8_BAR; }
    }
    PG8_WAIT_V(0);
    if constexpr (!ALIGN_EPI) { if (wr == 0) PG8_BAR; }
    PG8_BAR;
    if constexpr (Epi::AFTER_DRAIN) { E.fused(acc, cur, wr, wc, fr, fq, lds, wid, lane); S.done(cur); }
#undef PG8_SA
#undef PG8_SB
#undef PG8_STAGE
#undef PG8_LDA
#undef PG8_LDB
#undef PG8_MMA
#undef PG8_WAIT_V
#undef PG8_WAIT_L
#undef PG8_BAR
#undef PG8_SCHED
}
}

namespace mk {
using pg8::bf16_t; using pg8::f32x4; using pg8::u32x4; using pg8::bf16x8; using pg8::Unit;
#define LAS __attribute__((address_space(3)))
typedef unsigned u32x2 __attribute__((ext_vector_type(2)));
typedef float f32x2 __attribute__((ext_vector_type(2)));
constexpr int M = 32768, D = 1024, FF = 2816, NIN = 1536, AW = 512, SEQ = 4096;
constexpr float EPS = 1e-6f;
constexpr int LDS_BYTES = 147456;
constexpr size_t MiB = 1u << 20;
constexpr size_t WS_W1A = 0 * MiB, WS_W1D = 11 * MiB, WS_W2A = 17 * MiB, WS_W2D = 28 * MiB, WS_WIN = 34 * MiB, WS_WOUT = 37 * MiB, WS_WM = 39 * MiB, WS_SS = 40 * MiB,
                 WS_CTL = 41 * MiB, CTL_BYTES = 65536,  WS_XB = 42 * MiB, WS_ACT = 106 * MiB,
                 WS_U = WS_ACT, WS_V = WS_ACT + 1024, WS_Z = WS_ACT + 2048, WS_Y = WS_ACT + 3072, WS_END = 282 * MiB;

__device__ __forceinline__ float silu_f(float g) { return g * __builtin_amdgcn_rcpf(1.0f + __builtin_amdgcn_exp2f(-1.4426950409f * g)); }
__device__ __forceinline__ float gelu_f(float v) { const float w = v + 0.044715f * v * v * v; return v * __builtin_amdgcn_rcpf(1.0f + __builtin_amdgcn_exp2f(-2.3022081981f * w)); }
__device__ __forceinline__ f32x2 gelu2(const f32x2 a2, const float rr) {
    const f32x2 v2 = a2 * rr, w2 = v2 * v2, p2 = w2 * (-2.3022081981f * 0.044715f) + (-2.3022081981f), g2 = v2 * p2;
    f32x2 e2; e2.x = __builtin_amdgcn_exp2f(g2.x); e2.y = __builtin_amdgcn_exp2f(g2.y);
    const f32x2 d2 = e2 + 1.0f; f32x2 q2; q2.x = __builtin_amdgcn_rcpf(d2.x); q2.y = __builtin_amdgcn_rcpf(d2.y);
    return v2 * q2;
}
__device__ __forceinline__ float bf_lo(unsigned w) { return __uint_as_float(w << 16); }
__device__ __forceinline__ float bf_hi(unsigned w) { return __uint_as_float(w & 0xffff0000u); }
__device__ __forceinline__ u32x4 pack8(const f32x4 a, const f32x4 b) { u32x4 w; w.x = pg8::cvt_pk_bf16(a[0], a[1]); w.y = pg8::cvt_pk_bf16(a[2], a[3]); w.z = pg8::cvt_pk_bf16(b[0], b[1]); w.w = pg8::cvt_pk_bf16(b[2], b[3]); return w; }
__device__ __forceinline__ float row_rstd(const float* ss, int row) { return __builtin_amdgcn_rsqf(ss[row] * (1.0f / 1024.0f) + EPS); }
constexpr size_t SS_STRIDE = 32768;
constexpr int CNT_WORD0 = 4096;

__device__ __forceinline__ void epi_pre_wait(float (&e)[8]) { asm volatile("s_waitcnt vmcnt(8)" : "+v"(e[0]), "+v"(e[1]), "+v"(e[2]), "+v"(e[3]), "+v"(e[4]), "+v"(e[5]), "+v"(e[6]), "+v"(e[7]) :: "memory"); }
struct EpiSwiglu {
    static constexpr bool PERM = true, AFTER_DRAIN = false;
    bf16_t* O; const float* ss;
    static constexpr int NPRE = 8;
    __device__ __forceinline__ void pre(float (&e)[8], const Unit& u, int wr, int wc, int fr, int fq) const {
        const float* p0 = ss + (u.pm * 256 + wr * 64 + fr);
#pragma unroll
        for (int i = 0; i < 8; ++i) asm volatile("global_load_dword %0, %1, off offset:%2" : "=v"(e[i]) : "v"(p0), "i"(((i >> 2) * 128 + (i & 3) * 16) * 4) : "memory");
    }
    __device__ __forceinline__ void operator()(const f32x4 (&acc)[2][2][4][2], float (&e)[8], const Unit& u, int wr, int wc, int fr, int fq) const {
        const int row0 = u.pm * 256 + wr * 64 + fr, col0 = u.pn * 128 + wc * 32 + 8 * fq;
        epi_pre_wait(e);
        float r[2][4];
#pragma unroll
        for (int ai = 0; ai < 2; ++ai)
#pragma unroll
            for (int m = 0; m < 4; ++m) r[ai][m] = __builtin_amdgcn_rsqf(e[ai * 4 + m] * (1.0f / 1024.0f) + EPS);
#pragma unroll
        for (int ai = 0; ai < 2; ++ai)
#pragma unroll
            for (int m = 0; m < 4; ++m) {
                const float rr = r[ai][m], c1 = -1.4426950409f * rr, r2 = rr * rr;
                f32x4 o[2];
#pragma unroll
                for (int n = 0; n < 2; ++n)
#pragma unroll
                    for (int h = 0; h < 2; ++h) {
                        const f32x2 g2 = (f32x2){acc[ai][0][m][n][2 * h], acc[ai][0][m][n][2 * h + 1]}, u2 = (f32x2){acc[ai][1][m][n][2 * h], acc[ai][1][m][n][2 * h + 1]};
                        const f32x2 a2 = g2 * c1; f32x2 e2; e2.x = __builtin_amdgcn_exp2f(a2.x); e2.y = __builtin_amdgcn_exp2f(a2.y);
                        const f32x2 d2 = e2 + 1.0f; f32x2 q2; q2.x = __builtin_amdgcn_rcpf(d2.x); q2.y = __builtin_amdgcn_rcpf(d2.y);
                        const f32x2 t2 = ((g2 * u2) * r2) * q2;
                        o[n][2 * h] = t2.x; o[n][2 * h + 1] = t2.y; }
                *(u32x4*)(O + (size_t)(row0 + ai * 128 + m * 16) * FF + col0) = pack8(o[0], o[1]);
            }
    }
};
template <bool BASE_F32> struct EpiRes {
    static constexpr bool PERM = true, AFTER_DRAIN = false;
    const float* basef; bf16_t* xb; float* ss; float alpha;
    static constexpr int NPRE = 1;
    __device__ __forceinline__ void pre(float (&)[1], const Unit&, int, int, int, int) const {}
    __device__ __forceinline__ void operator()(const f32x4 (&acc)[2][2][4][2], float (&)[1], const Unit& u, int wr, int wc, int fr, int fq) const {
        const unsigned off0 = (unsigned)(u.pm * 256 + wr * 64 + fr) * (unsigned)D + (unsigned)(u.pn * 256 + wc * 32 + 8 * fq);
        const unsigned sso = (unsigned)(u.pm * 256 + wr * 64 + fr);
        u32x4 bw[2][4][2];
        if constexpr (!BASE_F32) {
#pragma unroll
            for (int ai = 0; ai < 2; ++ai)
#pragma unroll
                for (int m = 0; m < 4; ++m)
#pragma unroll
                    for (int bj = 0; bj < 2; ++bj) bw[ai][m][bj] = *(const u32x4*)(xb + off0 + (unsigned)((ai * 128 + m * 16) * D + bj * 128));
        }
#pragma unroll
        for (int ai = 0; ai < 2; ++ai)
#pragma unroll
            for (int m = 0; m < 4; ++m) {
                float sq = 0.f;
#pragma unroll
                for (int bj = 0; bj < 2; ++bj) {
                    const unsigned off = off0 + (unsigned)((ai * 128 + m * 16) * D + bj * 128);
                    f32x4 b0, b1;
                    if constexpr (BASE_F32) { b0 = *(const f32x4*)(basef + off); b1 = *(const f32x4*)(basef + off + 4); }
                    else { const u32x4 w = bw[ai][m][bj]; b0 = (f32x4){bf_lo(w.x), bf_hi(w.x), bf_lo(w.y), bf_hi(w.y)}; b1 = (f32x4){bf_lo(w.z), bf_hi(w.z), bf_lo(w.w), bf_hi(w.w)}; }
                    const f32x4 v0 = b0 + acc[ai][bj][m][0] * alpha, v1 = b1 + acc[ai][bj][m][1] * alpha;
                    *(u32x4*)(xb + off) = pack8(v0, v1);
                    sq += (v0[0] * v0[0] + v0[1] * v0[1]) + (v0[2] * v0[2] + v0[3] * v0[3]) + (v1[0] * v1[0] + v1[1] * v1[1]) + (v1[2] * v1[2] + v1[3] * v1[3]);
                }
                sq += __shfl_xor(sq, 16); sq += __shfl_xor(sq, 32);
                if (fq == 0) __hip_atomic_fetch_add(ss + sso + (unsigned)(ai * 128 + m * 16), sq, __ATOMIC_RELAXED, __HIP_MEMORY_SCOPE_AGENT);
                if (BASE_F32 && (m & 1)) asm volatile("" ::: "memory");
            }
    }
};
struct EpiResFinal {
    static constexpr bool PERM = true, AFTER_DRAIN = false;
    const bf16_t* xb; float* out; float* ss; unsigned* cnt; const float* gfin; float alpha;
    static constexpr int NPRE = 1;
    __device__ __forceinline__ void pre(float (&)[1], const Unit&, int, int, int, int) const {}
    __device__ __forceinline__ void operator()(f32x4 (&acc)[2][2][4][2], float (&)[1], const Unit& u, int wr, int wc, int fr, int fq) const {
        const unsigned off0 = (unsigned)(u.pm * 256 + wr * 64 + fr) * (unsigned)D + (unsigned)(u.pn * 256 + wc * 32 + 8 * fq);
        const unsigned sso = (unsigned)(u.pm * 256 + wr * 64 + fr);
        u32x4 bw[2][4][2];
#pragma unroll
        for (int ai = 0; ai < 2; ++ai)
#pragma unroll
            for (int m = 0; m < 4; ++m)
#pragma unroll
                for (int bj = 0; bj < 2; ++bj) bw[ai][m][bj] = *(const u32x4*)(xb + off0 + (unsigned)((ai * 128 + m * 16) * D + bj * 128));
#pragma unroll
        for (int ai = 0; ai < 2; ++ai)
#pragma unroll
            for (int m = 0; m < 4; ++m) {
                float sq = 0.f;
#pragma unroll
                for (int bj = 0; bj < 2; ++bj) {
                    const u32x4 w = bw[ai][m][bj];
                    const f32x4 b0 = (f32x4){bf_lo(w.x), bf_hi(w.x), bf_lo(w.y), bf_hi(w.y)}, b1 = (f32x4){bf_lo(w.z), bf_hi(w.z), bf_lo(w.w), bf_hi(w.w)};
                    const f32x4 v0 = b0 + acc[ai][bj][m][0] * alpha, v1 = b1 + acc[ai][bj][m][1] * alpha;
                    acc[ai][bj][m][0] = v0; acc[ai][bj][m][1] = v1;
                    sq += (v0[0] * v0[0] + v0[1] * v0[1]) + (v0[2] * v0[2] + v0[3] * v0[3]) + (v1[0] * v1[0] + v1[1] * v1[1]) + (v1[2] * v1[2] + v1[3] * v1[3]);
                }
                sq += __shfl_xor(sq, 16); sq += __shfl_xor(sq, 32);
                if (fq == 0) __hip_atomic_fetch_add(ss + sso + (unsigned)(ai * 128 + m * 16), sq, __ATOMIC_RELAXED, __HIP_MEMORY_SCOPE_AGENT);
            }
        asm volatile("s_waitcnt vmcnt(0)" ::: "memory");
        unsigned* c = cnt + 64 * u.pm;
        if (fr == 0 && fq == 0) __hip_atomic_fetch_add(c, 1u, __ATOMIC_RELAXED, __HIP_MEMORY_SCOPE_AGENT);
        unsigned spins = 0;
        while ((unsigned)__builtin_amdgcn_readfirstlane(__hip_atomic_load(c, __ATOMIC_RELAXED, __HIP_MEMORY_SCOPE_AGENT)) < 32u) { __builtin_amdgcn_s_sleep(2); if (++spins > (1u << 20)) break; }
        f32x4 gv[2][2];
#pragma unroll
        for (int bj = 0; bj < 2; ++bj)
#pragma unroll
            for (int n = 0; n < 2; ++n) gv[bj][n] = *(const f32x4*)(gfin + u.pn * 256 + bj * 128 + wc * 32 + 8 * fq + 4 * n);
        float tot[2][4];
#pragma unroll
        for (int ai = 0; ai < 2; ++ai)
#pragma unroll
            for (int m = 0; m < 4; ++m) tot[ai][m] = __hip_atomic_load(ss + sso + (unsigned)(ai * 128 + m * 16), __ATOMIC_RELAXED, __HIP_MEMORY_SCOPE_AGENT);
#pragma unroll
        for (int ai = 0; ai < 2; ++ai)
#pragma unroll
            for (int m = 0; m < 4; ++m) { const float r = __builtin_amdgcn_rsqf(tot[ai][m] * (1.0f / 1024.0f) + EPS);
#pragma unroll
                for (int bj = 0; bj < 2; ++bj) { const unsigned off = off0 + (unsigned)((ai * 128 + m * 16) * D + bj * 128);
                    __builtin_nontemporal_store(acc[ai][bj][m][0] * r * gv[bj][0], (f32x4*)(out + off)); __builtin_nontemporal_store(acc[ai][bj][m][1] * r * gv[bj][1], (f32x4*)(out + off + 4)); } }
    }
};
struct EpiWin {
    static constexpr bool PERM = true, AFTER_DRAIN = false;
    bf16_t *U, *V, *Z; const float* ss;
    static constexpr int NPRE = 8;
    __device__ __forceinline__ void pre(float (&e)[8], const Unit& u, int wr, int wc, int fr, int fq) const {
        const float* p0 = ss + (u.pm * 256 + wr * 64 + fr);
#pragma unroll
        for (int i = 0; i < 8; ++i) asm volatile("global_load_dword %0, %1, off offset:%2" : "=v"(e[i]) : "v"(p0), "i"(((i >> 2) * 128 + (i & 3) * 16) * 4) : "memory");
    }
    __device__ __forceinline__ void operator()(const f32x4 (&acc)[2][2][4][2], float (&e)[8], const Unit& u, int wr, int wc, int fr, int fq) const {
        const int row0 = u.pm * 256 + wr * 64 + fr;
        epi_pre_wait(e);
        float r[2][4];
#pragma unroll
        for (int ai = 0; ai < 2; ++ai)
#pragma unroll
            for (int m = 0; m < 4; ++m) r[ai][m] = __builtin_amdgcn_rsqf(e[ai * 4 + m] * (1.0f / 1024.0f) + EPS);
        if (u.pn < 2) {
            const int col0 = u.pn * 256 + wc * 32 + 8 * fq;
#pragma unroll
            for (int ai = 0; ai < 2; ++ai)
#pragma unroll
                for (int m = 0; m < 4; ++m) { const float rr = r[ai][m]; bf16_t* rowp = U + (size_t)(row0 + ai * 128 + m * 16) * FF + col0;
#pragma unroll
                    for (int bj = 0; bj < 2; ++bj) { f32x4 o0, o1;
#pragma unroll
                        for (int h = 0; h < 2; ++h) { const f32x2 x0 = gelu2((f32x2){acc[ai][bj][m][0][2 * h], acc[ai][bj][m][0][2 * h + 1]}, rr), x1 = gelu2((f32x2){acc[ai][bj][m][1][2 * h], acc[ai][bj][m][1][2 * h + 1]}, rr);
                            o0[2 * h] = x0.x; o0[2 * h + 1] = x0.y; o1[2 * h] = x1.x; o1[2 * h + 1] = x1.y; }
                        *(u32x4*)(rowp + bj * 128) = pack8(o0, o1); } }
        } else if (u.pn < 4) {
            const int colb = 64 * ((u.pn - 2) * 4 + wc) + 8 * fq;
#pragma unroll
            for (int ai = 0; ai < 2; ++ai)
#pragma unroll
                for (int m = 0; m < 4; ++m) { const float rr = r[ai][m]; f32x4 g[2][2]; float sq = 0.f;
#pragma unroll
                    for (int bj = 0; bj < 2; ++bj)
#pragma unroll
                        for (int n = 0; n < 2; ++n)
#pragma unroll
                            for (int h = 0; h < 2; ++h) { const f32x2 t = gelu2((f32x2){acc[ai][bj][m][n][2 * h], acc[ai][bj][m][n][2 * h + 1]}, rr); g[bj][n][2 * h] = t.x; g[bj][n][2 * h + 1] = t.y; sq += t.x * t.x + t.y * t.y; }
                    sq += __shfl_xor(sq, 16); sq += __shfl_xor(sq, 32);
                    const float hr = __builtin_amdgcn_rsqf(sq * (1.0f / 64.0f) + EPS);
                    bf16_t* rowp = V + (size_t)(row0 + ai * 128 + m * 16) * FF + colb;
#pragma unroll
                    for (int bj = 0; bj < 2; ++bj) *(u32x4*)(rowp + 32 * bj) = pack8(g[bj][0] * hr, g[bj][1] * hr); }
        } else {
            const int col0 = (u.pn - 4) * 256 + wc * 32 + 8 * fq;
#pragma unroll
            for (int ai = 0; ai < 2; ++ai)
#pragma unroll
                for (int m = 0; m < 4; ++m) { const float rr = r[ai][m]; bf16_t* rowp = Z + (size_t)(row0 + ai * 128 + m * 16) * FF + col0;
#pragma unroll
                    for (int bj = 0; bj < 2; ++bj) *(u32x4*)(rowp + bj * 128) = pack8(acc[ai][bj][m][0] * rr, acc[ai][bj][m][1] * rr); }
        }
    }
};

__device__ __forceinline__ float wave_sum(float v) {
#pragma unroll
    for (int o = 1; o < 64; o <<= 1) v += __shfl_xor(v, o);
    return v;
}
__device__ __forceinline__ void p0_transpose_item(const float* src, int ld, int Kd, int k0, int scol0, bf16_t* dst, int drow0, const float* gk, LAS float* scr, int lane) {
    float tv[32];
#pragma unroll
    for (int i = 0; i < 32; ++i) { const int kk = 2 * i + (lane >> 5); tv[i] = src[(size_t)(k0 + kk) * ld + scol0 + (lane & 31)]; }
    if (gk) {
#pragma unroll
        for (int i = 0; i < 32; ++i) tv[i] *= gk[k0 + 2 * i + (lane >> 5)];
    }
#pragma unroll
    for (int i = 0; i < 32; ++i) scr[(2 * i + (lane >> 5)) * 33 + (lane & 31)] = tv[i];
    asm volatile("s_waitcnt lgkmcnt(0)" ::: "memory");
    const int c = lane & 7;
#pragma unroll
    for (int j = 0; j < 4; ++j) { const int n = (lane >> 3) + 8 * j; const LAS float* s = scr + (8 * c) * 33 + n;
        u32x4 o; o.x = pg8::cvt_pk_bf16(s[0 * 33], s[1 * 33]); o.y = pg8::cvt_pk_bf16(s[2 * 33], s[3 * 33]); o.z = pg8::cvt_pk_bf16(s[4 * 33], s[5 * 33]); o.w = pg8::cvt_pk_bf16(s[6 * 33], s[7 * 33]);
        *(u32x4*)(dst + (size_t)(drow0 + n) * Kd + k0 + 8 * c) = o; }
    asm volatile("s_waitcnt lgkmcnt(0)" ::: "memory");
}

struct Params { const float* in[18]; float* out; unsigned char* ws; int ph_lo, ph_hi; };

__device__ __forceinline__ void p0_prep(const Params& p, LAS unsigned char* lds, int tid, int wave, int lane) {
    unsigned char* ws = p.ws;
    LAS float* scr = (LAS float*)(lds + wave * 16384);
    const int gw = blockIdx.x * 4 + (wave & 3), NGW = gridDim.x * 4;
    constexpr int I_A = 16 * 176, I_D = 44 * 32, I_IN = 16 * 32, I_OUT = 16 * 32, I_ZP = 1024;
    constexpr int NITEMS = I_ZP + 2 * (I_A + I_D) + I_IN + I_OUT;
    bf16_t* XB = (bf16_t*)(ws + WS_XB); float* ss = (float*)(ws + WS_SS);
    if (wave >= 4) {
    for (int it = gw; it < NITEMS; it += NGW) {
        int r = it;
        if (r < I_ZP) {
            const int g = r >> 8, kb = (r >> 4) & 15, jb = r & 15, k = 64 * kb + lane;
            const float* __restrict__ wrow = p.in[6] + (size_t)k * NIN + 1024 + 128 * g;
            const float* __restrict__ wp = p.in[10] + (size_t)g * 16384 + 8 * jb;
            float a[8];
#pragma unroll
            for (int j = 0; j < 8; ++j) a[j] = 0.f;
#pragma unroll
            for (int b = 0; b < 4; ++b) { f32x4 w4[8];
#pragma unroll
                for (int q = 0; q < 8; ++q) w4[q] = *(const f32x4*)(wrow + 32 * b + 4 * q);
#pragma unroll
                for (int q = 0; q < 8; ++q)
#pragma unroll
                    for (int e = 0; e < 4; ++e) { const float* wpi = wp + (size_t)(32 * b + 4 * q + e) * 128;
#pragma unroll
                        for (int j = 0; j < 8; ++j) a[j] += w4[q][e] * wpi[j]; } }
            const float gm = p.in[5][k];
            bf16_t* dst = (bf16_t*)(ws + WS_WIN) + (size_t)(1024 + 128 * g + 8 * jb) * D + k;
#pragma unroll
            for (int j = 0; j < 8; ++j) dst[(size_t)j * D] = (bf16_t)(pg8::cvt_pk_bf16(a[j] * gm, 0.f) & 0xffffu);
            continue;
        }
        r -= I_ZP;
        if (r < 2 * (I_A + I_D)) {
            const int l = r >= (I_A + I_D); if (l) r -= (I_A + I_D);
            const float* nrm = l ? p.in[13] : p.in[1]; const float* wg = l ? p.in[14] : p.in[2]; const float* wu = l ? p.in[15] : p.in[3]; const float* wd = l ? p.in[16] : p.in[4];
            bf16_t* dA = (bf16_t*)(ws + (l ? WS_W2A : WS_W1A)); bf16_t* dD = (bf16_t*)(ws + (l ? WS_W2D : WS_W1D));
            if (r < I_A) { const int kb = r / 176, rb = r % 176, pn = rb >> 3, bj = (rb >> 2) & 1, c0 = (rb & 3) * 32;
                p0_transpose_item(bj ? wu : wg, FF, D, 64 * kb, 128 * pn + c0, dA, 32 * rb, nrm, scr, lane); }
            else { r -= I_A; const int kb = r / 32, rb = r % 32; p0_transpose_item(wd, D, FF, 64 * kb, 32 * rb, dD, 32 * rb, nullptr, scr, lane); }
            continue;
        }
        r -= 2 * (I_A + I_D);
        if (r < I_IN) { const int kb = r / 32, rb = r % 32; int sc;
            if (rb < 16) sc = 32 * rb; else { const int q = rb - 16, pn = q >> 3, bj = (q >> 2) & 1, wc = q & 3; sc = 512 + 64 * (4 * pn + wc) + 32 * bj; }
            p0_transpose_item(p.in[6], NIN, D, 64 * kb, sc, (bf16_t*)(ws + WS_WIN), 32 * rb, p.in[5], scr, lane); continue; }
        r -= I_IN;
        { const int kb = r / 32, rb = r % 32; p0_transpose_item(p.in[12], D, D, 64 * kb, 32 * rb, (bf16_t*)(ws + WS_WOUT), 32 * rb, nullptr, scr, lane); }
    }
    for (int e8 = blockIdx.x * 256 + (tid - 256); e8 < 8 * 128 * 128 / 8; e8 += gridDim.x * 256) {
        const int e = e8 * 8, t = (e >> 7) & 127, s0 = e & 127;
        const f32x4 a = *(const f32x4*)(p.in[8] + e), b = *(const f32x4*)(p.in[8] + e + 4); f32x4 ma, mb;
#pragma unroll
        for (int j = 0; j < 4; ++j) { ma[j] = (s0 + j <= t) ? a[j] : 0.f; mb[j] = (s0 + 4 + j <= t) ? b[j] : 0.f; }
        *(u32x4*)((bf16_t*)(ws + WS_WM) + e) = pack8(ma, mb);
    }
    for (int i = blockIdx.x * 256 + (tid - 256); i < 3 * M / 4; i += gridDim.x * 256) ((f32x4*)(ss + SS_STRIDE))[i] = (f32x4){0.f, 0.f, 0.f, 0.f};
    return;
    }
    for (int m = gw; m < M; m += 4 * NGW) {
        f32x4 v[4][4];
#pragma unroll
        for (int q = 0; q < 4; ++q) { const int mq = (m + q * NGW < M) ? m + q * NGW : m; const f32x4* xr = (const f32x4*)(p.in[0] + (size_t)mq * D) + lane;
#pragma unroll
            for (int j = 0; j < 4; ++j) v[q][j] = __builtin_nontemporal_load(xr + 64 * j); }
#pragma unroll
        for (int q = 0; q < 4; ++q) { const int mq = m + q * NGW; if (mq < M) {
            float sq = 0.f;
#pragma unroll
            for (int j = 0; j < 4; ++j) sq += (v[q][j][0] * v[q][j][0] + v[q][j][1] * v[q][j][1]) + (v[q][j][2] * v[q][j][2] + v[q][j][3] * v[q][j][3]);
            sq = wave_sum(sq);
            u32x2* o = (u32x2*)(XB + (size_t)mq * D) + lane;
#pragma unroll
            for (int j = 0; j < 4; ++j) { u32x2 w; w.x = pg8::cvt_pk_bf16(v[q][j][0], v[q][j][1]); w.y = pg8::cvt_pk_bf16(v[q][j][2], v[q][j][3]); o[64 * j] = w; }
            if (lane == 0) ss[mq] = sq; } }
    }
}

__device__ __forceinline__ f32x4 unpack4(const u32x2 z) { return (f32x4){bf_lo(z.x), bf_hi(z.x), bf_lo(z.y), bf_hi(z.y)}; }
template <int WIN> __device__ __forceinline__ void pool_task(const bf16_t* __restrict__ zc, bf16_t* __restrict__ yc, const size_t Rt, const int pos0, const f32x4 sc) {
    constexpr int H = WIN - 1;
    u32x2 raw[H + 8];
#pragma unroll
    for (int i = 0; i < H + 8; ++i) { const bool ok = pos0 - H + i >= 0; raw[i] = *(const u32x2*)(zc + (ok ? Rt - H + i : Rt) * FF); if (!ok) raw[i] = (u32x2){0u, 0u}; }
    f32x4 s = (f32x4){0.f, 0.f, 0.f, 0.f};
#pragma unroll
    for (int i = 0; i < H; ++i) s += unpack4(raw[i]);
#pragma unroll
    for (int t = 0; t < 8; ++t) {
        const f32x4 zt = unpack4(raw[H + t]); s += zt;
        const int pos = pos0 + t, cnt = (pos + 1 < WIN) ? pos + 1 : WIN; const float inv = 1.0f / (float)cnt;
        const f32x4 o = (s * inv - zt) * sc;
        u32x2 w; w.x = pg8::cvt_pk_bf16(o[0], o[1]); w.y = pg8::cvt_pk_bf16(o[2], o[3]);
        *(u32x2*)(yc + (Rt + t) * FF) = w;
        s -= unpack4(raw[t]);
    }
}
__device__ __forceinline__ void p4_mixer(const Params& p, LAS unsigned char* lds, int tid, int wave, int lane, int vc) {
    unsigned char* ws = p.ws;
    const bf16_t* __restrict__ U = (const bf16_t*)(ws + WS_U); const bf16_t* __restrict__ V = (const bf16_t*)(ws + WS_V); const bf16_t* __restrict__ Z = (const bf16_t*)(ws + WS_Z); bf16_t* __restrict__ Y = (bf16_t*)(ws + WS_Y);
    const bf16_t* __restrict__ Wm = (const bf16_t*)(ws + WS_WM); const float* __restrict__ bs = p.in[9]; const float* __restrict__ pscale = p.in[11]; const float* __restrict__ vgain = p.in[7];
    constexpr int P = 136;
    LAS bf16_t* Vt = (LAS bf16_t*)lds;
    const int fr = lane & 15, fq = lane >> 4;
    for (int chunk = (gridDim.x == 256) ? 32 * (vc & 7) + (vc >> 3) : (int)blockIdx.x; chunk < M / 128; chunk += gridDim.x) {
        const size_t R0 = (size_t)chunk * 128;
        const int vs = tid & 127, cq0 = tid >> 7; u32x4 vreg[16];
        {
            const bf16_t* vrow = V + (R0 + vs) * FF + 8 * cq0;
#pragma unroll
            for (int it = 0; it < 16; ++it) vreg[it] = *(const u32x4*)(vrow + 32 * it);
        }
        {
            const int g = wave & 3, cq = 32 * g + (lane & 31), q4 = (wave >> 2) * 2 + (lane >> 5);
            const bf16_t* zc = Z + 4 * cq; bf16_t* yc = Y + 512 + 4 * cq; const f32x4 sc = *(const f32x4*)(pscale + 4 * cq);
            const int pb = (chunk & 31) * 128 + 32 * q4; const size_t Rb = R0 + 32 * q4;
#pragma unroll 1
            for (int k = 0; k < 4; ++k) {
                if (g == 0) pool_task<2>(zc, yc, Rb + 8 * k, pb + 8 * k, sc);
                else if (g == 1) pool_task<4>(zc, yc, Rb + 8 * k, pb + 8 * k, sc);
                else if (g == 2) pool_task<8>(zc, yc, Rb + 8 * k, pb + 8 * k, sc);
                else pool_task<16>(zc, yc, Rb + 8 * k, pb + 8 * k, sc);
            }
        }
        {
#pragma unroll
            for (int it = 0; it < 16; ++it) { LAS bf16_t* d = Vt + (8 * (cq0 + 4 * it)) * P + vs;
                d[0 * P] = (bf16_t)(vreg[it].x & 0xffffu); d[1 * P] = (bf16_t)(vreg[it].x >> 16); d[2 * P] = (bf16_t)(vreg[it].y & 0xffffu); d[3 * P] = (bf16_t)(vreg[it].y >> 16);
                d[4 * P] = (bf16_t)(vreg[it].z & 0xffffu); d[5 * P] = (bf16_t)(vreg[it].z >> 16); d[6 * P] = (bf16_t)(vreg[it].w & 0xffffu); d[7 * P] = (bf16_t)(vreg[it].w >> 16); }
        }
        __syncthreads();
#pragma unroll 1
        for (int ib = 0; ib < 8; ib += 4) {
            bf16x8 wf[4][4]; float bias[4]; u32x2 uu[4][4]; f32x4 gn[4][4];
#pragma unroll
            for (int j = 0; j < 4; ++j) { const int h = ib + j, ts = (wave + h) & 7, t = 16 * ts + fr; const size_t row = R0 + t;
                const bf16_t* wrow = Wm + (size_t)(h * 128 + t) * 128 + 8 * fq;
#pragma unroll
                for (int ks = 0; ks < 4; ++ks) wf[j][ks] = *(const bf16x8*)(wrow + 32 * ks);
                bias[j] = bs[h * 128 + t];
#pragma unroll
                for (int nb = 0; nb < 4; ++nb) { const int col = 64 * h + 16 * nb + 4 * fq; uu[j][nb] = *(const u32x2*)(U + row * FF + col); gn[j][nb] = *(const f32x4*)(vgain + col); } }
#pragma unroll
            for (int j = 0; j < 4; ++j) { const int h = ib + j, ts = (wave + h) & 7, t = 16 * ts + fr, nks = (ts >> 1) + 1; const size_t row = R0 + t;
                f32x4 acc[4];
#pragma unroll
                for (int nb = 0; nb < 4; ++nb) acc[nb] = (f32x4){0.f, 0.f, 0.f, 0.f};
#pragma unroll
                for (int ks = 0; ks < 4; ++ks) if (ks < nks) {
#pragma unroll
                    for (int nb = 0; nb < 4; ++nb) { const bf16x8 vf = *(const LAS bf16x8*)(Vt + (64 * h + 16 * nb + fr) * P + 32 * ks + 8 * fq);
                        acc[nb] = __builtin_amdgcn_mfma_f32_16x16x32_bf16(vf, wf[j][ks], acc[nb], 0, 0, 0); }
                }
#pragma unroll
                for (int nb = 0; nb < 4; ++nb) { const int col = 64 * h + 16 * nb + 4 * fq;
                    u32x2 w; w.x = pg8::cvt_pk_bf16(bf_lo(uu[j][nb].x) * (acc[nb][0] * gn[j][nb][0] + bias[j]), bf_hi(uu[j][nb].x) * (acc[nb][1] * gn[j][nb][1] + bias[j]));
                    w.y = pg8::cvt_pk_bf16(bf_lo(uu[j][nb].y) * (acc[nb][2] * gn[j][nb][2] + bias[j]), bf_hi(uu[j][nb].y) * (acc[nb][3] * gn[j][nb][3] + bias[j]));
                    *(u32x2*)(Y + row * FF + col) = w; } }
        }
        __syncthreads();
    }
}

#define XB_TMO      128
#define XB_XCNT(j)  (256  + 64 * (j))
#define XB_XSUB(j)  (1280 + 64 * (j))
#define XB_XGEN(j)  (2304 + 64 * (j))
#define XB_TOP      3328
#define XB_TOPGEN   3392
#define XCD_BAR_WORDS 3456
#define XB_SPIN_CAP (1u << 18)

__device__ __forceinline__ unsigned xb_ld(unsigned* p)              { return __hip_atomic_load(p, __ATOMIC_RELAXED, __HIP_MEMORY_SCOPE_AGENT); }
__device__ __forceinline__ unsigned xb_add(unsigned* p, unsigned v) { return __hip_atomic_fetch_add(p, v, __ATOMIC_RELAXED, __HIP_MEMORY_SCOPE_AGENT); }
__device__ __forceinline__ unsigned xb_xcc_id() { return (unsigned)__builtin_amdgcn_s_getreg((3 << 11) | 20) & 0xFu; }
#define XB_SPIN(cond, bar) do { unsigned _sp = 0; while (cond) { __builtin_amdgcn_s_sleep(1); \
    if ((++_sp & 255u) == 0u) { if (xb_ld(&(bar)[XB_TMO])) break; if (_sp > XB_SPIN_CAP) { atomicAdd(&(bar)[XB_TMO], 1u); break; } } } } while (0)

struct XcdBarrier {
    unsigned* bar; unsigned x;
    volatile __attribute__((address_space(3))) unsigned* st;
};

__device__ __forceinline__ XcdBarrier xcd_barrier_post(unsigned* bar, volatile __attribute__((address_space(3))) unsigned* st) {
    XcdBarrier b; b.bar = bar; b.x = xb_xcc_id(); b.st = st;
    if (threadIdx.x == 0) st[2] = xb_add(&bar[XB_XCNT(b.x)], 1u);
    return b;
}
__device__ __forceinline__ void xcd_barrier_complete(unsigned* bar, unsigned x, unsigned& nloc, unsigned& nx) {
    const unsigned G = gridDim.x * gridDim.y * gridDim.z;
    unsigned sum, cnt, mine, sp = 0u;
    for (;;) {
        sum = 0u; cnt = 0u; mine = 0u;
#pragma unroll
        for (unsigned j = 0; j < 16; ++j) { const unsigned c = xb_ld(&bar[XB_XCNT(j)]); sum += c; cnt += (c > 0u) ? 1u : 0u; mine = (j == x) ? c : mine; }
        if (sum == G) break;
        __builtin_amdgcn_s_sleep(1);
        if ((++sp & 255u) == 0u) { if (xb_ld(&bar[XB_TMO])) break; if (sp > XB_SPIN_CAP) { atomicAdd(&bar[XB_TMO], 1u); break; } }
    }
    nloc = mine > 0u ? mine : 1u; nx = cnt > 0u ? cnt : 1u;
}
__device__ __forceinline__ unsigned xcd_census_is_8x32(unsigned* bar) {
    unsigned ok = (gridDim.x == 256u) ? 1u : 0u;
#pragma unroll
    for (unsigned j = 0; j < 16; ++j) { const unsigned c = xb_ld(&bar[XB_XCNT(j)]); if (c != (j < 8u ? 32u : 0u)) ok = 0u; }
    return ok;
}

__device__ __forceinline__ void xcd_barrier(const XcdBarrier& b) {
    asm volatile("s_waitcnt vmcnt(0)" ::: "memory");
    __syncthreads();
    if (threadIdx.x == 0) {
        unsigned* bar = b.bar;
        __builtin_amdgcn_s_waitcnt(0);
        unsigned nloc = b.st[0], nx = b.st[1];
        if (nloc == 0u) { xcd_barrier_complete(bar, b.x, nloc, nx); b.st[0] = nloc; b.st[1] = nx; b.st[3] = xcd_census_is_8x32(bar); }
        const unsigned old = xb_add(&bar[XB_XSUB(b.x)], 1u);
        const unsigned gen = old / nloc;
        if (old + 1u == (gen + 1u) * nloc) {
            __builtin_amdgcn_fence(__ATOMIC_RELEASE, "agent");
            asm volatile("s_waitcnt vmcnt(0)" ::: "memory");
            const unsigned og = xb_add(&bar[XB_TOP], 1u);
            const unsigned tg = og / nx;
            if (og + 1u == (tg + 1u) * nx) xb_add(&bar[XB_TOPGEN], 1u);
            else XB_SPIN(xb_ld(&bar[XB_TOPGEN]) == tg, bar);
            __builtin_amdgcn_fence(__ATOMIC_ACQUIRE, "agent");
            xb_add(&bar[XB_XGEN(b.x)], 1u);
            asm volatile("s_waitcnt vmcnt(0)" ::: "memory");
        } else {
            XB_SPIN(xb_ld(&bar[XB_XGEN(b.x)]) == gen, bar);
            __builtin_amdgcn_fence(__ATOMIC_ACQUIRE, "agent");
            asm volatile("s_waitcnt vmcnt(0)" ::: "memory");
        }
    }
    __syncthreads();
}

#define XB_LSUB(j)  (12288 + 64 * (j))
#define XB_LGEN(j)  (13312 + 64 * (j))
__device__ __forceinline__ void xcd_local_barrier(const XcdBarrier& b) {
    asm volatile("s_waitcnt vmcnt(0)" ::: "memory");
    __syncthreads();
    if (threadIdx.x == 0) {
        unsigned* bar = b.bar;
        __builtin_amdgcn_s_waitcnt(0);
        const unsigned nloc = b.st[0];
        const unsigned old = xb_add(&bar[XB_LSUB(b.x)], 1u);
        const unsigned gen = old / nloc;
        if (old + 1u == (gen + 1u) * nloc) xb_add(&bar[XB_LGEN(b.x)], 1u);
        else XB_SPIN(xb_ld(&bar[XB_LGEN(b.x)]) == gen, bar);
        __builtin_amdgcn_fence(__ATOMIC_ACQUIRE, "agent");
        asm volatile("s_waitcnt vmcnt(0)" ::: "memory");
    }
    __syncthreads();
}

__device__ __forceinline__ void stagger_wait(int c, unsigned ticks) {
    const unsigned g = ((unsigned)c >> 3) & 3u;
    if (g) { const unsigned long long t0 = __builtin_amdgcn_s_memrealtime(); while (__builtin_amdgcn_s_memrealtime() - t0 < (unsigned long long)(g * ticks)) __builtin_amdgcn_s_sleep(8); }
}
template <int PH> __device__ __forceinline__ void run_phase(const Params& p, LAS unsigned char* lds, const int wave0, const int c) {
    int tid = wave0 * 64 + (int)__builtin_amdgcn_mbcnt_hi(~0u, __builtin_amdgcn_mbcnt_lo(~0u, 0u)); asm volatile("" : "+v"(tid));
    const int lane = tid & 63, wave = __builtin_amdgcn_readfirstlane(tid >> 6);
    unsigned char* ws = p.ws;
    bf16_t* XB = (bf16_t*)(ws + WS_XB); bf16_t* ACT = (bf16_t*)(ws + WS_ACT); float* ss = (float*)(ws + WS_SS);
    const int G = gridDim.x;
    if constexpr (PH == 0) p0_prep(p, lds, tid, wave, lane);
    if constexpr (PH == 1 || PH == 6) {
        pg8::Gemm g{XB, (const bf16_t*)(ws + (PH == 1 ? WS_W1A : WS_W2A)), M, 2 * FF, D}; pg8::StaticOrder S; S.init(M, 2 * FF, G, c);
        EpiSwiglu E{ACT, ss + (PH == 1 ? 0 : 2) * SS_STRIDE};
        pg8::gemm_phase<EpiSwiglu, pg8::StaticOrder, true, true>(lds, g, S, E, tid);
    }
    if constexpr (PH == 2) {
        pg8::Gemm g{ACT, (const bf16_t*)(ws + WS_W1D), M, D, FF}; pg8::StaticOrder S; S.init(M, D, G, c);
        EpiRes<false> E{nullptr, XB, ss + SS_STRIDE, 0.5f};
        pg8::gemm_phase<EpiRes<false>, pg8::StaticOrder, true, true>(lds, g, S, E, tid);
    }
    if constexpr (PH == 7) {
        pg8::Gemm g{ACT, (const bf16_t*)(ws + WS_W2D), M, D, FF}; pg8::StaticOrder S; S.init(M, D, G, c);
        EpiResFinal E{XB, p.out, ss + 3 * SS_STRIDE, (unsigned*)(ws + WS_CTL) + CNT_WORD0, p.in[17], 0.5f};
        pg8::gemm_phase<EpiResFinal, pg8::StaticOrder, true, true>(lds, g, S, E, tid);
    }
    if constexpr (PH == 3) {
        pg8::Gemm g{XB, (const bf16_t*)(ws + WS_WIN), M, NIN, D}; pg8::StaticOrder S; S.init(M, NIN, G, c);
        EpiWin E{(bf16_t*)(ws + WS_U), (bf16_t*)(ws + WS_V), (bf16_t*)(ws + WS_Z), ss + SS_STRIDE};
        pg8::gemm_phase<EpiWin, pg8::StaticOrder, true, true>(lds, g, S, E, tid);
    }
    if constexpr (PH == 4) p4_mixer(p, lds, tid, wave, lane, c);
    if constexpr (PH == 5) {
        pg8::Gemm g{(const bf16_t*)(ws + WS_Y), (const bf16_t*)(ws + WS_WOUT), M, D, D, FF}; pg8::StaticOrder S; S.init(M, D, G, c);
        EpiRes<false> E{nullptr, XB, ss + 2 * SS_STRIDE, 1.0f};
        pg8::gemm_phase<EpiRes<false>, pg8::StaticOrder, true, true>(lds, g, S, E, tid);
    }
}
__global__ void __launch_bounds__(512, 2) fwd(Params p) {
    extern __shared__ __attribute__((aligned(16))) unsigned char lds_raw[];
    LAS unsigned char* lds = (LAS unsigned char*)lds_raw;
    const int wave0 = __builtin_amdgcn_readfirstlane(threadIdx.x >> 6);
    const int lo = p.ph_lo, hi = p.ph_hi;
    volatile LAS unsigned* st = (volatile LAS unsigned*)(lds + LDS_BYTES - 64);
    if (threadIdx.x < 4) st[threadIdx.x] = 0u;
    __syncthreads();
    XcdBarrier bar; bar.bar = (unsigned*)(p.ws + WS_CTL); bar.x = 0; bar.st = st;
    const bool use_cg = hi > 8;
    if (hi - lo > 1 && !use_cg) bar = xcd_barrier_post((unsigned*)(p.ws + WS_CTL), st);
    int vc = blockIdx.x; bool local_ok = false;
#define MK_SEAM() do { if (use_cg) cg::this_grid().sync(); else if (local_ok) xcd_local_barrier(bar); else xcd_barrier(bar); } while (0)
#define MK_PHASE(k) if (lo <= (k) && (k) < hi) { if ((PHM >> (k)) & 1) run_phase<k>(p, lds, wave0, vc); if (PROBE_REP == (k)) { MK_SEAM(); run_phase<k>(p, lds, wave0, vc); } if ((k) + 1 < hi) MK_SEAM(); }
    MK_PHASE(0)
    if (hi - lo > 1 && !use_cg && lo == 0) { local_ok = __builtin_amdgcn_readfirstlane((int)st[3]) != 0; if (local_ok) vc = __builtin_amdgcn_readfirstlane((int)(st[2] * 8u + bar.x)); }
    MK_PHASE(1) MK_PHASE(2) MK_PHASE(3) MK_PHASE(4) MK_PHASE(5) MK_PHASE(6) MK_PHASE(7)
#undef MK_SEAM
#undef MK_PHASE
}
}

extern "C" void kernel_launch(void* const* d_in, const int* in_sizes, int n_in, void* d_out, int out_size, void* d_ws, size_t ws_size, hipStream_t stream) {
    static int grid = 0;
    if (grid == 0) {
        if (n_in != 18 || out_size != mk::M * mk::D || ws_size < mk::WS_END) { fprintf(stderr, "kernel_launch: unexpected shapes (n_in %d out %d ws %zu)\n", n_in, out_size, ws_size); grid = -1; return; }
        int dev = 0, cus = 0;
        if (hipGetDevice(&dev) != hipSuccess || hipDeviceGetAttribute(&cus, hipDeviceAttributeMultiprocessorCount, dev) != hipSuccess) { grid = -1; return; }
        if (hipFuncSetAttribute((const void*)mk::fwd, hipFuncAttributeMaxDynamicSharedMemorySize, mk::LDS_BYTES) != hipSuccess) { fprintf(stderr, "kernel_launch: hipFuncSetAttribute failed\n"); grid = -1; return; }
        grid = cus;
    }
    if (grid < 0) return;
    mk::Params p{};
    for (int i = 0; i < 18; ++i) p.in[i] = (const float*)d_in[i];
    p.out = (float*)d_out; p.ws = (unsigned char*)d_ws;
    if (hipMemsetAsync((char*)d_ws + mk::WS_CTL, 0, mk::CTL_BYTES, stream) != hipSuccess) { fprintf(stderr, "kernel_launch: memset of the barrier words failed\n"); return; }
#if MK_LAUNCHES == 1
    p.ph_lo = 0; p.ph_hi = 8;
    void* args[] = {&p};
    hipError_t e = hipLaunchCooperativeKernel((const void*)mk::fwd, dim3(grid), dim3(512), args, mk::LDS_BYTES, stream);
    if (e != hipSuccess) fprintf(stderr, "cooperative launch failed: %s (grid %d)\n", hipGetErrorString(e), grid);
#else
    for (int ph = 0; ph < 8; ++ph) { p.ph_lo = ph; p.ph_hi = ph + 1; hipLaunchKernelGGL(mk::fwd, dim3(grid), dim3(512), mk::LDS_BYTES, stream, p); }
#endif
}
```

```cpp
#include <hip/hip_runtime.h>
#include <hip/hip_cooperative_groups.h>
#include <cstdio>
#include <cstdint>
namespace cg = cooperative_groups;
#ifndef PHM
#define PHM 0x1ff
#endif
#ifndef PROBE_REP
#define PROBE_REP -1
#endif
#ifndef MK_LAUNCHES
#define MK_LAUNCHES 1
#endif
namespace pg8 {
#define PG8_LAS __attribute__((address_space(3)))
typedef unsigned short bf16_t;
typedef short bf16x8 __attribute__((ext_vector_type(8)));
typedef float f32x4 __attribute__((ext_vector_type(4)));
typedef unsigned u32x4 __attribute__((ext_vector_type(4)));
constexpr int BM = 256, BK = 64, HALF = 128, HTB = HALF * BK * 2  , STAGE_BYTES = 8 * HTB, NXCD = 8, WGM = 8;

__host__ __device__ __forceinline__ int lds_byte(int r, int c) { const int st = (r >> 4) * 2 + (c >> 5), rr = r & 15, cc = c & 31, ob = rr * 64 + cc * 2; return st * 1024 + (ob ^ (((ob >> 9) & 1) << 5)); }
__host__ __device__ __forceinline__ void stage_rc(int b, int& R, int& C) { const int st = b / 1024, sb = b % 1024, swz = sb ^ (((sb >> 9) & 1) << 5); R = (st >> 1) * 16 + swz / 64; C = (st & 1) * 32 + (swz % 64) / 2; }
__host__ __device__ __forceinline__ int perm32(int rho) { const int n = rho >> 4, i = rho & 15; return 8 * (i >> 2) + 4 * n + (i & 3); }

struct Unit { int pm, pn; };
struct Gemm { const bf16_t* A; const bf16_t* Bt; int M, N, K; int lda = 0; };

struct StaticOrder {
    int nM, nN, nwg, G, c, half = 0;
    __host__ __device__ void init(int M, int N, int G_, int c_) { nM = M / BM; nN = N / BM; nwg = nM * nN; G = G_; c = c_; }
    __host__ __device__ bool next(int i, Unit& u) const {
        if (half) {
            const int xcc = c & 7, rank = c >> 3, h = rank >> 4, rr = rank & 15, og = i * 16 + rr;
            if (og >= 8 * nN) return false;
            const int nig = 4 * nN, sg = og / nig, w = og % nig;
            u.pm = 16 * xcc + 8 * h + 4 * sg + (w & 3); u.pn = w >> 2; return true;
        }
        const long L = (long)i * G + c; if (L >= nwg) return false;
        int wgid = (int)L; { const int q = nwg / NXCD, r = nwg % NXCD, xcd = wgid % NXCD, off = wgid / NXCD; wgid = (xcd < r ? xcd * (q + 1) : r * (q + 1) + (xcd - r) * q) + off; }
        const int nig = WGM * nN, gid = wgid / nig, fm = gid * WGM, gsz = (nM - fm) < WGM ? (nM - fm) : WGM;
        u.pm = fm + ((wgid % nig) % gsz); u.pn = (wgid % nig) / gsz; return true;
    }
    __device__ __forceinline__ void a_ready(const Unit&) const {}
    __device__ __forceinline__ void done(const Unit&) const {}
};
__device__ __forceinline__ unsigned cvt_pk_bf16(float lo, float hi) { unsigned r; asm volatile("v_cvt_pk_bf16_f32 %0, %1, %2" : "=v"(r) : "v"(lo), "v"(hi)); return r; }
template <class Epi, class Sched, bool ALIGN_EPI = false, bool SP2 = false>
__device__ __forceinline__ void gemm_phase(PG8_LAS unsigned char* lds, const Gemm g, const Sched& S, const Epi& E, const int tid) {
    const int wid = __builtin_amdgcn_readfirstlane(tid >> 6), lane = tid & 63, wr = wid >> 2, wc = wid & 3, fr = lane & 15, fq = lane >> 4;
    const int K = g.K, nt = K / BK, lda = g.lda ? g.lda : g.K;
    unsigned voffA[2], voffB[2];
#pragma unroll
    for (int i = 0; i < 2; ++i) { int R, C; stage_rc(tid * 16 + i * 8192, R, C); const int Rb = Epi::PERM ? ((R & ~31) + perm32(R & 31)) : R;
        voffA[i] = (unsigned)(R * lda + C) * 2u; voffB[i] = (unsigned)(Rb * K + C) * 2u; }
    const size_t kstep = (size_t)(BK * 2);
    const size_t hstep = (size_t)HALF * K * 2;
    const size_t tstep = 2 * hstep;
    const size_t hstepA = (size_t)HALF * lda * 2, tstepA = 2 * hstepA;
    const unsigned ldsw = (unsigned)wid * 1024u;
    const int aoff = lds_byte(wr * 64 + fr, fq * 8), boff = lds_byte(wc * 32 + fr, fq * 8);
#define PG8_SA(b, h) (((b) * 2 + (h)) * HTB)
#define PG8_SB(b, h) ((4 + (b) * 2 + (h)) * HTB)
#define PG8_STAGE(bufoff, gbase, voff) do { _Pragma("unroll") for (int _i = 0; _i < 2; ++_i) \
        __builtin_amdgcn_global_load_lds((const unsigned*)((const char*)(gbase) + (voff)[_i]), (PG8_LAS unsigned*)(lds + (bufoff) + ldsw + _i * 8192), 16, 0, 0); } while (0)
#define PG8_LDA(dst, b, h) do { _Pragma("unroll") for (int m = 0; m < 4; ++m) _Pragma("unroll") for (int k = 0; k < 2; ++k) dst[m][k] = *(const PG8_LAS bf16x8*)(lds + PG8_SA(b, h) + aoff + m * 2048 + k * 1024); } while (0)
#define PG8_LDB(dst, b, h) do { _Pragma("unroll") for (int n = 0; n < 2; ++n) _Pragma("unroll") for (int k = 0; k < 2; ++k) dst[n][k] = *(const PG8_LAS bf16x8*)(lds + PG8_SB(b, h) + boff + n * 2048 + k * 1024); } while (0)
#define PG8_MMA(ai, bj, At, Bt) do { __builtin_amdgcn_s_setprio(1); _Pragma("unroll") for (int m = 0; m < 4; ++m) _Pragma("unroll") for (int n = 0; n < 2; ++n) _Pragma("unroll") for (int k = 0; k < 2; ++k) \
        acc[ai][bj][m][n] = __builtin_amdgcn_mfma_f32_16x16x32_bf16(Bt[n][k], At[m][k], acc[ai][bj][m][n], 0, 0, 0); __builtin_amdgcn_s_setprio(0); } while (0)
#define PG8_WAIT_V(n) asm volatile("s_waitcnt vmcnt(" #n ")" ::: "memory")
#define PG8_WAIT_L(n) asm volatile("s_waitcnt lgkmcnt(" #n ")" ::: "memory")
#define PG8_BAR __builtin_amdgcn_s_barrier()
#define PG8_SCHED __builtin_amdgcn_sched_barrier(0)
    Unit cur, nxt; int ui = 0;
    if (!S.next(0, cur)) return;
    f32x4 acc[2][2][4][2];
#pragma unroll
    for (int a = 0; a < 2; ++a)
#pragma unroll
        for (int b = 0; b < 2; ++b)
#pragma unroll
            for (int m = 0; m < 4; ++m)
#pragma unroll
                for (int n = 0; n < 2; ++n) acc[a][b][m][n] = (f32x4){0.f, 0.f, 0.f, 0.f};
    bf16x8 At[4][2], B0[2][2], B1[2][2];
    float epre[Epi::NPRE];
    const char* cA = (const char*)g.A + (size_t)cur.pm * tstepA; const char* cB = (const char*)g.Bt + (size_t)cur.pn * tstep;
    S.a_ready(cur);
    if constexpr (SP2) {
        PG8_STAGE(PG8_SB(0, 0), cB, voffB); PG8_STAGE(PG8_SB(0, 1), cB + hstep, voffB); PG8_STAGE(PG8_SA(0, 0), cA, voffA); PG8_STAGE(PG8_SA(0, 1), cA + hstepA, voffA);
        if (wr == 1) PG8_BAR;
        PG8_WAIT_V(2); PG8_BAR;
        PG8_STAGE(PG8_SB(1, 0), cB + kstep, voffB); PG8_STAGE(PG8_SA(1, 0), cA + kstep, voffA); PG8_STAGE(PG8_SB(1, 1), cB + hstep + kstep, voffB);
        PG8_WAIT_V(6); PG8_BAR;
    } else {
        PG8_STAGE(PG8_SB(0, 0), cB, voffB); PG8_STAGE(PG8_SA(0, 0), cA, voffA); PG8_STAGE(PG8_SB(0, 1), cB + hstep, voffB); PG8_STAGE(PG8_SA(0, 1), cA + hstepA, voffA);
        if (wr == 1) PG8_BAR;
        PG8_WAIT_V(4); PG8_BAR;
        PG8_STAGE(PG8_SB(1, 0), cB + kstep, voffB); PG8_STAGE(PG8_SA(1, 0), cA + kstep, voffA); PG8_STAGE(PG8_SB(1, 1), cB + hstep + kstep, voffB);
        PG8_WAIT_V(6); PG8_BAR;
    }
    for (;;) {
        const bool has_next = S.next(ui + 1, nxt);
        const char* nA = has_next ? (const char*)g.A + (size_t)nxt.pm * tstepA : cA; const char* nB = has_next ? (const char*)g.Bt + (size_t)nxt.pn * tstep : cB;
        for (int t = 0; t < nt; t += 2) {
            const bool last = (t == nt - 2);
            const char* a1 = cA + (size_t)(t + 1) * kstep;
            const char* a2 = last ? nA : cA + (size_t)(t + 2) * kstep; const char* b2 = last ? nB : cB + (size_t)(t + 2) * kstep;
            const char* a3 = a2 + kstep; const char* b3 = b2 + kstep;
            if (last && has_next) S.a_ready(nxt);
            if (last) E.pre(epre, cur, wr, wc, fr, fq);
            if constexpr (SP2) {
            PG8_LDB(B0, 0, 0); PG8_LDB(B1, 0, 1); PG8_SCHED; PG8_LDA(At, 0, 0); PG8_STAGE(PG8_SA(1, 1), a1 + hstepA, voffA);
            PG8_WAIT_V(8); PG8_WAIT_L(0); PG8_BAR; PG8_MMA(0, 0, At, B0); PG8_MMA(0, 1, At, B1); PG8_BAR; PG8_SCHED;
            PG8_LDA(At, 0, 1); PG8_STAGE(PG8_SB(0, 0), b2, voffB); PG8_STAGE(PG8_SB(0, 1), b2 + hstep, voffB); PG8_STAGE(PG8_SA(0, 0), a2, voffA);
            PG8_WAIT_V(8); PG8_WAIT_L(0); PG8_BAR; PG8_MMA(1, 0, At, B0); PG8_MMA(1, 1, At, B1); PG8_BAR; PG8_SCHED;
            PG8_LDB(B0, 1, 0); PG8_LDB(B1, 1, 1); PG8_SCHED; PG8_LDA(At, 1, 0); PG8_STAGE(PG8_SA(0, 1), a2 + hstepA, voffA);
            PG8_WAIT_V(8); PG8_WAIT_L(0); PG8_BAR; PG8_MMA(0, 0, At, B0); PG8_MMA(0, 1, At, B1); PG8_BAR; PG8_SCHED;
            PG8_LDA(At, 1, 1); PG8_STAGE(PG8_SB(1, 0), b3, voffB); PG8_STAGE(PG8_SB(1, 1), b3 + hstep, voffB); PG8_STAGE(PG8_SA(1, 0), a3, voffA);
            PG8_WAIT_V(8); PG8_WAIT_L(0); PG8_BAR; PG8_MMA(1, 0, At, B0); PG8_MMA(1, 1, At, B1); PG8_BAR; PG8_SCHED;
            } else {
            PG8_LDB(B0, 0, 0); PG8_SCHED; PG8_LDA(At, 0, 0); PG8_STAGE(PG8_SA(1, 1), a1 + hstepA, voffA);
            PG8_WAIT_L(8); PG8_BAR; PG8_WAIT_L(0); PG8_MMA(0, 0, At, B0); PG8_BAR; PG8_SCHED;
            PG8_LDB(B1, 0, 1); PG8_STAGE(PG8_SB(0, 0), b2, voffB);
            PG8_BAR; PG8_WAIT_L(0); PG8_MMA(0, 1, At, B1); PG8_BAR;
            PG8_LDA(At, 0, 1); PG8_STAGE(PG8_SA(0, 0), a2, voffA);
            PG8_BAR; PG8_WAIT_L(0); PG8_MMA(1, 0, At, B0); PG8_BAR; PG8_SCHED;
            PG8_STAGE(PG8_SB(0, 1), b2 + hstep, voffB);
            PG8_WAIT_V(6); PG8_BAR; PG8_MMA(1, 1, At, B1); PG8_BAR;
            PG8_LDB(B0, 1, 0); PG8_SCHED; PG8_LDA(At, 1, 0); PG8_STAGE(PG8_SA(0, 1), a2 + hstepA, voffA);
            PG8_WAIT_L(8); PG8_BAR; PG8_WAIT_L(0); PG8_MMA(0, 0, At, B0); PG8_BAR; PG8_SCHED;
            PG8_LDB(B1, 1, 1); PG8_STAGE(PG8_SB(1, 0), b3, voffB);
            PG8_BAR; PG8_WAIT_L(0); PG8_MMA(0, 1, At, B1); PG8_BAR;
            PG8_LDA(At, 1, 1); PG8_STAGE(PG8_SA(1, 0), a3, voffA);
            PG8_BAR; PG8_WAIT_L(0); PG8_MMA(1, 0, At, B0); PG8_BAR; PG8_SCHED;
            PG8_STAGE(PG8_SB(1, 1), b3 + hstep, voffB);
            PG8_WAIT_V(6); PG8_BAR; PG8_MMA(1, 1, At, B1); PG8_BAR;
            }
        }
        if constexpr (ALIGN_EPI) { if (wr == 0) PG8_BAR; }
        if constexpr (!Epi::AFTER_DRAIN) { E(acc, epre, cur, wr, wc, fr, fq); S.done(cur); }
        if (!has_next) break;
#pragma unroll
        for (int a = 0; a < 2; ++a)
#pragma unroll
            for (int b = 0; b < 2; ++b)
#pragma unroll
                for (int m = 0; m < 4; ++m)
#pragma unroll
                    for (int n = 0; n < 2; ++n) acc[a][b][m][n] = (f32x4){0.f, 0.f, 0.f, 0.f};
        cur = nxt; cA = nA; cB = nB; ++ui;
        if constexpr (ALIGN_EPI) { if (wr == 1) PG8_BAR; }
    }
    PG8_WAIT_V(0);
    if constexpr (!ALIGN_EPI) { if (wr == 0) PG8_BAR; }
    PG8_BAR;
    if constexpr (Epi::AFTER_DRAIN) { E.fused(acc, cur, wr, wc, fr, fq, lds, wid, lane); S.done(cur); }
#undef PG8_SA
#undef PG8_SB
#undef PG8_STAGE
#undef PG8_LDA
#undef PG8_LDB
#undef PG8_MMA
#undef PG8_WAIT_V
#undef PG8_WAIT_L
#undef PG8_BAR
#undef PG8_SCHED
}
}

namespace mk {
using pg8::bf16_t; using pg8::f32x4; using pg8::u32x4; using pg8::bf16x8; using pg8::Unit;
#define LAS __attribute__((address_space(3)))
typedef unsigned u32x2 __attribute__((ext_vector_type(2)));
typedef float f32x2 __attribute__((ext_vector_type(2)));
constexpr int M = 32768, D = 1024, FF = 2816, NIN = 1536, AW = 512, SEQ = 4096;
constexpr float EPS = 1e-6f;
constexpr int LDS_BYTES = 147456;
constexpr size_t MiB = 1u << 20;
constexpr size_t WS_W1A = 0 * MiB, WS_W1D = 11 * MiB, WS_W2A = 17 * MiB, WS_W2D = 28 * MiB, WS_WIN = 34 * MiB, WS_WOUT = 37 * MiB, WS_WM = 39 * MiB, WS_SS = 40 * MiB,
                 WS_CTL = 41 * MiB, CTL_BYTES = 65536,  WS_XB = 42 * MiB, WS_ACT = 106 * MiB,
                 WS_U = WS_ACT, WS_V = WS_ACT + 1024, WS_Z = WS_ACT + 2048, WS_Y = WS_ACT + 3072, WS_END = 282 * MiB;

__device__ __forceinline__ float silu_f(float g) { return g * __builtin_amdgcn_rcpf(1.0f + __builtin_amdgcn_exp2f(-1.4426950409f * g)); }
__device__ __forceinline__ float gelu_f(float v) { const float w = v + 0.044715f * v * v * v; return v * __builtin_amdgcn_rcpf(1.0f + __builtin_amdgcn_exp2f(-2.3022081981f * w)); }
__device__ __forceinline__ f32x2 gelu2(const f32x2 a2, const float rr) {
    const f32x2 v2 = a2 * rr, w2 = v2 * v2, p2 = w2 * (-2.3022081981f * 0.044715f) + (-2.3022081981f), g2 = v2 * p2;
    f32x2 e2; e2.x = __builtin_amdgcn_exp2f(g2.x); e2.y = __builtin_amdgcn_exp2f(g2.y);
    const f32x2 d2 = e2 + 1.0f; f32x2 q2; q2.x = __builtin_amdgcn_rcpf(d2.x); q2.y = __builtin_amdgcn_rcpf(d2.y);
    return v2 * q2;
}
__device__ __forceinline__ float bf_lo(unsigned w) { return __uint_as_float(w << 16); }
__device__ __forceinline__ float bf_hi(unsigned w) { return __uint_as_float(w & 0xffff0000u); }
__device__ __forceinline__ u32x4 pack8(const f32x4 a, const f32x4 b) { u32x4 w; w.x = pg8::cvt_pk_bf16(a[0], a[1]); w.y = pg8::cvt_pk_bf16(a[2], a[3]); w.z = pg8::cvt_pk_bf16(b[0], b[1]); w.w = pg8::cvt_pk_bf16(b[2], b[3]); return w; }
__device__ __forceinline__ float row_rstd(const float* ss, int row) { return __builtin_amdgcn_rsqf(ss[row] * (1.0f / 1024.0f) + EPS); }
constexpr size_t SS_STRIDE = 32768;
constexpr int CNT_WORD0 = 4096;

__device__ __forceinline__ void epi_pre_wait(float (&e)[8]) { asm volatile("s_waitcnt vmcnt(8)" : "+v"(e[0]), "+v"(e[1]), "+v"(e[2]), "+v"(e[3]), "+v"(e[4]), "+v"(e[5]), "+v"(e[6]), "+v"(e[7]) :: "memory"); }
struct EpiSwiglu {
    static constexpr bool PERM = true, AFTER_DRAIN = false;
    bf16_t* O; const float* ss;
    static constexpr int NPRE = 8;
    __device__ __forceinline__ void pre(float (&e)[8], const Unit& u, int wr, int wc, int fr, int fq) const {
        const float* p0 = ss + (u.pm * 256 + wr * 64 + fr);
#pragma unroll
        for (int i = 0; i < 8; ++i) asm volatile("global_load_dword %0, %1, off offset:%2" : "=v"(e[i]) : "v"(p0), "i"(((i >> 2) * 128 + (i & 3) * 16) * 4) : "memory");
    }
    __device__ __forceinline__ void operator()(const f32x4 (&acc)[2][2][4][2], float (&e)[8], const Unit& u, int wr, int wc, int fr, int fq) const {
        const int row0 = u.pm * 256 + wr * 64 + fr, col0 = u.pn * 128 + wc * 32 + 8 * fq;
        epi_pre_wait(e);
        float r[2][4];
#pragma unroll
        for (int ai = 0; ai < 2; ++ai)
#pragma unroll
            for (int m = 0; m < 4; ++m) r[ai][m] = __builtin_amdgcn_rsqf(e[ai * 4 + m] * (1.0f / 1024.0f) + EPS);
#pragma unroll
        for (int ai = 0; ai < 2; ++ai)
#pragma unroll
            for (int m = 0; m < 4; ++m) {
                const float rr = r[ai][m], c1 = -1.4426950409f * rr, r2 = rr * rr;
                f32x4 o[2];
#pragma unroll
                for (int n = 0; n < 2; ++n)
#pragma unroll
                    for (int h = 0; h < 2; ++h) {
                        const f32x2 g2 = (f32x2){acc[ai][0][m][n][2 * h], acc[ai][0][m][n][2 * h + 1]}, u2 = (f32x2){acc[ai][1][m][n][2 * h], acc[ai][1][m][n][2 * h + 1]};
                        const f32x2 a2 = g2 * c1; f32x2 e2; e2.x = __builtin_amdgcn_exp2f(a2.x); e2.y = __builtin_amdgcn_exp2f(a2.y);
                        const f32x2 d2 = e2 + 1.0f; f32x2 q2; q2.x = __builtin_amdgcn_rcpf(d2.x); q2.y = __builtin_amdgcn_rcpf(d2.y);
                        const f32x2 t2 = ((g2 * u2) * r2) * q2;
                        o[n][2 * h] = t2.x; o[n][2 * h + 1] = t2.y; }
                *(u32x4*)(O + (size_t)(row0 + ai * 128 + m * 16) * FF + col0) = pack8(o[0], o[1]);
            }
    }
};
template <bool BASE_F32> struct EpiRes {
    static constexpr bool PERM = true, AFTER_DRAIN = false;
    const float* basef; bf16_t* xb; float* ss; float alpha;
    static constexpr int NPRE = 1;
    __device__ __forceinline__ void pre(float (&)[1], const Unit&, int, int, int, int) const {}
    __device__ __forceinline__ void operator()(const f32x4 (&acc)[2][2][4][2], float (&)[1], const Unit& u, int wr, int wc, int fr, int fq) const {
        const unsigned off0 = (unsigned)(u.pm * 256 + wr * 64 + fr) * (unsigned)D + (unsigned)(u.pn * 256 + wc * 32 + 8 * fq);
        const unsigned sso = (unsigned)(u.pm * 256 + wr * 64 + fr);
        u32x4 bw[2][4][2];
        if constexpr (!BASE_F32) {
#pragma unroll
            for (int ai = 0; ai < 2; ++ai)
#pragma unroll
                for (int m = 0; m < 4; ++m)
#pragma unroll
                    for (int bj = 0; bj < 2; ++bj) bw[ai][m][bj] = *(const u32x4*)(xb + off0 + (unsigned)((ai * 128 + m * 16) * D + bj * 128));
        }
#pragma unroll
        for (int ai = 0; ai < 2; ++ai)
#pragma unroll
            for (int m = 0; m < 4; ++m) {
                float sq = 0.f;
#pragma unroll
                for (int bj = 0; bj < 2; ++bj) {
                    const unsigned off = off0 + (unsigned)((ai * 128 + m * 16) * D + bj * 128);
                    f32x4 b0, b1;
                    if constexpr (BASE_F32) { b0 = *(const f32x4*)(basef + off); b1 = *(const f32x4*)(basef + off + 4); }
                    else { const u32x4 w = bw[ai][m][bj]; b0 = (f32x4){bf_lo(w.x), bf_hi(w.x), bf_lo(w.y), bf_hi(w.y)}; b1 = (f32x4){bf_lo(w.z), bf_hi(w.z), bf_lo(w.w), bf_hi(w.w)}; }
                    const f32x4 v0 = b0 + acc[ai][bj][m][0] * alpha, v1 = b1 + acc[ai][bj][m][1] * alpha;
                    *(u32x4*)(xb + off) = pack8(v0, v1);
                    sq += (v0[0] * v0[0] + v0[1] * v0[1]) + (v0[2] * v0[2] + v0[3] * v0[3]) + (v1[0] * v1[0] + v1[1] * v1[1]) + (v1[2] * v1[2] + v1[3] * v1[3]);
                }
                sq += __shfl_xor(sq, 16); sq += __shfl_xor(sq, 32);
                if (fq == 0) __hip_atomic_fetch_add(ss + sso + (unsigned)(ai * 128 + m * 16), sq, __ATOMIC_RELAXED, __HIP_MEMORY_SCOPE_AGENT);
                if (BASE_F32 && (m & 1)) asm volatile("" ::: "memory");
            }
    }
};
struct EpiResFinal {
    static constexpr bool PERM = true, AFTER_DRAIN = false;
    const bf16_t* xb; float* out; float* ss; unsigned* cnt; const float* gfin; float alpha;
    static constexpr int NPRE = 1;
    __device__ __forceinline__ void pre(float (&)[1], const Unit&, int, int, int, int) const {}
    __device__ __forceinline__ void operator()(f32x4 (&acc)[2][2][4][2], float (&)[1], const Unit& u, int wr, int wc, int fr, int fq) const {
        const unsigned off0 = (unsigned)(u.pm * 256 + wr * 64 + fr) * (unsigned)D + (unsigned)(u.pn * 256 + wc * 32 + 8 * fq);
        const unsigned sso = (unsigned)(u.pm * 256 + wr * 64 + fr);
        u32x4 bw[2][4][2];
#pragma unroll
        for (int ai = 0; ai < 2; ++ai)
#pragma unroll
            for (int m = 0; m < 4; ++m)
#pragma unroll
                for (int bj = 0; bj < 2; ++bj) bw[ai][m][bj] = *(const u32x4*)(xb + off0 + (unsigned)((ai * 128 + m * 16) * D + bj * 128));
#pragma unroll
        for (int ai = 0; ai < 2; ++ai)
#pragma unroll
            for (int m = 0; m < 4; ++m) {
                float sq = 0.f;
#pragma unroll
                for (int bj = 0; bj < 2; ++bj) {
                    const u32x4 w = bw[ai][m][bj];
                    const f32x4 b0 = (f32x4){bf_lo(w.x), bf_hi(w.x), bf_lo(w.y), bf_hi(w.y)}, b1 = (f32x4){bf_lo(w.z), bf_hi(w.z), bf_lo(w.w), bf_hi(w.w)};
                    const f32x4 v0 = b0 + acc[ai][bj][m][0] * alpha, v1 = b1 + acc[ai][bj][m][1] * alpha;
                    acc[ai][bj][m][0] = v0; acc[ai][bj][m][1] = v1;
                    sq += (v0[0] * v0[0] + v0[1] * v0[1]) + (v0[2] * v0[2] + v0[3] * v0[3]) + (v1[0] * v1[0] + v1[1] * v1[1]) + (v1[2] * v1[2] + v1[3] * v1[3]);
                }
                sq += __shfl_xor(sq, 16); sq += __shfl_xor(sq, 32);
                if (fq == 0) __hip_atomic_fetch_add(ss + sso + (unsigned)(ai * 128 + m * 16), sq, __ATOMIC_RELAXED, __HIP_MEMORY_SCOPE_AGENT);
            }
        asm volatile("s_waitcnt vmcnt(0)" ::: "memory");
        unsigned* c = cnt + 64 * u.pm;
        if (fr == 0 && fq == 0) __hip_atomic_fetch_add(c, 1u, __ATOMIC_RELAXED, __HIP_MEMORY_SCOPE_AGENT);
        unsigned spins = 0;
        while ((unsigned)__builtin_amdgcn_readfirstlane(__hip_atomic_load(c, __ATOMIC_RELAXED, __HIP_MEMORY_SCOPE_AGENT)) < 32u) { __builtin_amdgcn_s_sleep(2); if (++spins > (1u << 20)) break; }
        f32x4 gv[2][2];
#pragma unroll
        for (int bj = 0; bj < 2; ++bj)
#pragma unroll
            for (int n = 0; n < 2; ++n) gv[bj][n] = *(const f32x4*)(gfin + u.pn * 256 + bj * 128 + wc * 32 + 8 * fq + 4 * n);
        float tot[2][4];
#pragma unroll
        for (int ai = 0; ai < 2; ++ai)
#pragma unroll
            for (int m = 0; m < 4; ++m) tot[ai][m] = __hip_atomic_load(ss + sso + (unsigned)(ai * 128 + m * 16), __ATOMIC_RELAXED, __HIP_MEMORY_SCOPE_AGENT);
#pragma unroll
        for (int ai = 0; ai < 2; ++ai)
#pragma unroll
            for (int m = 0; m < 4; ++m) { const float r = __builtin_amdgcn_rsqf(tot[ai][m] * (1.0f / 1024.0f) + EPS);
#pragma unroll
                for (int bj = 0; bj < 2; ++bj) { const unsigned off = off0 + (unsigned)((ai * 128 + m * 16) * D + bj * 128);
                    __builtin_nontemporal_store(acc[ai][bj][m][0] * r * gv[bj][0], (f32x4*)(out + off)); __builtin_nontemporal_store(acc[ai][bj][m][1] * r * gv[bj][1], (f32x4*)(out + off + 4)); } }
    }
};
struct EpiWin {
    static constexpr bool PERM = true, AFTER_DRAIN = false;
    bf16_t *U, *V, *Z; const float* ss;
    static constexpr int NPRE = 8;
    __device__ __forceinline__ void pre(float (&e)[8], const Unit& u, int wr, int wc, int fr, int fq) const {
        const float* p0 = ss + (u.pm * 256 + wr * 64 + fr);
#pragma unroll
        for (int i = 0; i < 8; ++i) asm volatile("global_load_dword %0, %1, off offset:%2" : "=v"(e[i]) : "v"(p0), "i"(((i >> 2) * 128 + (i & 3) * 16) * 4) : "memory");
    }
    __device__ __forceinline__ void operator()(const f32x4 (&acc)[2][2][4][2], float (&e)[8], const Unit& u, int wr, int wc, int fr, int fq) const {
        const int row0 = u.pm * 256 + wr * 64 + fr;
        epi_pre_wait(e);
        float r[2][4];
#pragma unroll
        for (int ai = 0; ai < 2; ++ai)
#pragma unroll
            for (int m = 0; m < 4; ++m) r[ai][m] = __builtin_amdgcn_rsqf(e[ai * 4 + m] * (1.0f / 1024.0f) + EPS);
        if (u.pn < 2) {
            const int col0 = u.pn * 256 + wc * 32 + 8 * fq;
#pragma unroll
            for (int ai = 0; ai < 2; ++ai)
#pragma unroll
                for (int m = 0; m < 4; ++m) { const float rr = r[ai][m]; bf16_t* rowp = U + (size_t)(row0 + ai * 128 + m * 16) * FF + col0;
#pragma unroll
                    for (int bj = 0; bj < 2; ++bj) { f32x4 o0, o1;
#pragma unroll
                        for (int h = 0; h < 2; ++h) { const f32x2 x0 = gelu2((f32x2){acc[ai][bj][m][0][2 * h], acc[ai][bj][m][0][2 * h + 1]}, rr), x1 = gelu2((f32x2){acc[ai][bj][m][1][2 * h], acc[ai][bj][m][1][2 * h + 1]}, rr);
                            o0[2 * h] = x0.x; o0[2 * h + 1] = x0.y; o1[2 * h] = x1.x; o1[2 * h + 1] = x1.y; }
                        *(u32x4*)(rowp + bj * 128) = pack8(o0, o1); } }
        } else if (u.pn < 4) {
            const int colb = 64 * ((u.pn - 2) * 4 + wc) + 8 * fq;
#pragma unroll
            for (int ai = 0; ai < 2; ++ai)
#pragma unroll
                for (int m = 0; m < 4; ++m) { const float rr = r[ai][m]; f32x4 g[2][2]; float sq = 0.f;
#pragma unroll
                    for (int bj = 0; bj < 2; ++bj)
#pragma unroll
                        for (int n = 0; n < 2; ++n)
#pragma unroll
                            for (int h = 0; h < 2; ++h) { const f32x2 t = gelu2((f32x2){acc[ai][bj][m][n][2 * h], acc[ai][bj][m][n][2 * h + 1]}, rr); g[bj][n][2 * h] = t.x; g[bj][n][2 * h + 1] = t.y; sq += t.x * t.x + t.y * t.y; }
                    sq += __shfl_xor(sq, 16); sq += __shfl_xor(sq, 32);
                    const float hr = __builtin_amdgcn_rsqf(sq * (1.0f / 64.0f) + EPS);
                    bf16_t* rowp = V + (size_t)(row0 + ai * 128 + m * 16) * FF + colb;
#pragma unroll
                    for (int bj = 0; bj < 2; ++bj) *(u32x4*)(rowp + 32 * bj) = pack8(g[bj][0] * hr, g[bj][1] * hr); }
        } else {
            const int col0 = (u.pn - 4) * 256 + wc * 32 + 8 * fq;
#pragma unroll
            for (int ai = 0; ai < 2; ++ai)
#pragma unroll
                for (int m = 0; m < 4; ++m) { const float rr = r[ai][m]; bf16_t* rowp = Z + (size_t)(row0 + ai * 128 + m * 16) * FF + col0;
#pragma unroll
                    for (int bj = 0; bj < 2; ++bj) *(u32x4*)(rowp + bj * 128) = pack8(acc[ai][bj][m][0] * rr, acc[ai][bj][m][1] * rr); }
        }
    }
};

__device__ __forceinline__ float wave_sum(float v) {
#pragma unroll
    for (int o = 1; o < 64; o <<= 1) v += __shfl_xor(v, o);
    return v;
}
__device__ __forceinline__ void p0_transpose_item(const float* src, int ld, int Kd, int k0, int scol0, bf16_t* dst, int drow0, const float* gk, LAS float* scr, int lane) {
    float tv[32];
#pragma unroll
    for (int i = 0; i < 32; ++i) { const int kk = 2 * i + (lane >> 5); tv[i] = src[(size_t)(k0 + kk) * ld + scol0 + (lane & 31)]; }
    if (gk) {
#pragma unroll
        for (int i = 0; i < 32; ++i) tv[i] *= gk[k0 + 2 * i + (lane >> 5)];
    }
#pragma unroll
    for (int i = 0; i < 32; ++i) scr[(2 * i + (lane >> 5)) * 33 + (lane & 31)] = tv[i];
    asm volatile("s_waitcnt lgkmcnt(0)" ::: "memory");
    const int c = lane & 7;
#pragma unroll
    for (int j = 0; j < 4; ++j) { const int n = (lane >> 3) + 8 * j; const LAS float* s = scr + (8 * c) * 33 + n;
        u32x4 o; o.x = pg8::cvt_pk_bf16(s[0 * 33], s[1 * 33]); o.y = pg8::cvt_pk_bf16(s[2 * 33], s[3 * 33]); o.z = pg8::cvt_pk_bf16(s[4 * 33], s[5 * 33]); o.w = pg8::cvt_pk_bf16(s[6 * 33], s[7 * 33]);
        *(u32x4*)(dst + (size_t)(drow0 + n) * Kd + k0 + 8 * c) = o; }
    asm volatile("s_waitcnt lgkmcnt(0)" ::: "memory");
}

struct Params { const float* in[18]; float* out; unsigned char* ws; int ph_lo, ph_hi; };

__device__ __forceinline__ void p0_prep(const Params& p, LAS unsigned char* lds, int tid, int wave, int lane) {
    unsigned char* ws = p.ws;
    LAS float* scr = (LAS float*)(lds + wave * 16384);
    const int gw = blockIdx.x * 4 + (wave & 3), NGW = gridDim.x * 4;
    constexpr int I_A = 16 * 176, I_D = 44 * 32, I_IN = 16 * 32, I_OUT = 16 * 32, I_ZP = 1024;
    constexpr int NITEMS = I_ZP + 2 * (I_A + I_D) + I_IN + I_OUT;
    bf16_t* XB = (bf16_t*)(ws + WS_XB); float* ss = (float*)(ws + WS_SS);
    if (wave >= 4) {
    for (int it = gw; it < NITEMS; it += NGW) {
        int r = it;
        if (r < I_ZP) {
            const int g = r >> 8, kb = (r >> 4) & 15, jb = r & 15, k = 64 * kb + lane;
            const float* __restrict__ wrow = p.in[6] + (size_t)k * NIN + 1024 + 128 * g;
            const float* __restrict__ wp = p.in[10] + (size_t)g * 16384 + 8 * jb;
            float a[8];
#pragma unroll
            for (int j = 0; j < 8; ++j) a[j] = 0.f;
#pragma unroll
            for (int b = 0; b < 4; ++b) { f32x4 w4[8];
#pragma unroll
                for (int q = 0; q < 8; ++q) w4[q] = *(const f32x4*)(wrow + 32 * b + 4 * q);
#pragma unroll
                for (int q = 0; q < 8; ++q)
#pragma unroll
                    for (int e = 0; e < 4; ++e) { const float* wpi = wp + (size_t)(32 * b + 4 * q + e) * 128;
#pragma unroll
                        for (int j = 0; j < 8; ++j) a[j] += w4[q][e] * wpi[j]; } }
            const float gm = p.in[5][k];
            bf16_t* dst = (bf16_t*)(ws + WS_WIN) + (size_t)(1024 + 128 * g + 8 * jb) * D + k;
#pragma unroll
            for (int j = 0; j < 8; ++j) dst[(size_t)j * D] = (bf16_t)(pg8::cvt_pk_bf16(a[j] * gm, 0.f) & 0xffffu);
            continue;
        }
        r -= I_ZP;
        if (r < 2 * (I_A + I_D)) {
            const int l = r >= (I_A + I_D); if (l) r -= (I_A + I_D);
            const float* nrm = l ? p.in[13] : p.in[1]; const float* wg = l ? p.in[14] : p.in[2]; const float* wu = l ? p.in[15] : p.in[3]; const float* wd = l ? p.in[16] : p.in[4];
            bf16_t* dA = (bf16_t*)(ws + (l ? WS_W2A : WS_W1A)); bf16_t* dD = (bf16_t*)(ws + (l ? WS_W2D : WS_W1D));
            if (r < I_A) { const int kb = r / 176, rb = r % 176, pn = rb >> 3, bj = (rb >> 2) & 1, c0 = (rb & 3) * 32;
                p0_transpose_item(bj ? wu : wg, FF, D, 64 * kb, 128 * pn + c0, dA, 32 * rb, nrm, scr, lane); }
            else { r -= I_A; const int kb = r / 32, rb = r % 32; p0_transpose_item(wd, D, FF, 64 * kb, 32 * rb, dD, 32 * rb, nullptr, scr, lane); }
            continue;
        }
        r -= 2 * (I_A + I_D);
        if (r < I_IN) { const int kb = r / 32, rb = r % 32; int sc;
            if (rb < 16) sc = 32 * rb; else { const int q = rb - 16, pn = q >> 3, bj = (q >> 2) & 1, wc = q & 3; sc = 512 + 64 * (4 * pn + wc) + 32 * bj; }
            p0_transpose_item(p.in[6], NIN, D, 64 * kb, sc, (bf16_t*)(ws + WS_WIN), 32 * rb, p.in[5], scr, lane); continue; }
        r -= I_IN;
        { const int kb = r / 32, rb = r % 32; p0_transpose_item(p.in[12], D, D, 64 * kb, 32 * rb, (bf16_t*)(ws + WS_WOUT), 32 * rb, nullptr, scr, lane); }
    }
    for (int e8 = blockIdx.x * 256 + (tid - 256); e8 < 8 * 128 * 128 / 8; e8 += gridDim.x * 256) {
        const int e = e8 * 8, t = (e >> 7) & 127, s0 = e & 127;
        const f32x4 a = *(const f32x4*)(p.in[8] + e), b = *(const f32x4*)(p.in[8] + e + 4); f32x4 ma, mb;
#pragma unroll
        for (int j = 0; j < 4; ++j) { ma[j] = (s0 + j <= t) ? a[j] : 0.f; mb[j] = (s0 + 4 + j <= t) ? b[j] : 0.f; }
        *(u32x4*)((bf16_t*)(ws + WS_WM) + e) = pack8(ma, mb);
    }
    for (int i = blockIdx.x * 256 + (tid - 256); i < 3 * M / 4; i += gridDim.x * 256) ((f32x4*)(ss + SS_STRIDE))[i] = (f32x4){0.f, 0.f, 0.f, 0.f};
    return;
    }
    for (int m = gw; m < M; m += 4 * NGW) {
        f32x4 v[4][4];
#pragma unroll
        for (int q = 0; q < 4; ++q) { const int mq = (m + q * NGW < M) ? m + q * NGW : m; const f32x4* xr = (const f32x4*)(p.in[0] + (size_t)mq * D) + lane;
#pragma unroll
            for (int j = 0; j < 4; ++j) v[q][j] = __builtin_nontemporal_load(xr + 64 * j); }
#pragma unroll
        for (int q = 0; q < 4; ++q) { const int mq = m + q * NGW; if (mq < M) {
            float sq = 0.f;
#pragma unroll
            for (int j = 0; j < 4; ++j) sq += (v[q][j][0] * v[q][j][0] + v[q][j][1] * v[q][j][1]) + (v[q][j][2] * v[q][j][2] + v[q][j][3] * v[q][j][3]);
            sq = wave_sum(sq);
            u32x2* o = (u32x2*)(XB + (size_t)mq * D) + lane;
#pragma unroll
            for (int j = 0; j < 4; ++j) { u32x2 w; w.x = pg8::cvt_pk_bf16(v[q][j][0], v[q][j][1]); w.y = pg8::cvt_pk_bf16(v[q][j][2], v[q][j][3]); o[64 * j] = w; }
            if (lane == 0) ss[mq] = sq; } }
    }
}

__device__ __forceinline__ f32x4 unpack4(const u32x2 z) { return (f32x4){bf_lo(z.x), bf_hi(z.x), bf_lo(z.y), bf_hi(z.y)}; }
template <int WIN> __device__ __forceinline__ void pool_task(const bf16_t* __restrict__ zc, bf16_t* __restrict__ yc, const size_t Rt, const int pos0, const f32x4 sc) {
    constexpr int H = WIN - 1;
    u32x2 raw[H + 8];
#pragma unroll
    for (int i = 0; i < H + 8; ++i) { const bool ok = pos0 - H + i >= 0; raw[i] = *(const u32x2*)(zc + (ok ? Rt - H + i : Rt) * FF); if (!ok) raw[i] = (u32x2){0u, 0u}; }
    f32x4 s = (f32x4){0.f, 0.f, 0.f, 0.f};
#pragma unroll
    for (int i = 0; i < H; ++i) s += unpack4(raw[i]);
#pragma unroll
    for (int t = 0; t < 8; ++t) {
        const f32x4 zt = unpack4(raw[H + t]); s += zt;
        const int pos = pos0 + t, cnt = (pos + 1 < WIN) ? pos + 1 : WIN; const float inv = 1.0f / (float)cnt;
        const f32x4 o = (s * inv - zt) * sc;
        u32x2 w; w.x = pg8::cvt_pk_bf16(o[0], o[1]); w.y = pg8::cvt_pk_bf16(o[2], o[3]);
        *(u32x2*)(yc + (Rt + t) * FF) = w;
        s -= unpack4(raw[t]);
    }
}
__device__ __forceinline__ void p4_mixer(const Params& p, LAS unsigned char* lds, int tid, int wave, int lane, int vc) {
    unsigned char* ws = p.ws;
    const bf16_t* __restrict__ U = (const bf16_t*)(ws + WS_U); const bf16_t* __restrict__ V = (const bf16_t*)(ws + WS_V); const bf16_t* __restrict__ Z = (const bf16_t*)(ws + WS_Z); bf16_t* __restrict__ Y = (bf16_t*)(ws + WS_Y);
    const bf16_t* __restrict__ Wm = (const bf16_t*)(ws + WS_WM); const float* __restrict__ bs = p.in[9]; const float* __restrict__ pscale = p.in[11]; const float* __restrict__ vgain = p.in[7];
    constexpr int P = 136;
    LAS bf16_t* Vt = (LAS bf16_t*)lds;
    const int fr = lane & 15, fq = lane >> 4;
    for (int chunk = (gridDim.x == 256) ? 32 * (vc & 7) + (vc >> 3) : (int)blockIdx.x; chunk < M / 128; chunk += gridDim.x) {
        const size_t R0 = (size_t)chunk * 128;
        const int vs = tid & 127, cq0 = tid >> 7; u32x4 vreg[16];
        {
            const bf16_t* vrow = V + (R0 + vs) * FF + 8 * cq0;
#pragma unroll
            for (int it = 0; it < 16; ++it) vreg[it] = *(const u32x4*)(vrow + 32 * it);
        }
        {
            const int g = wave & 3, cq = 32 * g + (lane & 31), q4 = (wave >> 2) * 2 + (lane >> 5);
            const bf16_t* zc = Z + 4 * cq; bf16_t* yc = Y + 512 + 4 * cq; const f32x4 sc = *(const f32x4*)(pscale + 4 * cq);
            const int pb = (chunk & 31) * 128 + 32 * q4; const size_t Rb = R0 + 32 * q4;
#pragma unroll 1
            for (int k = 0; k < 4; ++k) {
                if (g == 0) pool_task<2>(zc, yc, Rb + 8 * k, pb + 8 * k, sc);
                else if (g == 1) pool_task<4>(zc, yc, Rb + 8 * k, pb + 8 * k, sc);
                else if (g == 2) pool_task<8>(zc, yc, Rb + 8 * k, pb + 8 * k, sc);
                else pool_task<16>(zc, yc, Rb + 8 * k, pb + 8 * k, sc);
            }
        }
        {
#pragma unroll
            for (int it = 0; it < 16; ++it) { LAS bf16_t* d = Vt + (8 * (cq0 + 4 * it)) * P + vs;
                d[0 * P] = (bf16_t)(vreg[it].x & 0xffffu); d[1 * P] = (bf16_t)(vreg[it].x >> 16); d[2 * P] = (bf16_t)(vreg[it].y & 0xffffu); d[3 * P] = (bf16_t)(vreg[it].y >> 16);
                d[4 * P] = (bf16_t)(vreg[it].z & 0xffffu); d[5 * P] = (bf16_t)(vreg[it].z >> 16); d[6 * P] = (bf16_t)(vreg[it].w & 0xffffu); d[7 * P] = (bf16_t)(vreg[it].w >> 16); }
        }
        __syncthreads();
#pragma unroll 1
        for (int ib = 0; ib < 8; ib += 4) {
            bf16x8 wf[4][4]; float bias[4]; u32x2 uu[4][4]; f32x4 gn[4][4];
#pragma unroll
            for (int j = 0; j < 4; ++j) { const int h = ib + j, ts = (wave + h) & 7, t = 16 * ts + fr; const size_t row = R0 + t;
                const bf16_t* wrow = Wm + (size_t)(h * 128 + t) * 128 + 8 * fq;
#pragma unroll
                for (int ks = 0; ks < 4; ++ks) wf[j][ks] = *(const bf16x8*)(wrow + 32 * ks);
                bias[j] = bs[h * 128 + t];
#pragma unroll
                for (int nb = 0; nb < 4; ++nb) { const int col = 64 * h + 16 * nb + 4 * fq; uu[j][nb] = *(const u32x2*)(U + row * FF + col); gn[j][nb] = *(const f32x4*)(vgain + col); } }
#pragma unroll
            for (int j = 0; j < 4; ++j) { const int h = ib + j, ts = (wave + h) & 7, t = 16 * ts + fr, nks = (ts >> 1) + 1; const size_t row = R0 + t;
                f32x4 acc[4];
#pragma unroll
                for (int nb = 0; nb < 4; ++nb) acc[nb] = (f32x4){0.f, 0.f, 0.f, 0.f};
#pragma unroll
                for (int ks = 0; ks < 4; ++ks) if (ks < nks) {
#pragma unroll
                    for (int nb = 0; nb < 4; ++nb) { const bf16x8 vf = *(const LAS bf16x8*)(Vt + (64 * h + 16 * nb + fr) * P + 32 * ks + 8 * fq);
                        acc[nb] = __builtin_amdgcn_mfma_f32_16x16x32_bf16(vf, wf[j][ks], acc[nb], 0, 0, 0); }
                }
#pragma unroll
                for (int nb = 0; nb < 4; ++nb) { const int col = 64 * h + 16 * nb + 4 * fq;
                    u32x2 w; w.x = pg8::cvt_pk_bf16(bf_lo(uu[j][nb].x) * (acc[nb][0] * gn[j][nb][0] + bias[j]), bf_hi(uu[j][nb].x) * (acc[nb][1] * gn[j][nb][1] + bias[j]));
                    w.y = pg8::cvt_pk_bf16(bf_lo(uu[j][nb].y) * (acc[nb][2] * gn[j][nb][2] + bias[j]), bf_hi(uu[j][nb].y) * (acc[nb][3] * gn[j][nb][3] + bias[j]));
                    *(u32x2*)(Y + row * FF + col) = w; } }
        }
        __syncthreads();
    }
}

#define XB_TMO      128
#define XB_XCNT(j)  (256  + 64 * (j))
#define XB_XSUB(j)  (1280 + 64 * (j))
#define XB_XGEN(j)  (2304 + 64 * (j))
#define XB_TOP      3328
#define XB_TOPGEN   3392
#define XCD_BAR_WORDS 3456
#define XB_SPIN_CAP (1u << 18)

__device__ __forceinline__ unsigned xb_ld(unsigned* p)              { return __hip_atomic_load(p, __ATOMIC_RELAXED, __HIP_MEMORY_SCOPE_AGENT); }
__device__ __forceinline__ unsigned xb_add(unsigned* p, unsigned v) { return __hip_atomic_fetch_add(p, v, __ATOMIC_RELAXED, __HIP_MEMORY_SCOPE_AGENT); }
__device__ __forceinline__ unsigned xb_xcc_id() { return (unsigned)__builtin_amdgcn_s_getreg((3 << 11) | 20) & 0xFu; }
#define XB_SPIN(cond, bar) do { unsigned _sp = 0; while (cond) { __builtin_amdgcn_s_sleep(1); \
    if ((++_sp & 255u) == 0u) { if (xb_ld(&(bar)[XB_TMO])) break; if (_sp > XB_SPIN_CAP) { atomicAdd(&(bar)[XB_TMO], 1u); break; } } } } while (0)

struct XcdBarrier {
    unsigned* bar; unsigned x;
    volatile __attribute__((address_space(3))) unsigned* st;
};

__device__ __forceinline__ XcdBarrier xcd_barrier_post(unsigned* bar, volatile __attribute__((address_space(3))) unsigned* st) {
    XcdBarrier b; b.bar = bar; b.x = xb_xcc_id(); b.st = st;
    if (threadIdx.x == 0) st[2] = xb_add(&bar[XB_XCNT(b.x)], 1u);
    return b;
}
__device__ __forceinline__ void xcd_barrier_complete(unsigned* bar, unsigned x, unsigned& nloc, unsigned& nx) {
    const unsigned G = gridDim.x * gridDim.y * gridDim.z;
    unsigned sum, cnt, mine, sp = 0u;
    for (;;) {
        sum = 0u; cnt = 0u; mine = 0u;
#pragma unroll
        for (unsigned j = 0; j < 16; ++j) { const unsigned c = xb_ld(&bar[XB_XCNT(j)]); sum += c; cnt += (c > 0u) ? 1u : 0u; mine = (j == x) ? c : mine; }
        if (sum == G) break;
        __builtin_amdgcn_s_sleep(1);
        if ((++sp & 255u) == 0u) { if (xb_ld(&bar[XB_TMO])) break; if (sp > XB_SPIN_CAP) { atomicAdd(&bar[XB_TMO], 1u); break; } }
    }
    nloc = mine > 0u ? mine : 1u; nx = cnt > 0u ? cnt : 1u;
}
__device__ __forceinline__ unsigned xcd_census_is_8x32(unsigned* bar) {
    unsigned ok = (gridDim.x == 256u) ? 1u : 0u;
#pragma unroll
    for (unsigned j = 0; j < 16; ++j) { const unsigned c = xb_ld(&bar[XB_XCNT(j)]); if (c != (j < 8u ? 32u : 0u)) ok = 0u; }
    return ok;
}

__device__ __forceinline__ void xcd_barrier(const XcdBarrier& b) {
    asm volatile("s_waitcnt vmcnt(0)" ::: "memory");
    __syncthreads();
    if (threadIdx.x == 0) {
        unsigned* bar = b.bar;
        __builtin_amdgcn_s_waitcnt(0);
        unsigned nloc = b.st[0], nx = b.st[1];
        if (nloc == 0u) { xcd_barrier_complete(bar, b.x, nloc, nx); b.st[0] = nloc; b.st[1] = nx; b.st[3] = xcd_census_is_8x32(bar); }
        const unsigned old = xb_add(&bar[XB_XSUB(b.x)], 1u);
        const unsigned gen = old / nloc;
        if (old + 1u == (gen + 1u) * nloc) {
            __builtin_amdgcn_fence(__ATOMIC_RELEASE, "agent");
            asm volatile("s_waitcnt vmcnt(0)" ::: "memory");
            const unsigned og = xb_add(&bar[XB_TOP], 1u);
            const unsigned tg = og / nx;
            if (og + 1u == (tg + 1u) * nx) xb_add(&bar[XB_TOPGEN], 1u);
            else XB_SPIN(xb_ld(&bar[XB_TOPGEN]) == tg, bar);
            __builtin_amdgcn_fence(__ATOMIC_ACQUIRE, "agent");
            xb_add(&bar[XB_XGEN(b.x)], 1u);
            asm volatile("s_waitcnt vmcnt(0)" ::: "memory");
        } else {
            XB_SPIN(xb_ld(&bar[XB_XGEN(b.x)]) == gen, bar);
            __builtin_amdgcn_fence(__ATOMIC_ACQUIRE, "agent");
            asm volatile("s_waitcnt vmcnt(0)" ::: "memory");
        }
    }
    __syncthreads();
}

#define XB_LSUB(j)  (12288 + 64 * (j))
#define XB_LGEN(j)  (13312 + 64 * (j))
__device__ __forceinline__ void xcd_local_barrier(const XcdBarrier& b) {
    asm volatile("s_waitcnt vmcnt(0)" ::: "memory");
    __syncthreads();
    if (threadIdx.x == 0) {
        unsigned* bar = b.bar;
        __builtin_amdgcn_s_waitcnt(0);
        const unsigned nloc = b.st[0];
        const unsigned old = xb_add(&bar[XB_LSUB(b.x)], 1u);
        const unsigned gen = old / nloc;
        if (old + 1u == (gen + 1u) * nloc) xb_add(&bar[XB_LGEN(b.x)], 1u);
        else XB_SPIN(xb_ld(&bar[XB_LGEN(b.x)]) == gen, bar);
        __builtin_amdgcn_fence(__ATOMIC_ACQUIRE, "agent");
        asm volatile("s_waitcnt vmcnt(0)" ::: "memory");
    }
    __syncthreads();
}

#define XB_HSUB(j)  (14336 + 32 * (j))
#define XB_HGEN(j)  (14848 + 32 * (j))
__device__ __forceinline__ void xcd_half_barrier(const XcdBarrier& b, const unsigned hidx) {
    asm volatile("s_waitcnt vmcnt(0)" ::: "memory");
    __syncthreads();
    if (threadIdx.x == 0) {
        unsigned* bar = b.bar;
        __builtin_amdgcn_s_waitcnt(0);
        const unsigned old = xb_add(&bar[XB_HSUB(hidx)], 1u);
        const unsigned gen = old / 16u;
        if (old + 1u == (gen + 1u) * 16u) xb_add(&bar[XB_HGEN(hidx)], 1u);
        else XB_SPIN(xb_ld(&bar[XB_HGEN(hidx)]) == gen, bar);
        __builtin_amdgcn_fence(__ATOMIC_ACQUIRE, "agent");
        asm volatile("s_waitcnt vmcnt(0)" ::: "memory");
    }
    __syncthreads();
}

__device__ __forceinline__ void stagger_wait(int c, unsigned ticks) {
    const unsigned g = ((unsigned)c >> 3) & 3u;
    if (g) { const unsigned long long t0 = __builtin_amdgcn_s_memrealtime(); while (__builtin_amdgcn_s_memrealtime() - t0 < (unsigned long long)(g * ticks)) __builtin_amdgcn_s_sleep(8); }
}
template <int PH> __device__ __forceinline__ void run_phase(const Params& p, LAS unsigned char* lds, const int wave0, const int c, const int halfm) {
    int tid = wave0 * 64 + (int)__builtin_amdgcn_mbcnt_hi(~0u, __builtin_amdgcn_mbcnt_lo(~0u, 0u)); asm volatile("" : "+v"(tid));
    const int lane = tid & 63, wave = __builtin_amdgcn_readfirstlane(tid >> 6);
    unsigned char* ws = p.ws;
    bf16_t* XB = (bf16_t*)(ws + WS_XB); bf16_t* ACT = (bf16_t*)(ws + WS_ACT); float* ss = (float*)(ws + WS_SS);
    const int G = gridDim.x;
    if constexpr (PH == 0) p0_prep(p, lds, tid, wave, lane);
    if constexpr (PH == 1 || PH == 6) {
        pg8::Gemm g{XB, (const bf16_t*)(ws + (PH == 1 ? WS_W1A : WS_W2A)), M, 2 * FF, D}; pg8::StaticOrder S; S.init(M, 2 * FF, G, c); S.half = halfm;
        EpiSwiglu E{ACT, ss + (PH == 1 ? 0 : 2) * SS_STRIDE};
        pg8::gemm_phase<EpiSwiglu, pg8::StaticOrder, true, true>(lds, g, S, E, tid);
    }
    if constexpr (PH == 2) {
        pg8::Gemm g{ACT, (const bf16_t*)(ws + WS_W1D), M, D, FF}; pg8::StaticOrder S; S.init(M, D, G, c); S.half = halfm;
        EpiRes<false> E{nullptr, XB, ss + SS_STRIDE, 0.5f};
        pg8::gemm_phase<EpiRes<false>, pg8::StaticOrder, true, true>(lds, g, S, E, tid);
    }
    if constexpr (PH == 7) {
        pg8::Gemm g{ACT, (const bf16_t*)(ws + WS_W2D), M, D, FF}; pg8::StaticOrder S; S.init(M, D, G, c); S.half = halfm;
        EpiResFinal E{XB, p.out, ss + 3 * SS_STRIDE, (unsigned*)(ws + WS_CTL) + CNT_WORD0, p.in[17], 0.5f};
        pg8::gemm_phase<EpiResFinal, pg8::StaticOrder, true, true>(lds, g, S, E, tid);
    }
    if constexpr (PH == 3) {
        pg8::Gemm g{XB, (const bf16_t*)(ws + WS_WIN), M, NIN, D}; pg8::StaticOrder S; S.init(M, NIN, G, c); S.half = halfm;
        EpiWin E{(bf16_t*)(ws + WS_U), (bf16_t*)(ws + WS_V), (bf16_t*)(ws + WS_Z), ss + SS_STRIDE};
        pg8::gemm_phase<EpiWin, pg8::StaticOrder, true, true>(lds, g, S, E, tid);
    }
    if constexpr (PH == 4) p4_mixer(p, lds, tid, wave, lane, c);
    if constexpr (PH == 5) {
        pg8::Gemm g{(const bf16_t*)(ws + WS_Y), (const bf16_t*)(ws + WS_WOUT), M, D, D, FF}; pg8::StaticOrder S; S.init(M, D, G, c); S.half = halfm;
        EpiRes<false> E{nullptr, XB, ss + 2 * SS_STRIDE, 1.0f};
        pg8::gemm_phase<EpiRes<false>, pg8::StaticOrder, true, true>(lds, g, S, E, tid);
    }
}
__global__ void __launch_bounds__(512, 2) fwd(Params p) {
    extern __shared__ __attribute__((aligned(16))) unsigned char lds_raw[];
    LAS unsigned char* lds = (LAS unsigned char*)lds_raw;
    const int wave0 = __builtin_amdgcn_readfirstlane(threadIdx.x >> 6);
    const int lo = p.ph_lo, hi = p.ph_hi;
    volatile LAS unsigned* st = (volatile LAS unsigned*)(lds + LDS_BYTES - 64);
    if (threadIdx.x < 4) st[threadIdx.x] = 0u;
    __syncthreads();
    XcdBarrier bar; bar.bar = (unsigned*)(p.ws + WS_CTL); bar.x = 0; bar.st = st;
    const bool use_cg = hi > 8;
    if (hi - lo > 1 && !use_cg) bar = xcd_barrier_post((unsigned*)(p.ws + WS_CTL), st);
    int vc = blockIdx.x; bool local_ok = false; unsigned hidx = 0;
#define MK_SEAM() do { if (use_cg) cg::this_grid().sync(); else if (local_ok) xcd_local_barrier(bar); else xcd_barrier(bar); } while (0)
#define MK_SEAMK(k) do { if (local_ok && ((k) == 1 || (k) == 2 || (k) == 4 || (k) == 6)) xcd_half_barrier(bar, hidx); else MK_SEAM(); } while (0)
#define MK_PHASE(k) if (lo <= (k) && (k) < hi) { if ((PHM >> (k)) & 1) run_phase<k>(p, lds, wave0, vc, local_ok ? 1 : 0); if ((k) + 1 < hi) MK_SEAMK(k); }
    MK_PHASE(0)
    if (hi - lo > 1 && !use_cg && lo == 0) { local_ok = __builtin_amdgcn_readfirstlane((int)st[3]) != 0; if (local_ok) { vc = __builtin_amdgcn_readfirstlane((int)(st[2] * 8u + bar.x)); hidx = (unsigned)((vc & 7) * 2 + (vc >> 7)); } }
    MK_PHASE(1) MK_PHASE(2) MK_PHASE(3) MK_PHASE(4) MK_PHASE(5) MK_PHASE(6) MK_PHASE(7)
#undef MK_SEAM
#undef MK_SEAMK
#undef MK_PHASE
}
}

extern "C" void kernel_launch(void* const* d_in, const int* in_sizes, int n_in, void* d_out, int out_size, void* d_ws, size_t ws_size, hipStream_t stream) {
    static int grid = 0;
    if (grid == 0) {
        if (n_in != 18 || out_size != mk::M * mk::D || ws_size < mk::WS_END) { fprintf(stderr, "kernel_launch: unexpected shapes (n_in %d out %d ws %zu)\n", n_in, out_size, ws_size); grid = -1; return; }
        int dev = 0, cus = 0;
        if (hipGetDevice(&dev) != hipSuccess || hipDeviceGetAttribute(&cus, hipDeviceAttributeMultiprocessorCount, dev) != hipSuccess) { grid = -1; return; }
        if (hipFuncSetAttribute((const void*)mk::fwd, hipFuncAttributeMaxDynamicSharedMemorySize, mk::LDS_BYTES) != hipSuccess) { fprintf(stderr, "kernel_launch: hipFuncSetAttribute failed\n"); grid = -1; return; }
        grid = cus;
    }
    if (grid < 0) return;
    mk::Params p{};
    for (int i = 0; i < 18; ++i) p.in[i] = (const float*)d_in[i];
    p.out = (float*)d_out; p.ws = (unsigned char*)d_ws;
    if (hipMemsetAsync((char*)d_ws + mk::WS_CTL, 0, mk::CTL_BYTES, stream) != hipSuccess) { fprintf(stderr, "kernel_launch: memset of the barrier words failed\n"); return; }
#if MK_LAUNCHES == 1
    p.ph_lo = 0; p.ph_hi = 8;
    void* args[] = {&p};
    hipError_t e = hipLaunchCooperativeKernel((const void*)mk::fwd, dim3(grid), dim3(512), args, mk::LDS_BYTES, stream);
    if (e != hipSuccess) fprintf(stderr, "cooperative launch failed: %s (grid %d)\n", hipGetErrorString(e), grid);
#else
    for (int ph = 0; ph < 8; ++ph) { p.ph_lo = ph; p.ph_hi = ph + 1; hipLaunchKernelGGL(mk::fwd, dim3(grid), dim3(512), mk::LDS_BYTES, stream, p); }
#endif
}
```
